# Optimizing an MI355X kernel written in HIP

```python
import math
import jax
import jax.numpy as jnp
from jax import lax
import numpy as np

D_MODEL = 1024
BATCH = 8
SEQ = 8192
DEPTH = 1

CHUNK = 64
GMLP_GROUPS = 8
GMLP_GROUP_DIM = 64
GMLP_WIDTH = GMLP_GROUPS * GMLP_GROUP_DIM
GMLP_BLOCK = 128
DIFF_HEADS = 8
DIFF_QK_DIM = 64
DIFF_V_DIM = 2 * DIFF_QK_DIM
DIFF_QK_WIDTH = DIFF_HEADS * 2 * DIFF_QK_DIM
DIFF_WIDTH = DIFF_HEADS * DIFF_V_DIM
Q_BLOCK = 128
N_GROUPS = 4
EXPERTS_PER_GROUP = 8
N_EXPERTS = N_GROUPS * EXPERTS_PER_GROUP
EXPERT_TOPK = 2
EXPERT_HIDDEN = 512
DISPATCH_BLOCK = 256
ALPHA = (2.0 * DEPTH) ** 0.25
BETA = (8.0 * DEPTH) ** -0.25
LN_EPS = 1e-5
RMS_EPS = 1e-5
OFF_U = 0
OFF_V = OFF_U + GMLP_WIDTH
OFF_Q = OFF_V + GMLP_WIDTH
OFF_K = OFF_Q + DIFF_QK_WIDTH
OFF_VAL = OFF_K + DIFF_QK_WIDTH
OFF_GA = OFF_VAL + DIFF_WIDTH
OFF_GB = OFF_GA + D_MODEL
IN_WIDTH = OFF_GB + D_MODEL

kernel_name = 'hybrid_gmlp_diffattn_hmoe_deepnorm'


def _layer_norm(x, g, b):
    xf = x.astype(jnp.float32)
    mu = jnp.mean(xf, axis=-1, keepdims=True)
    var = jnp.mean(jnp.square(xf - mu), axis=-1, keepdims=True)
    return ((xf - mu) * lax.rsqrt(var + LN_EPS)).astype(x.dtype) * g + b


def _spatial_gating(u, v, ln_g, ln_b, w_s, b_s):
    B, S, _ = u.shape
    n_blk = S // GMLP_BLOCK
    v = _layer_norm(v, ln_g, ln_b)
    v = v.reshape(B, n_blk, GMLP_BLOCK, GMLP_GROUPS, GMLP_GROUP_DIM)
    chunk_id = jnp.arange(GMLP_BLOCK) // CHUNK
    causal = chunk_id[:, None] >= chunk_id[None, :]
    w = jnp.where(causal[None], w_s, 0)
    mixed = jnp.einsum('gts,bnsgc->bntgc', w, v) + b_s.T[:, :, None]
    return u * mixed.reshape(B, S, GMLP_WIDTH)


def _diff_attention(q, k, v, lam, subln_g, lambda_init):
    B, S = q.shape[0], q.shape[1]
    n_blk = S // Q_BLOCK
    q = jnp.transpose(q * (DIFF_QK_DIM ** -0.5), (0, 2, 3, 1, 4))
    k = jnp.transpose(k, (0, 2, 3, 1, 4))
    v = jnp.transpose(v, (0, 2, 1, 3))
    q_blocks = jnp.moveaxis(q.reshape(B, DIFF_HEADS, 2, n_blk, Q_BLOCK, DIFF_QK_DIM), 3, 0)
    slopes = 2.0 ** (-8.0 * jnp.arange(1, DIFF_HEADS + 1, dtype=jnp.float32) / DIFF_HEADS)
    key_pos = jnp.arange(S)
    lam = lam.astype(jnp.float32)

    def one_block(args):
        q_blk, i = args
        q_pos = i * Q_BLOCK + jnp.arange(Q_BLOCK)
        visible = (key_pos[None, :] // CHUNK) <= (q_pos[:, None] // CHUNK)
        dist = jnp.abs(q_pos[:, None] - key_pos[None, :]).astype(jnp.float32)
        alibi = -slopes[:, None, None] * dist
        s = jnp.einsum('bhcqd,bhckd->bhcqk', q_blk, k).astype(jnp.float32) + alibi[None, :, None]
        s = jnp.where(visible, s, -jnp.inf)
        p = jax.nn.softmax(s, axis=-1)
        a = p[:, :, 0] - lam * p[:, :, 1]
        return jnp.einsum('bhqk,bhkd->bhqd', a.astype(v.dtype), v)

    out = lax.map(one_block, (q_blocks, jnp.arange(n_blk)))
    out = jnp.transpose(out, (1, 0, 3, 2, 4)).reshape(B, S, DIFF_HEADS, DIFF_V_DIM)
    of = out.astype(jnp.float32)
    of = of * lax.rsqrt(jnp.mean(jnp.square(of), axis=-1, keepdims=True) + RMS_EPS)
    out = of.astype(v.dtype) * subln_g * (1.0 - lambda_init)
    return out.reshape(B, S, DIFF_WIDTH)


def _token_mixer(h, layer, w_in, b_in, sg_ln_g, sg_ln_b, sg_w, sg_b, w_branch_a,
                 lam_q1, lam_k1, lam_q2, lam_k2, subln_g, w_branch_b, w_out):
    B, S, _ = h.shape

    def proj(lo, hi):
        return h @ w_in[:, lo:hi] + b_in[lo:hi]

    u = jax.nn.gelu(proj(OFF_U, OFF_V), approximate=False)
    v = jax.nn.gelu(proj(OFF_V, OFF_Q), approximate=False)
    y_a = _spatial_gating(u, v, sg_ln_g, sg_ln_b, sg_w, sg_b) @ w_branch_a
    q = proj(OFF_Q, OFF_K).reshape(B, S, DIFF_HEADS, 2, DIFF_QK_DIM)
    k = proj(OFF_K, OFF_VAL).reshape(B, S, DIFF_HEADS, 2, DIFF_QK_DIM)
    val = proj(OFF_VAL, OFF_GA).reshape(B, S, DIFF_HEADS, DIFF_V_DIM)
    lambda_init = 0.8 - 0.6 * math.exp(-0.3 * layer)
    lam = (jnp.exp(jnp.sum((lam_q1 * lam_k1).astype(jnp.float32)))
           - jnp.exp(jnp.sum((lam_q2 * lam_k2).astype(jnp.float32))) + lambda_init)
    y_b = _diff_attention(q, k, val, lam, subln_g, lambda_init) @ w_branch_b
    g_a = jax.nn.sigmoid(proj(OFF_GA, OFF_GB))
    g_b = jax.nn.sigmoid(proj(OFF_GB, IN_WIDTH))
    return (g_a * y_a + g_b * y_b) @ w_out


def _hier_moe(x, w_group, b_group, w_expert, b_expert, w_gate, w_up, w_down):
    B, S, D = x.shape
    t = x.reshape(B * S, D)
    T = B * S
    g_logits = (t @ w_group).astype(jnp.float32) + b_group.astype(jnp.float32)
    g_sel = jnp.argmax(g_logits, axis=-1)
    g_w = jnp.take_along_axis(jax.nn.softmax(g_logits, axis=-1), g_sel[:, None], axis=-1)
    e_logits = ((t @ w_expert).astype(jnp.float32) + b_expert.astype(jnp.float32))
    e_logits = e_logits.reshape(T, N_GROUPS, EXPERTS_PER_GROUP)
    e_logits = jnp.take_along_axis(e_logits, g_sel[:, None, None], axis=1)[:, 0]
    top_v, top_i = lax.top_k(e_logits, EXPERT_TOPK)
    top_w = jax.nn.softmax(top_v, axis=-1) * g_w
    expert_id = (g_sel[:, None] * EXPERTS_PER_GROUP + top_i).astype(jnp.int32)
    A = T * EXPERT_TOPK
    flat_e = expert_id.reshape(A)
    flat_w = top_w.reshape(A)
    flat_tok = jnp.arange(A, dtype=jnp.int32) // EXPERT_TOPK
    order = jnp.argsort(flat_e)
    sorted_e = flat_e[order]
    counts = jnp.zeros((N_EXPERTS,), jnp.int32).at[flat_e].add(1)
    padded = (counts + DISPATCH_BLOCK - 1) // DISPATCH_BLOCK * DISPATCH_BLOCK
    start = jnp.cumsum(counts) - counts
    pad_end = jnp.cumsum(padded)
    pad_start = pad_end - padded
    dest = pad_start[sorted_e] + jnp.arange(A, dtype=jnp.int32) - start[sorted_e]
    P = A + N_EXPERTS * DISPATCH_BLOCK
    n_blocks = P // DISPATCH_BLOCK
    slot_tok = jnp.zeros((P,), jnp.int32).at[dest].set(flat_tok[order])
    slot_w = jnp.zeros((P,), jnp.float32).at[dest].set(flat_w[order])
    block_start = jnp.arange(n_blocks, dtype=jnp.int32) * DISPATCH_BLOCK
    block_e = jnp.minimum(jnp.searchsorted(pad_end, block_start, side='right'), N_EXPERTS - 1)

    def expert_block(args):
        tok, wgt, e = args
        xb = t[tok]
        hb = jax.nn.silu(xb @ w_gate[e]) * (xb @ w_up[e])
        return (hb @ w_down[e]) * wgt[:, None].astype(xb.dtype)

    out = lax.map(expert_block, (slot_tok.reshape(n_blocks, DISPATCH_BLOCK),
                                 slot_w.reshape(n_blocks, DISPATCH_BLOCK), block_e))
    y = jnp.zeros_like(t).at[slot_tok].add(out.reshape(P, D))
    return y.reshape(B, S, D)


def setup_inputs(seed: int = 0) -> dict:
    key = jax.random.key(seed)
    ks = jax.random.split(key, 32)
    L = DEPTH

    def nrm(k, shape, scale):
        return jax.random.normal(k, shape, jnp.float32) * scale

    col_scale = np.ones((IN_WIDTH,), np.float32)
    col_scale[OFF_VAL:OFF_GA] = BETA
    return {
        'x': nrm(ks[0], (BATCH, SEQ, D_MODEL), 1.0),
        'w_in': nrm(ks[1], (L, D_MODEL, IN_WIDTH), D_MODEL ** -0.5) * jnp.asarray(col_scale),
        'b_in': nrm(ks[2], (L, IN_WIDTH), 0.01),
        'sg_ln_g': 1.0 + nrm(ks[3], (L, GMLP_WIDTH), 0.05),
        'sg_ln_b': nrm(ks[4], (L, GMLP_WIDTH), 0.01),
        'sg_w': nrm(ks[5], (L, GMLP_GROUPS, GMLP_BLOCK, GMLP_BLOCK), GMLP_BLOCK ** -0.5),
        'sg_b': 1.0 + nrm(ks[6], (L, GMLP_GROUPS, GMLP_BLOCK), 0.1),
        'w_branch_a': nrm(ks[7], (L, GMLP_WIDTH, D_MODEL), BETA * GMLP_WIDTH ** -0.5),
        'lam_q1': nrm(ks[8], (L, DIFF_QK_DIM), 0.1),
        'lam_k1': nrm(ks[9], (L, DIFF_QK_DIM), 0.1),
        'lam_q2': nrm(ks[10], (L, DIFF_QK_DIM), 0.1),
        'lam_k2': nrm(ks[11], (L, DIFF_QK_DIM), 0.1),
        'subln_g': 1.0 + nrm(ks[12], (L, DIFF_V_DIM), 0.05),
        'w_branch_b': nrm(ks[13], (L, DIFF_WIDTH, D_MODEL), BETA * DIFF_WIDTH ** -0.5),
        'w_out': nrm(ks[14], (L, D_MODEL, D_MODEL), BETA * D_MODEL ** -0.5),
        'ln1_g': 1.0 + nrm(ks[15], (L, D_MODEL), 0.05),
        'ln1_b': nrm(ks[16], (L, D_MODEL), 0.01),
        'w_group': nrm(ks[17], (L, D_MODEL, N_GROUPS), D_MODEL ** -0.5),
        'b_group': nrm(ks[18], (L, N_GROUPS), 0.01),
        'w_expert': nrm(ks[19], (L, D_MODEL, N_EXPERTS), D_MODEL ** -0.5),
        'b_expert': nrm(ks[20], (L, N_EXPERTS), 0.01),
        'w_gate': nrm(ks[21], (L, N_EXPERTS, D_MODEL, EXPERT_HIDDEN), D_MODEL ** -0.5),
        'w_up': nrm(ks[22], (L, N_EXPERTS, D_MODEL, EXPERT_HIDDEN), D_MODEL ** -0.5),
        'w_down': nrm(ks[23], (L, N_EXPERTS, EXPERT_HIDDEN, D_MODEL), BETA * EXPERT_HIDDEN ** -0.5),
        'ln2_g': 1.0 + nrm(ks[24], (L, D_MODEL), 0.05),
        'ln2_b': nrm(ks[25], (L, D_MODEL), 0.01),
    }


def reference(x, w_in, b_in, sg_ln_g, sg_ln_b, sg_w, sg_b, w_branch_a,
              lam_q1, lam_k1, lam_q2, lam_k2, subln_g, w_branch_b, w_out,
              ln1_g, ln1_b, w_group, b_group, w_expert, b_expert,
              w_gate, w_up, w_down, ln2_g, ln2_b):
    h = x
    for layer in range(DEPTH):
        mix = _token_mixer(h, layer, w_in[layer], b_in[layer], sg_ln_g[layer], sg_ln_b[layer],
                           sg_w[layer], sg_b[layer], w_branch_a[layer],
                           lam_q1[layer], lam_k1[layer], lam_q2[layer], lam_k2[layer],
                           subln_g[layer], w_branch_b[layer], w_out[layer])
        h = _layer_norm(ALPHA * h + mix, ln1_g[layer], ln1_b[layer])
        ffn = _hier_moe(h, w_group[layer], b_group[layer], w_expert[layer], b_expert[layer],
                        w_gate[layer], w_up[layer], w_down[layer])
        h = _layer_norm(ALPHA * h + ffn, ln2_g[layer], ln2_b[layer])
    return h
```

```cpp
#include <hip/hip_runtime.h>
#include <cstdio>
#include <cstdint>
namespace pg8 {
#define PG8_LAS __attribute__((address_space(3)))
typedef unsigned short bf16_t;
typedef short bf16x8 __attribute__((ext_vector_type(8)));
typedef float f32x4 __attribute__((ext_vector_type(4)));
typedef unsigned u32x4 __attribute__((ext_vector_type(4)));
constexpr int BM = 256, BK = 64, HALF = 128, HTB = HALF * BK * 2  , STAGE_BYTES = 8 * HTB, NXCD = 8, WGM = 8;

__host__ __device__ __forceinline__ int lds_byte(int r, int c) { const int st = (r >> 4) * 2 + (c >> 5), rr = r & 15, cc = c & 31, ob = rr * 64 + cc * 2; return st * 1024 + (ob ^ (((ob >> 9) & 1) << 5)); }
__host__ __device__ __forceinline__ void stage_rc(int b, int& R, int& C) { const int st = b / 1024, sb = b % 1024, swz = sb ^ (((sb >> 9) & 1) << 5); R = (st >> 1) * 16 + swz / 64; C = (st & 1) * 32 + (swz % 64) / 2; }
__host__ __device__ __forceinline__ int perm32(int rho) { const int n = rho >> 4, i = rho & 15; return 8 * (i >> 2) + 4 * n + (i & 3); }

struct Unit { int pm, pn; };
struct Gemm { const bf16_t* A; const bf16_t* Bt; int M, N, K; };

struct StaticOrder {
    int nM, nN, nwg, G, c;
    __host__ __device__ void init(int M, int N, int G_, int c_) { nM = M / BM; nN = N / BM; nwg = nM * nN; G = G_; c = c_; }
    __host__ __device__ bool next(int i, Unit& u) const {
        const long L = (long)i * G + c; if (L >= nwg) return false;
        int wgid = (int)L; { const int q = nwg / NXCD, r = nwg % NXCD, xcd = wgid % NXCD, off = wgid / NXCD; wgid = (xcd < r ? xcd * (q + 1) : r * (q + 1) + (xcd - r) * q) + off; }
        const int nig = WGM * nN, gid = wgid / nig, fm = gid * WGM, gsz = (nM - fm) < WGM ? (nM - fm) : WGM;
        u.pm = fm + ((wgid % nig) % gsz); u.pn = (wgid % nig) / gsz; return true;
    }
    __device__ __forceinline__ void a_ready(const Unit&) const {}
    __device__ __forceinline__ void done(const Unit&) const {}
};

__device__ __forceinline__ unsigned cvt_pk_bf16(float lo, float hi) { unsigned r; asm volatile("v_cvt_pk_bf16_f32 %0, %1, %2" : "=v"(r) : "v"(lo), "v"(hi)); return r; }
typedef float f32x2 __attribute__((ext_vector_type(2)));
__device__ __forceinline__ f32x2 gelu_pk(f32x2 v) {
    const f32x2 av = __builtin_elementwise_abs(v), d = av * 0.2316418882f + 1.0f;
    f32x2 t; t.x = __builtin_amdgcn_rcpf(d.x); t.y = __builtin_amdgcn_rcpf(d.y);
    f32x2 q = t * 0.5307027145f + (-0.7265760135f); q = q * t + 0.7107068705f; q = q * t + (-0.142248368f); q = q * t + 0.127414796f; q = q * t;
    const f32x2 s = (v * v) * (-0.72134752044f);
    f32x2 e; e.x = __builtin_amdgcn_exp2f(s.x); e.y = __builtin_amdgcn_exp2f(s.y);
    const f32x2 m = v * (q * e), r = v - m;
    f32x2 o; o.x = v.x < 0.f ? m.x : r.x; o.y = v.y < 0.f ? m.y : r.y; return o;
}
typedef unsigned u32x2 __attribute__((ext_vector_type(2)));
__device__ __forceinline__ float bf_lo(unsigned w) { return __uint_as_float(w << 16); }
__device__ __forceinline__ float bf_hi(unsigned w) { return __uint_as_float(w & 0xffff0000u); }
__device__ __forceinline__ float sigmoid_f(float x) { return __builtin_amdgcn_rcpf(1.0f + __builtin_amdgcn_exp2f(-1.4426950408889634f * x)); }

struct EpiInProj {
    static constexpr bool PERM = true, AFTER_DRAIN = false;
    bf16_t* uv; bf16_t* g1; size_t gstride; const float* bias; float qscale;
    __device__ __forceinline__ void operator()(const f32x4 (&acc)[2][2][4][2], const Unit& u, int wr, int wc, int fr, int fq) const {
        const int t = u.pn >> 2;
        bf16_t* base = (t == 0) ? uv : g1 + (size_t)(t - 1) * gstride;
        const int row0 = u.pm * BM + wr * 64 + fr;
        const int col0 = (u.pn & 3) * BM + wc * 32 + 8 * fq, bcol0 = u.pn * BM + wc * 32 + 8 * fq;
        const float sc = (t == 1) ? qscale : 1.0f;
        f32x4 bv[2][2];
#pragma unroll
        for (int bj = 0; bj < 2; ++bj)
#pragma unroll
            for (int n = 0; n < 2; ++n) bv[bj][n] = *(const f32x4*)(bias + bcol0 + bj * HALF + 4 * n);
#pragma unroll
        for (int ai = 0; ai < 2; ++ai)
#pragma unroll
            for (int m = 0; m < 4; ++m) { bf16_t* rowp = base + (size_t)(row0 + ai * HALF + m * 16) * 1024 + col0;
#pragma unroll
                for (int bj = 0; bj < 2; ++bj) { f32x4 v0 = acc[ai][bj][m][0] + bv[bj][0], v1 = acc[ai][bj][m][1] + bv[bj][1];
                    if (t == 0) { f32x2 a = gelu_pk((f32x2){v0[0], v0[1]}), b = gelu_pk((f32x2){v0[2], v0[3]}), c = gelu_pk((f32x2){v1[0], v1[1]}), d = gelu_pk((f32x2){v1[2], v1[3]});
                        v0 = (f32x4){a.x, a.y, b.x, b.y}; v1 = (f32x4){c.x, c.y, d.x, d.y}; }
                    else if (t >= 4) {
#pragma unroll
                        for (int e = 0; e < 4; ++e) { v0[e] = sigmoid_f(v0[e]); v1[e] = sigmoid_f(v1[e]); } }
                    else { v0 = v0 * sc; v1 = v1 * sc; }
                    u32x4 w; w.x = cvt_pk_bf16(v0[0], v0[1]); w.y = cvt_pk_bf16(v0[2], v0[3]); w.z = cvt_pk_bf16(v1[0], v1[1]); w.w = cvt_pk_bf16(v1[2], v1[3]);
                    *(u32x4*)(rowp + bj * HALF) = w; } }
    }
};

template <int MODE  > struct EpiGateMix {
    static constexpr bool PERM = true, AFTER_DRAIN = false;
    bf16_t* io; const bf16_t* g2;
    __device__ __forceinline__ void operator()(const f32x4 (&acc)[2][2][4][2], const Unit& u, int wr, int wc, int fr, int fq) const {
        const int row0 = u.pm * BM + wr * 64 + fr, col0 = u.pn * BM + wc * 32 + 8 * fq;
#pragma unroll
        for (int ai = 0; ai < 2; ++ai)
#pragma unroll
            for (int m = 0; m < 4; ++m) { const size_t off = (size_t)(row0 + ai * HALF + m * 16) * 1024 + col0;
#pragma unroll
                for (int bj = 0; bj < 2; ++bj) { const f32x4 a0 = acc[ai][bj][m][0], a1 = acc[ai][bj][m][1];
                    const u32x4 x = *(const u32x4*)(io + off + bj * HALF);
                    float r[8];
                    if (MODE == 0) {
                        r[0] = bf_lo(x.x) * a0[0]; r[1] = bf_hi(x.x) * a0[1]; r[2] = bf_lo(x.y) * a0[2]; r[3] = bf_hi(x.y) * a0[3];
                        r[4] = bf_lo(x.z) * a1[0]; r[5] = bf_hi(x.z) * a1[1]; r[6] = bf_lo(x.w) * a1[2]; r[7] = bf_hi(x.w) * a1[3];
                    } else {
                        const u32x4 g = *(const u32x4*)(g2 + off + bj * HALF);
                        r[0] = bf_lo(x.x) + bf_lo(g.x) * a0[0]; r[1] = bf_hi(x.x) + bf_hi(g.x) * a0[1]; r[2] = bf_lo(x.y) + bf_lo(g.y) * a0[2]; r[3] = bf_hi(x.y) + bf_hi(g.y) * a0[3];
                        r[4] = bf_lo(x.z) + bf_lo(g.z) * a1[0]; r[5] = bf_hi(x.z) + bf_hi(g.z) * a1[1]; r[6] = bf_lo(x.w) + bf_lo(g.w) * a1[2]; r[7] = bf_hi(x.w) + bf_hi(g.w) * a1[3];
                    }
                    u32x4 w; w.x = cvt_pk_bf16(r[0], r[1]); w.y = cvt_pk_bf16(r[2], r[3]); w.z = cvt_pk_bf16(r[4], r[5]); w.w = cvt_pk_bf16(r[6], r[7]);
                    *(u32x4*)(io + off + bj * HALF) = w; } }
    }
};

struct EpiResid {
    static constexpr bool PERM = false, AFTER_DRAIN = false;
    const float* x; float* out; float alpha;
    __device__ __forceinline__ void operator()(const f32x4 (&acc)[2][2][4][2], const Unit& u, int wr, int wc, int fr, int fq) const {
        const int row0 = u.pm * BM + wr * 64 + fr, col0 = u.pn * BM + wc * 32 + 4 * fq;
#pragma unroll
        for (int ai = 0; ai < 2; ++ai)
#pragma unroll
            for (int m = 0; m < 4; ++m) { const size_t off = (size_t)(row0 + ai * HALF + m * 16) * 1024 + col0;
#pragma unroll
                for (int bj = 0; bj < 2; ++bj)
#pragma unroll
                    for (int n = 0; n < 2; ++n) { const f32x4 xv = *(const f32x4*)(x + off + bj * HALF + n * 16);
                        *(f32x4*)(out + off + bj * HALF + n * 16) = xv * alpha + acc[ai][bj][m][n]; } }
    }
};

struct EpiGateUp {
    static constexpr bool PERM = true, AFTER_DRAIN = false;
    bf16_t* hb;
    __device__ __forceinline__ void operator()(const f32x4 (&acc)[2][2][4][2], const Unit& u, int wr, int wc, int fr, int fq) const {
        const int row0 = u.pm * BM + wr * 64 + fr, col0 = (u.pn & 3) * HALF + wc * 32 + 8 * fq;
#pragma unroll
        for (int ai = 0; ai < 2; ++ai)
#pragma unroll
            for (int m = 0; m < 4; ++m) { bf16_t* p = hb + (size_t)(row0 + ai * HALF + m * 16) * 512 + col0;
                float r[8];
#pragma unroll
                for (int n = 0; n < 2; ++n)
#pragma unroll
                    for (int e = 0; e < 4; ++e) { const float g = acc[ai][0][m][n][e], up = acc[ai][1][m][n][e]; r[n * 4 + e] = g * sigmoid_f(g) * up; }
                u32x4 w; w.x = cvt_pk_bf16(r[0], r[1]); w.y = cvt_pk_bf16(r[2], r[3]); w.z = cvt_pk_bf16(r[4], r[5]); w.w = cvt_pk_bf16(r[6], r[7]);
                *(u32x4*)p = w; }
    }
};

struct EpiDown {
    static constexpr bool PERM = true, AFTER_DRAIN = false;
    bf16_t* ffn; const int* slot_tok; const float* slot_w; const int* tile_rows;
    __device__ __forceinline__ void operator()(const f32x4 (&acc)[2][2][4][2], const Unit& u, int wr, int wc, int fr, int fq) const {
        const int nvalid = tile_rows[u.pm];
        const int col0 = (u.pn & 3) * BM + wc * 32 + 8 * fq;
#pragma unroll
        for (int ai = 0; ai < 2; ++ai)
#pragma unroll
            for (int m = 0; m < 4; ++m) { const int rl = ai * HALF + wr * 64 + m * 16 + fr;
                if (rl < nvalid) { const int slot = u.pm * BM + rl; const int a = slot_tok[slot]; const float wt = slot_w[slot];
                    bf16_t* p = ffn + (size_t)a * 1024 + col0;
#pragma unroll
                    for (int bj = 0; bj < 2; ++bj) { const f32x4 v0 = acc[ai][bj][m][0] * wt, v1 = acc[ai][bj][m][1] * wt;
                        u32x4 w; w.x = cvt_pk_bf16(v0[0], v0[1]); w.y = cvt_pk_bf16(v0[2], v0[3]); w.z = cvt_pk_bf16(v1[0], v1[1]); w.w = cvt_pk_bf16(v1[2], v1[3]);
                        *(u32x4*)(p + bj * HALF) = w; } } }
    }
};

struct MoeOrder {
    const int* tile_e; int ntiles, G, c;
    __device__ bool next(int i, Unit& u) const {
        const long L = (long)i * G + c; if (L >= (long)ntiles * 4) return false;
        const int rt = (int)(L >> 2), ct = (int)(L & 3);
        u.pm = rt; u.pn = __builtin_amdgcn_readfirstlane(tile_e[rt]) * 4 + ct; return true;
    }
    __device__ __forceinline__ void a_ready(const Unit&) const {}
    __device__ __forceinline__ void done(const Unit&) const {}
};

template <class Epi, class Sched, bool ALIGN_EPI = false, bool SP2 = false>
__device__ __forceinline__ void gemm_phase(PG8_LAS unsigned char* lds, const Gemm g, const Sched& S, const Epi& E) {
    const int tid = threadIdx.x, wid = __builtin_amdgcn_readfirstlane(tid >> 6), lane = tid & 63, wr = wid >> 2, wc = wid & 3, fr = lane & 15, fq = lane >> 4;
    const int K = g.K, nt = K / BK;
    unsigned voffA[2], voffB[2];
#pragma unroll
    for (int i = 0; i < 2; ++i) { int R, C; stage_rc(tid * 16 + i * 8192, R, C); const int Rb = Epi::PERM ? ((R & ~31) + perm32(R & 31)) : R;
        voffA[i] = (unsigned)(R * K + C) * 2u; voffB[i] = (unsigned)(Rb * K + C) * 2u; }
    const size_t kstep = (size_t)(BK * 2);
    const size_t hstep = (size_t)HALF * K * 2;
    const size_t tstep = 2 * hstep;
    const unsigned ldsw = (unsigned)wid * 1024u;
    const int aoff = lds_byte(wr * 64 + fr, fq * 8), boff = lds_byte(wc * 32 + fr, fq * 8);
#define PG8_SA(b, h) (((b) * 2 + (h)) * HTB)
#define PG8_SB(b, h) ((4 + (b) * 2 + (h)) * HTB)
#define PG8_STAGE(bufoff, gbase, voff) do { _Pragma("unroll") for (int _i = 0; _i < 2; ++_i) \
        __builtin_amdgcn_global_load_lds((const unsigned*)((const char*)(gbase) + (voff)[_i]), (PG8_LAS unsigned*)(lds + (bufoff) + ldsw + _i * 8192), 16, 0, 0); } while (0)
#define PG8_LDA(dst, b, h) do { _Pragma("unroll") for (int m = 0; m < 4; ++m) _Pragma("unroll") for (int k = 0; k < 2; ++k) dst[m][k] = *(const PG8_LAS bf16x8*)(lds + PG8_SA(b, h) + aoff + m * 2048 + k * 1024); } while (0)
#define PG8_LDB(dst, b, h) do { _Pragma("unroll") for (int n = 0; n < 2; ++n) _Pragma("unroll") for (int k = 0; k < 2; ++k) dst[n][k] = *(const PG8_LAS bf16x8*)(lds + PG8_SB(b, h) + boff + n * 2048 + k * 1024); } while (0)
#define PG8_MMA(ai, bj, At, Bt) do { __builtin_amdgcn_s_setprio(1); _Pragma("unroll") for (int m = 0; m < 4; ++m) _Pragma("unroll") for (int n = 0; n < 2; ++n) _Pragma("unroll") for (int k = 0; k < 2; ++k) \
        acc[ai][bj][m][n] = __builtin_amdgcn_mfma_f32_16x16x32_bf16(Bt[n][k], At[m][k], acc[ai][bj][m][n], 0, 0, 0); __builtin_amdgcn_s_setprio(0); } while (0)
#define PG8_WAIT_V(n) asm volatile("s_waitcnt vmcnt(" #n ")" ::: "memory")
#define PG8_WAIT_L(n) asm volatile("s_waitcnt lgkmcnt(" #n ")" ::: "memory")
#define PG8_BAR __builtin_amdgcn_s_barrier()
#define PG8_SCHED __builtin_amdgcn_sched_barrier(0)
    Unit cur, nxt; int ui = 0;
    if (!S.next(0, cur)) return;
    f32x4 acc[2][2][4][2];
#pragma unroll
    for (int a = 0; a < 2; ++a)
#pragma unroll
        for (int b = 0; b < 2; ++b)
#pragma unroll
            for (int m = 0; m < 4; ++m)
#pragma unroll
                for (int n = 0; n < 2; ++n) acc[a][b][m][n] = (f32x4){0.f, 0.f, 0.f, 0.f};
    bf16x8 At[4][2], B0[2][2], B1[2][2];
    const char* cA = (const char*)g.A + (size_t)cur.pm * tstep; const char* cB = (const char*)g.Bt + (size_t)cur.pn * tstep;
    S.a_ready(cur);
    if constexpr (SP2) {
        PG8_STAGE(PG8_SB(0, 0), cB, voffB); PG8_STAGE(PG8_SB(0, 1), cB + hstep, voffB); PG8_STAGE(PG8_SA(0, 0), cA, voffA); PG8_STAGE(PG8_SA(0, 1), cA + hstep, voffA);
        if (wr == 1) PG8_BAR;
        PG8_WAIT_V(2); PG8_BAR;
        PG8_STAGE(PG8_SB(1, 0), cB + kstep, voffB); PG8_STAGE(PG8_SA(1, 0), cA + kstep, voffA); PG8_STAGE(PG8_SB(1, 1), cB + hstep + kstep, voffB);
        PG8_WAIT_V(6); PG8_BAR;
    } else {
        PG8_STAGE(PG8_SB(0, 0), cB, voffB); PG8_STAGE(PG8_SA(0, 0), cA, voffA); PG8_STAGE(PG8_SB(0, 1), cB + hstep, voffB); PG8_STAGE(PG8_SA(0, 1), cA + hstep, voffA);
        if (wr == 1) PG8_BAR;
        PG8_WAIT_V(4); PG8_BAR;
        PG8_STAGE(PG8_SB(1, 0), cB + kstep, voffB); PG8_STAGE(PG8_SA(1, 0), cA + kstep, voffA); PG8_STAGE(PG8_SB(1, 1), cB + hstep + kstep, voffB);
        PG8_WAIT_V(6); PG8_BAR;
    }
    for (;;) {
        const bool has_next = S.next(ui + 1, nxt);
        const char* nA = has_next ? (const char*)g.A + (size_t)nxt.pm * tstep : cA; const char* nB = has_next ? (const char*)g.Bt + (size_t)nxt.pn * tstep : cB;
        for (int t = 0; t < nt; t += 2) {
            const bool last = (t == nt - 2);
            const char* a1 = cA + (size_t)(t + 1) * kstep;
            const char* a2 = last ? nA : cA + (size_t)(t + 2) * kstep; const char* b2 = last ? nB : cB + (size_t)(t + 2) * kstep;
            const char* a3 = a2 + kstep; const char* b3 = b2 + kstep;
            if (last && has_next) S.a_ready(nxt);
            if constexpr (SP2) {
            PG8_LDB(B0, 0, 0); PG8_LDB(B1, 0, 1); PG8_SCHED; PG8_LDA(At, 0, 0); PG8_STAGE(PG8_SA(1, 1), a1 + hstep, voffA);
            PG8_WAIT_V(8); PG8_WAIT_L(0); PG8_BAR; PG8_MMA(0, 0, At, B0); PG8_MMA(0, 1, At, B1); PG8_BAR; PG8_SCHED;
            PG8_LDA(At, 0, 1); PG8_STAGE(PG8_SB(0, 0), b2, voffB); PG8_STAGE(PG8_SB(0, 1), b2 + hstep, voffB); PG8_STAGE(PG8_SA(0, 0), a2, voffA);
            PG8_WAIT_V(8); PG8_WAIT_L(0); PG8_BAR; PG8_MMA(1, 0, At, B0); PG8_MMA(1, 1, At, B1); PG8_BAR; PG8_SCHED;
            PG8_LDB(B0, 1, 0); PG8_LDB(B1, 1, 1); PG8_SCHED; PG8_LDA(At, 1, 0); PG8_STAGE(PG8_SA(0, 1), a2 + hstep, voffA);
            PG8_WAIT_V(8); PG8_WAIT_L(0); PG8_BAR; PG8_MMA(0, 0, At, B0); PG8_MMA(0, 1, At, B1); PG8_BAR; PG8_SCHED;
            PG8_LDA(At, 1, 1); PG8_STAGE(PG8_SB(1, 0), b3, voffB); PG8_STAGE(PG8_SB(1, 1), b3 + hstep, voffB); PG8_STAGE(PG8_SA(1, 0), a3, voffA);
            PG8_WAIT_V(8); PG8_WAIT_L(0); PG8_BAR; PG8_MMA(1, 0, At, B0); PG8_MMA(1, 1, At, B1); PG8_BAR; PG8_SCHED;
            } else {
            PG8_LDB(B0, 0, 0); PG8_SCHED; PG8_LDA(At, 0, 0); PG8_STAGE(PG8_SA(1, 1), a1 + hstep, voffA);
            PG8_WAIT_L(8); PG8_BAR; PG8_WAIT_L(0); PG8_MMA(0, 0, At, B0); PG8_BAR; PG8_SCHED;
            PG8_LDB(B1, 0, 1); PG8_STAGE(PG8_SB(0, 0), b2, voffB);
            PG8_BAR; PG8_WAIT_L(0); PG8_MMA(0, 1, At, B1); PG8_BAR;
            PG8_LDA(At, 0, 1); PG8_STAGE(PG8_SA(0, 0), a2, voffA);
            PG8_BAR; PG8_WAIT_L(0); PG8_MMA(1, 0, At, B0); PG8_BAR; PG8_SCHED;
            PG8_STAGE(PG8_SB(0, 1), b2 + hstep, voffB);
            PG8_WAIT_V(6); PG8_BAR; PG8_MMA(1, 1, At, B1); PG8_BAR;
            PG8_LDB(B0, 1, 0); PG8_SCHED; PG8_LDA(At, 1, 0); PG8_STAGE(PG8_SA(0, 1), a2 + hstep, voffA);
            PG8_WAIT_L(8); PG8_BAR; PG8_WAIT_L(0); PG8_MMA(0, 0, At, B0); PG8_BAR; PG8_SCHED;
            PG8_LDB(B1, 1, 1); PG8_STAGE(PG8_SB(1, 0), b3, voffB);
            PG8_BAR; PG8_WAIT_L(0); PG8_MMA(0, 1, At, B1); PG8_BAR;
            PG8_LDA(At, 1, 1); PG8_STAGE(PG8_SA(1, 0), a3, voffA);
            PG8_BAR; PG8_WAIT_L(0); PG8_MMA(1, 0, At, B0); PG8_BAR; PG8_SCHED;
            PG8_STAGE(PG8_SB(1, 1), b3 + hstep, voffB);
            PG8_WAIT_V(6); PG8_BAR; PG8_MMA(1, 1, At, B1); PG8_BAR;
            }
        }
        if constexpr (ALIGN_EPI) { if (wr == 0) PG8_BAR; }
        if constexpr (!Epi::AFTER_DRAIN) { E(acc, cur, wr, wc, fr, fq); S.done(cur); }
        if (!has_next) break;
#pragma unroll
        for (int a = 0; a < 2; ++a)
#pragma unroll
            for (int b = 0; b < 2; ++b)
#pragma unroll
                for (int m = 0; m < 4; ++m)
#pragma unroll
                    for (int n = 0; n < 2; ++n) acc[a][b][m][n] = (f32x4){0.f, 0.f, 0.f, 0.f};
        cur = nxt; cA = nA; cB = nB; ++ui;
        if constexpr (ALIGN_EPI) { if (wr == 1) PG8_BAR; }
    }
    PG8_WAIT_V(0);
    if constexpr (!ALIGN_EPI) { if (wr == 0) PG8_BAR; }
    PG8_BAR;
    if constexpr (Epi::AFTER_DRAIN) { E.fused(acc, cur, wr, wc, fr, fq, lds, wid, lane); S.done(cur); }
#undef PG8_SA
#undef PG8_SB
#undef PG8_STAGE
#undef PG8_LDA
#undef PG8_LDB
#undef PG8_MMA
#undef PG8_WAIT_V
#undef PG8_WAIT_L
#undef PG8_BAR
#undef PG8_SCHED
}
}
namespace att {
using bf16x8 = __attribute__((ext_vector_type(8))) short;
using s16x4  = __attribute__((ext_vector_type(4))) short;
using f32x16 = __attribute__((ext_vector_type(16))) float;
using u32x4  = __attribute__((ext_vector_type(4))) unsigned;
typedef unsigned short bf16;
constexpr int NW = 8, QBLK = 32, KVBLK = 64, LD = 1024, SEQ = 8192;
constexpr int SHM_V = KVBLK * 128 * 2, SHM_K = KVBLK * 128 * 2;
constexpr int LDS_V = 0, LDS_K = 2 * SHM_V, LDS_WS = 2 * SHM_V + 2 * SHM_K, LDS_BYTES = LDS_WS + NW * 64 * 4;
constexpr float THR2 = 11.5f;
#define KSWZ(row, colB) ((row) * 256 + ((colB) ^ (((row) & 7) << 4)))
#define SBAR() __builtin_amdgcn_sched_barrier(0)
__device__ __forceinline__ int crow(int r, int hi) { return (r & 3) + 8 * (r >> 2) + 4 * hi; }
__device__ __forceinline__ unsigned cvtpk(float lo, float hi) { unsigned r; asm volatile("v_cvt_pk_bf16_f32 %0, %1, %2" : "=v"(r) : "v"(lo), "v"(hi)); return r; }

__device__ __forceinline__ void partialSM(f32x16& p0, f32x16& p1, float& m_reg, float& mn, float& alpha) {
  float pmax = p0[0];
#pragma unroll
  for (int r = 1; r < 16; ++r) pmax = fmaxf(pmax, p0[r]);
#pragma unroll
  for (int r = 0; r < 16; ++r) pmax = fmaxf(pmax, p1[r]);
  { auto rr = __builtin_amdgcn_permlane32_swap(__float_as_uint(pmax), __float_as_uint(pmax), false, false);
    pmax = fmaxf(__uint_as_float(rr[0]), __uint_as_float(rr[1])); }
  if (__builtin_expect(__all(pmax - m_reg <= THR2), 1)) { mn = m_reg; alpha = 1.f; }
  else { mn = fmaxf(m_reg, pmax); alpha = __builtin_amdgcn_exp2f(m_reg - mn); m_reg = mn; }
#pragma unroll
  for (int r = 0; r < 16; ++r) p0[r] = p0[r] - mn;
#pragma unroll
  for (int r = 0; r < 16; ++r) p1[r] = p1[r] - mn;
#pragma unroll
  for (int r = 0; r < 16; ++r) p0[r] = __builtin_amdgcn_exp2f(p0[r]);
}
__device__ __forceinline__ void finishSM(f32x16& p0, f32x16& p1, float alpha, float& l_reg, bf16x8& pa0, bf16x8& pa1, bf16x8& pa2, bf16x8& pa3) {
#pragma unroll
  for (int r = 0; r < 16; ++r) p1[r] = __builtin_amdgcn_exp2f(p1[r]);
  float ps = 0;
#pragma unroll
  for (int r = 0; r < 16; ++r) ps += p0[r];
#pragma unroll
  for (int r = 0; r < 16; ++r) ps += p1[r];
  { auto rr = __builtin_amdgcn_permlane32_swap(__float_as_uint(ps), __float_as_uint(ps), false, false);
    ps = __uint_as_float(rr[0]) + __uint_as_float(rr[1]); }
  l_reg = l_reg * alpha + ps;
#define PK4(P, BASE, OUT) do { unsigned a0 = cvtpk(P[BASE + 0], P[BASE + 1]), a1 = cvtpk(P[BASE + 2], P[BASE + 3]);   \
    unsigned b0 = cvtpk(P[BASE + 4], P[BASE + 5]), b1 = cvtpk(P[BASE + 6], P[BASE + 7]);                              \
    auto r0 = __builtin_amdgcn_permlane32_swap(a0, b0, false, false); auto r1 = __builtin_amdgcn_permlane32_swap(a1, b1, false, false); \
    u32x4 w = {r0[0], r1[0], r0[1], r1[1]}; OUT = *reinterpret_cast<bf16x8*>(&w); } while (0)
  PK4(p0, 0, pa0); PK4(p0, 8, pa1); PK4(p1, 0, pa2); PK4(p1, 8, pa3);
#undef PK4
}
__device__ __forceinline__ void qkt(f32x16& p0, f32x16& p1, const char* Ks, const bf16x8* qr, int r32, int hi, int c, float qrel, float nslope2) {
#pragma unroll
  for (int r = 0; r < 16; ++r) { const float kk = (float)((r & 3) + 8 * (r >> 2)); const float q4 = qrel - (float)(4 * hi);
    p0[r] = nslope2 * __builtin_fabsf(q4 - kk); p1[r] = nslope2 * __builtin_fabsf(q4 - kk - 32.0f); }
#pragma unroll
  for (int d0 = 0; d0 < 4; ++d0) { const int cb = (c * 64 + d0 * 16 + hi * 8) * 2;
    const bf16x8 b0 = *reinterpret_cast<const bf16x8*>(Ks + KSWZ(r32, cb));
    const bf16x8 b1 = *reinterpret_cast<const bf16x8*>(Ks + KSWZ(32 + r32, cb));
    p0 = __builtin_amdgcn_mfma_f32_32x32x16_bf16(b0, qr[d0], p0, 0, 0, 0);
    p1 = __builtin_amdgcn_mfma_f32_32x32x16_bf16(b1, qr[d0], p1, 0, 0, 0); }
}
__device__ __forceinline__ int v_st(int k, int c) { const int kk = (k & ~0xC) | ((k & 4) << 1) | ((k & 8) >> 1); return ((kk >> 3) * 4 + (c >> 5)) * 512 + ((kk & 7) * 32 + (c & 31)) * 2; }
__device__ __forceinline__ int v_rd_base(int lane) { return ((lane & 3) << 3) | (((lane >> 2) & 3) << 6) | (((lane >> 4) & 1) << 5) | (((lane >> 5) & 1) << 8); }
constexpr int v_rd_off(int d0, int ks, int half) { return d0 * 512 + ks * 4096 + half * 2048; }
template <int OFF> __device__ __forceinline__ s16x4 tr_read(int vb) {
  s16x4 r; asm volatile("ds_read_b64_tr_b16 %0, %1 offset:%2" : "=&v"(r) : "v"(vb), "i"(OFF) : "memory"); return r;
}
template <int D0> __device__ __forceinline__ void pv_one(f32x16& od, int vb, bf16x8 pa0, bf16x8 pa1, bf16x8 pa2, bf16x8 pa3) {
  const s16x4 l0 = tr_read<v_rd_off(D0, 0, 0)>(vb), h0 = tr_read<v_rd_off(D0, 0, 1)>(vb), l1 = tr_read<v_rd_off(D0, 1, 0)>(vb), h1 = tr_read<v_rd_off(D0, 1, 1)>(vb);
  const s16x4 l2 = tr_read<v_rd_off(D0, 2, 0)>(vb), h2 = tr_read<v_rd_off(D0, 2, 1)>(vb), l3 = tr_read<v_rd_off(D0, 3, 0)>(vb), h3 = tr_read<v_rd_off(D0, 3, 1)>(vb);
  asm volatile("s_waitcnt lgkmcnt(0)" ::: "memory"); SBAR();
#define PK(L, H) (bf16x8){L[0], L[1], L[2], L[3], H[0], H[1], H[2], H[3]}
  od = __builtin_amdgcn_mfma_f32_32x32x16_bf16(pa0, PK(l0, h0), od, 0, 0, 0);
  od = __builtin_amdgcn_mfma_f32_32x32x16_bf16(pa1, PK(l1, h1), od, 0, 0, 0);
  od = __builtin_amdgcn_mfma_f32_32x32x16_bf16(pa2, PK(l2, h2), od, 0, 0, 0);
  od = __builtin_amdgcn_mfma_f32_32x32x16_bf16(pa3, PK(l3, h3), od, 0, 0, 0);
#undef PK
}
__device__ __forceinline__ void pv_d0(f32x16* o, int vb, bf16x8 pa0, bf16x8 pa1, bf16x8 pa2, bf16x8 pa3) {
  pv_one<0>(o[0], vb, pa0, pa1, pa2, pa3); pv_one<1>(o[1], vb, pa0, pa1, pa2, pa3); pv_one<2>(o[2], vb, pa0, pa1, pa2, pa3); pv_one<3>(o[3], vb, pa0, pa1, pa2, pa3);
}

__device__ __forceinline__ void attn_unit(const bf16* Qb, const bf16* __restrict__ Kh, const bf16* __restrict__ Vh, bf16* Ob, int i, float nslope2, float lam, const float* __restrict__ subln_g, char* lds) {
  const int tid = threadIdx.x, wid = __builtin_amdgcn_readfirstlane(tid >> 6), lane = tid & 63, r32 = lane & 31, hi = lane >> 5;
  const int c = wid & 1, rb = wid >> 1;
  char* V_lds = lds + LDS_V; char* K_lds = lds + LDS_K;
  float* ws = (float*)(lds + LDS_WS) + wid * 64; float* li_l = ws; float* al_l = ws + 32;
  float m_reg = -1e30f, l_reg = 0; f32x16 o[4] = {}; bf16x8 qr[4];
  const bf16* Qw = Qb + (long)(rb * QBLK + r32) * LD + c * 64 + hi * 8;
#pragma unroll
  for (int d0 = 0; d0 < 4; ++d0) qr[d0] = *reinterpret_cast<const bf16x8*>(Qw + d0 * 16);
  const int sr = tid >> 4, sc = (tid & 15) * 8, vst0 = v_st(sr, sc), vst1 = v_st(32 + sr, sc);
  const int vb0 = (int)(uintptr_t)V_lds + v_rd_base(lane);
  struct { bf16x8 vs0, vs1, ks0, ks1; } sr_[2];
  const __amdgpu_buffer_rsrc_t krs = __builtin_amdgcn_make_buffer_rsrc((void*)Kh, 0, SEQ * LD * 2, 0x00020000), vrs = __builtin_amdgcn_make_buffer_rsrc((void*)Vh, 0, SEQ * LD * 2, 0x00020000);
  const int soffb = (sr * LD + sc) * 2;
#define BLD(rs, so) __builtin_bit_cast(bf16x8, __builtin_amdgcn_raw_buffer_load_b128(rs, soffb, (so), 0))
#define SLOAD(ix, k0) do { sr_[ix].vs0 = BLD(vrs, (k0) * (LD * 2)); sr_[ix].vs1 = BLD(vrs, ((k0) + 32) * (LD * 2)); \
    sr_[ix].ks0 = BLD(krs, (k0) * (LD * 2)); sr_[ix].ks1 = BLD(krs, ((k0) + 32) * (LD * 2)); } while (0)
#define SWRITE(b, ix) do { *(bf16x8*)(V_lds + (b) * SHM_V + vst0) = sr_[ix].vs0;          \
    *(bf16x8*)(V_lds + (b) * SHM_V + vst1) = sr_[ix].vs1; const int kc = sc * 2;               \
    *(bf16x8*)(K_lds + (b) * SHM_K + KSWZ(sr, kc)) = sr_[ix].ks0;                       \
    *(bf16x8*)(K_lds + (b) * SHM_K + KSWZ(32 + sr, kc)) = sr_[ix].ks1; } while (0)
#define SWAIT() asm volatile("s_waitcnt vmcnt(4)" ::: "memory")
#define RESC(a) do { if (__any((a) < 1.f)) { if (hi == 0) al_l[r32] = (a); asm volatile("s_waitcnt lgkmcnt(0)" ::: "memory"); \
    _Pragma("unroll") for (int d = 0; d < 4; ++d) _Pragma("unroll") for (int r = 0; r < 16; ++r) o[d][r] *= al_l[crow(r, hi)]; } } while (0)
  f32x16 pA0, pA1, pB0, pB1; float mnA, mnB, alA, alB; bf16x8 pa0, pa1, pa2, pa3;
  const int NT = 2 * i + 2;
  const bool skiplast = rb < 2;
  const float qpos = (float)(128 * i + rb * QBLK + r32);
#define QREL(t) (qpos - (float)(64 * (t)))
  constexpr int SE = 0, SO = 1;
  SLOAD(SE, 0); asm volatile("s_waitcnt vmcnt(0)" ::: "memory"); SWRITE(0, SE); __syncthreads();
  qkt(pA0, pA1, K_lds, qr, r32, hi, c, QREL(0), nslope2); partialSM(pA0, pA1, m_reg, mnA, alA);
  SLOAD(SO, KVBLK); if (2 < NT) SLOAD(SE, 2 * KVBLK);
  SWAIT(); SWRITE(1, SO); __syncthreads();
  for (int j = 1; j + 1 < NT; j += 2) {
    SBAR(); qkt(pB0, pB1, K_lds + SHM_K, qr, r32, hi, c, QREL(j), nslope2);
    finishSM(pA0, pA1, alA, l_reg, pa0, pa1, pa2, pa3); SBAR();
    SLOAD(SO, (j + 2) * KVBLK); SBAR();
    pv_d0(o, vb0, pa0, pa1, pa2, pa3); partialSM(pB0, pB1, m_reg, mnB, alB);
    __syncthreads(); SWAIT(); SWRITE(0, SE);
    RESC(alB); __syncthreads();
    SBAR(); qkt(pA0, pA1, K_lds, qr, r32, hi, c, QREL(j + 1), nslope2);
    finishSM(pB0, pB1, alB, l_reg, pa0, pa1, pa2, pa3); SBAR();
    if (j + 3 < NT) SLOAD(SE, (j + 3) * KVBLK); SBAR();
    pv_d0(o, vb0 + SHM_V, pa0, pa1, pa2, pa3); partialSM(pA0, pA1, m_reg, mnA, alA);
    __syncthreads(); SWAIT(); SWRITE(1, SO);
    RESC(alA); __syncthreads();
  }
  SBAR(); if (!skiplast) qkt(pB0, pB1, K_lds + SHM_K, qr, r32, hi, c, QREL(NT - 1), nslope2);
  finishSM(pA0, pA1, alA, l_reg, pa0, pa1, pa2, pa3); SBAR();
  pv_d0(o, vb0, pa0, pa1, pa2, pa3);
  if (!skiplast) partialSM(pB0, pB1, m_reg, mnB, alB);
  __syncthreads();
  if (!skiplast) { RESC(alB);
    finishSM(pB0, pB1, alB, l_reg, pa0, pa1, pa2, pa3); SBAR();
    pv_d0(o, vb0 + SHM_V, pa0, pa1, pa2, pa3); }
  if (hi == 0) li_l[r32] = l_reg; asm volatile("s_waitcnt lgkmcnt(0)" ::: "memory");
  const float sgn = c ? lam : 1.0f;
#pragma unroll
  for (int r = 0; r < 16; ++r) { const float rl = __builtin_amdgcn_rcpf(li_l[crow(r, hi)]) * sgn;
#pragma unroll
    for (int d0 = 0; d0 < 4; ++d0) o[d0][r] *= rl; }
  __syncthreads();
  float* ex = (float*)lds + (size_t)rb * (4 * 16 * 64);
  if (c == 1) {
#pragma unroll
    for (int d0 = 0; d0 < 4; ++d0)
#pragma unroll
      for (int r = 0; r < 16; ++r) ex[(d0 * 16 + r) * 64 + lane] = o[d0][r];
  }
  __syncthreads();
  if (c == 0) {
    float ss[16];
#pragma unroll
    for (int r = 0; r < 16; ++r) { float s = 0.f;
#pragma unroll
      for (int d0 = 0; d0 < 4; ++d0) { const float v = o[d0][r] - ex[(d0 * 16 + r) * 64 + lane]; o[d0][r] = v; s += v * v; }
      ss[r] = s; }
#pragma unroll
    for (int off = 1; off < 32; off <<= 1)
#pragma unroll
      for (int r = 0; r < 16; ++r) ss[r] += __shfl_xor(ss[r], off);
    float gsc[4];
#pragma unroll
    for (int d0 = 0; d0 < 4; ++d0) gsc[d0] = subln_g[d0 * 32 + r32] * 0.8f;
    bf16* Ow = Ob + (long)(rb * QBLK) * LD;
#pragma unroll
    for (int r = 0; r < 16; ++r) { const float rs = __builtin_amdgcn_rsqf(ss[r] * (1.0f / 128.0f) + 1e-5f); const int orow = crow(r, hi);
#pragma unroll
      for (int d0 = 0; d0 < 4; ++d0) { const float v = o[d0][r] * rs * gsc[d0]; const unsigned w = cvtpk(v, v); Ow[(long)orow * LD + d0 * 32 + r32] = (bf16)(w & 0xffffu); } }
  }
  __syncthreads();
#undef SLOAD
#undef BLD
#undef SWRITE
#undef SWAIT
#undef RESC
#undef QREL
}
#undef KSWZ
#undef SBAR
}

#define GAS __attribute__((address_space(1)))
#define LAS __attribute__((address_space(3)))
typedef unsigned short bf16;
typedef unsigned v4u __attribute__((ext_vector_type(4)));
typedef float f32x4 __attribute__((ext_vector_type(4)));
typedef short bf16x8 __attribute__((ext_vector_type(8)));
typedef GAS unsigned gu32;
typedef GAS unsigned long long gu64;
#define RLX_AGENT __ATOMIC_RELAXED, __HIP_MEMORY_SCOPE_AGENT
#define LDS_WAIT() asm volatile("s_waitcnt lgkmcnt(0)" ::: "memory")
#define VM_WAIT() asm volatile("s_waitcnt vmcnt(0)" ::: "memory")
__device__ __forceinline__ unsigned long long rt() { return __builtin_amdgcn_s_memrealtime(); }
__device__ __forceinline__ unsigned f2bf(float f) { unsigned u = __builtin_bit_cast(unsigned, f); return (u + 0x7fffu + ((u >> 16) & 1u)) >> 16; }
__device__ __forceinline__ unsigned pk2(float lo, float hi) { return f2bf(lo) | (f2bf(hi) << 16); }

#define XB_TMO      128
#define XB_XCNT(j)  (256  + 64 * (j))
#define XB_XSUB(j)  (1280 + 64 * (j))
#define XB_XGEN(j)  (2304 + 64 * (j))
#define XB_TOP      3328
#define XB_TOPGEN   3392
#define XCD_BAR_WORDS 3456
#define XB_SPIN_CAP (1u << 18)

__device__ __forceinline__ unsigned xb_ld(unsigned* p)              { return __hip_atomic_load(p, __ATOMIC_RELAXED, __HIP_MEMORY_SCOPE_AGENT); }
__device__ __forceinline__ unsigned xb_add(unsigned* p, unsigned v) { return __hip_atomic_fetch_add(p, v, __ATOMIC_RELAXED, __HIP_MEMORY_SCOPE_AGENT); }
__device__ __forceinline__ unsigned xb_xcc_id() { return (unsigned)__builtin_amdgcn_s_getreg((3 << 11) | 20) & 0xFu; }
#define XB_SPIN(cond, bar) do { unsigned _sp = 0; while (cond) { __builtin_amdgcn_s_sleep(1); \
    if ((++_sp & 255u) == 0u) { if (xb_ld(&(bar)[XB_TMO])) break; if (_sp > XB_SPIN_CAP) { atomicAdd(&(bar)[XB_TMO], 1u); break; } } } } while (0)

struct XcdBarrier {
    unsigned* bar; unsigned x;
    volatile LAS unsigned* st;
};

__device__ __forceinline__ XcdBarrier xcd_barrier_post(unsigned* bar, volatile LAS unsigned* st) {
    XcdBarrier b; b.bar = bar; b.x = xb_xcc_id(); b.st = st;
    if (threadIdx.x == 0) (void)xb_add(&bar[XB_XCNT(b.x)], 1u);
    return b;
}
__device__ __forceinline__ void xcd_barrier_complete(unsigned* bar, unsigned x, unsigned& nloc, unsigned& nx) {
    const unsigned G = gridDim.x * gridDim.y * gridDim.z;
    unsigned sum, cnt, mine, sp = 0u;
    for (;;) {
        sum = 0u; cnt = 0u; mine = 0u;
#pragma unroll
        for (unsigned j = 0; j < 16; ++j) { const unsigned c = xb_ld(&bar[XB_XCNT(j)]); sum += c; cnt += (c > 0u) ? 1u : 0u; mine = (j == x) ? c : mine; }
        if (sum == G) break;
        __builtin_amdgcn_s_sleep(1);
        if ((++sp & 255u) == 0u) { if (xb_ld(&bar[XB_TMO])) break; if (sp > XB_SPIN_CAP) { atomicAdd(&bar[XB_TMO], 1u); break; } }
    }
    nloc = mine > 0u ? mine : 1u; nx = cnt > 0u ? cnt : 1u;
}

__device__ __forceinline__ void xcd_barrier(const XcdBarrier& b) {
    asm volatile("s_waitcnt vmcnt(0)" ::: "memory");
    __syncthreads();
    if (threadIdx.x == 0) {
        unsigned* bar = b.bar;
        __builtin_amdgcn_s_waitcnt(0);
        unsigned nloc = b.st[0], nx = b.st[1];
        if (nloc == 0u) { xcd_barrier_complete(bar, b.x, nloc, nx); b.st[0] = nloc; b.st[1] = nx; }
        const unsigned old = xb_add(&bar[XB_XSUB(b.x)], 1u);
        const unsigned gen = old / nloc;
        if (old + 1u == (gen + 1u) * nloc) {
            __builtin_amdgcn_fence(__ATOMIC_RELEASE, "agent");
            asm volatile("s_waitcnt vmcnt(0)" ::: "memory");
            const unsigned og = xb_add(&bar[XB_TOP], 1u);
            const unsigned tg = og / nx;
            if (og + 1u == (tg + 1u) * nx) xb_add(&bar[XB_TOPGEN], 1u);
            else XB_SPIN(xb_ld(&bar[XB_TOPGEN]) == tg, bar);
            __builtin_amdgcn_fence(__ATOMIC_ACQUIRE, "agent");
            xb_add(&bar[XB_XGEN(b.x)], 1u);
            asm volatile("s_waitcnt vmcnt(0)" ::: "memory");
        } else {
            XB_SPIN(xb_ld(&bar[XB_XGEN(b.x)]) == gen, bar);
            __builtin_amdgcn_fence(__ATOMIC_ACQUIRE, "agent");
            asm volatile("s_waitcnt vmcnt(0)" ::: "memory");
        }
    }
    __syncthreads();
}

typedef unsigned v2u __attribute__((ext_vector_type(2)));

constexpr int NWAVES = 8, NTHREADS = NWAVES * 64;
constexpr int BATCH = 8, SEQ = 8192, D = 1024, T = BATCH * SEQ;
constexpr int INW = 6144, GW = 512, NHEAD = 8;
constexpr int NEXP = 32, EHID = 512, NASSIGN = T * 2;
constexpr int MAXTILES = (NASSIGN + NEXP * 255) / 256 + 1;
constexpr float LN_EPS = 1e-5f;
constexpr float ALPHA = 1.189207115002721f;
constexpr float C2 = 0.125f * 1.4426950408889634f;
constexpr int NPHASE = 12;
#ifndef MK_ONE_LAUNCH
#define MK_ONE_LAUNCH 0
#endif

constexpr size_t MiB = 1u << 20;
constexpr size_t WS_CTL = 0, CTL_ZERO_BYTES = 64 * 1024;
constexpr size_t WS_ROUTE_E = 1 * MiB;
constexpr size_t WS_ROUTE_W = WS_ROUTE_E + (size_t)NASSIGN * 4;
constexpr size_t WS_SLOT_TOK = WS_ROUTE_W + (size_t)NASSIGN * 4;
constexpr size_t WS_SLOT_W = WS_SLOT_TOK + (size_t)MAXTILES * 256 * 4;
constexpr size_t WS_TILE_E = WS_SLOT_W + (size_t)MAXTILES * 256 * 4;
constexpr size_t WS_TILE_ROWS = WS_TILE_E + 4096;
constexpr size_t WS_MISC_END = WS_TILE_ROWS + 4096;
static_assert(WS_MISC_END <= 4 * MiB, "misc tables");
constexpr size_t WS_WIN = 4 * MiB;
constexpr size_t WS_WA = 16 * MiB;
constexpr size_t WS_WB = 17 * MiB;
constexpr size_t WS_WO = 19 * MiB;
constexpr size_t WS_SGW = 21 * MiB;
constexpr size_t WS_WGU = 22 * MiB;
constexpr size_t WS_WD = 86 * MiB;
constexpr size_t WS_XB = 128 * MiB;
constexpr size_t WS_Q = 256 * MiB;
constexpr size_t WS_K = 384 * MiB, WS_VAL = 512 * MiB, WS_GA = 640 * MiB, WS_GB = 768 * MiB;
constexpr size_t WS_XS = 256 * MiB;
constexpr size_t WS_HB = 528 * MiB;
constexpr size_t WS_FFN = 664 * MiB;
constexpr size_t WS_END = 920 * MiB;
static_assert(WS_XS + (size_t)MAXTILES * 256 * 1024 * 2 <= WS_HB && WS_HB + (size_t)MAXTILES * 256 * 512 * 2 <= WS_FFN && WS_FFN + (size_t)NASSIGN * 1024 * 2 <= WS_END, "moe buffers");
constexpr size_t OUT_UV = 0, OUT_SG = 128 * MiB;
constexpr int CW_BAR = 1024;
constexpr int CW_CNT = 8192;
constexpr int CW_CUR = 8192 + 64;
static_assert((CW_BAR + 3456) <= CW_CNT && (CW_CUR + 64) * 4 <= (int)CTL_ZERO_BYTES, "ctl map");

constexpr int RING_OFF = 0, RING_BYTES = 131072;
constexpr int LDSCTL_OFF = RING_BYTES, MISC_OFF = LDSCTL_OFF + 320;
constexpr int LDS_BYTES = 147456;
static_assert(MISC_OFF + 128 <= LDS_BYTES, "LDS map");

__device__ __forceinline__ float wave_sum(float v) {
#pragma unroll
    for (int o = 1; o < 64; o <<= 1) v += __shfl_xor(v, o);
    return v;
}

__device__ __forceinline__ void p0_transpose_item(const float* W, int K, int N, bf16* WT, int row_off, LAS float* scr, int item, int lane) {
    const int nblk = N / 32, kb = item / nblk, nb = item % nblk, k0 = 64 * kb, n0 = 32 * nb;
#pragma unroll 8
    for (int i = 0; i < 32; ++i) { const int kk = 2 * i + (lane >> 5); scr[kk * 33 + (lane & 31)] = W[(size_t)(k0 + kk) * N + n0 + (lane & 31)]; }
    LDS_WAIT(); asm volatile("" ::: "memory");
    const int c = lane & 7;
#pragma unroll
    for (int j = 0; j < 4; ++j) { const int n = (lane >> 3) + 8 * j; const LAS float* s = scr + (8 * c) * 33 + n;
        v4u o; o.x = pk2(s[0 * 33], s[1 * 33]); o.y = pk2(s[2 * 33], s[3 * 33]); o.z = pk2(s[4 * 33], s[5 * 33]); o.w = pk2(s[6 * 33], s[7 * 33]);
        *(GAS v4u*)(WT + (size_t)(row_off + n0 + n) * K + k0 + 8 * c) = o; }
    LDS_WAIT(); asm volatile("" ::: "memory");
}
struct P0Args { const float *x, *w_in, *w_a, *w_b, *w_out, *sg_w, *w_gate, *w_up, *w_down; bf16 *win_t, *wa_t, *wb_t, *wo_t, *sgw, *wgu_t, *wd_t, *xb; };
__device__ __forceinline__ void p0_prologue(const P0Args& a, LAS unsigned char* lds, int gw, int NGW, int wave, int lane) {
    LAS float* scr = (LAS float*)(lds + RING_OFF + wave * 16384);
    constexpr int I_IN = (D / 64) * (INW / 32), I_A = (GW / 64) * (D / 32), I_B = (D / 64) * (D / 32), I_O = I_B;
    constexpr int I_G1 = (D / 64) * (EHID / 32), I_G = NEXP * I_G1, I_D1 = (EHID / 64) * (D / 32), I_DN = NEXP * I_D1;
    constexpr int NITEMS = I_IN + I_A + I_B + I_O + 2 * I_G + I_DN;
    for (int it = gw; it < NITEMS; it += NGW) {
        int r = it;
        if (r < I_IN) { p0_transpose_item(a.w_in, D, INW, a.win_t, 0, scr, r, lane); continue; } r -= I_IN;
        if (r < I_A) { p0_transpose_item(a.w_a, GW, D, a.wa_t, 0, scr, r, lane); continue; } r -= I_A;
        if (r < I_B) { p0_transpose_item(a.w_b, D, D, a.wb_t, 0, scr, r, lane); continue; } r -= I_B;
        if (r < I_O) { p0_transpose_item(a.w_out, D, D, a.wo_t, 0, scr, r, lane); continue; } r -= I_O;
        if (r < 2 * I_G) {
            const int which = r >= I_G; if (which) r -= I_G;
            const int e = r / I_G1, item = r % I_G1, nb = item % (EHID / 32), n0 = nb * 32, ct = n0 >> 7;
            const int row_off = e * 1024 + ct * 128 + which * 128;
            p0_transpose_item((which ? a.w_up : a.w_gate) + (size_t)e * D * EHID, D, EHID, a.wgu_t, row_off, scr, item, lane); continue; }
        r -= 2 * I_G;
        { const int e = r / I_D1, item = r % I_D1; p0_transpose_item(a.w_down + (size_t)e * EHID * D, EHID, D, a.wd_t, e * 1024, scr, item, lane); }
    }
    for (int idx = gw * 64 + lane; idx < 8 * 128 * 128; idx += NGW * 64) { const int s = idx & 127, t = (idx >> 7) & 127; const float w = a.sg_w[idx]; a.sgw[idx] = (bf16)f2bf(((t >> 6) >= (s >> 6)) ? w : 0.f); }
    const size_t n8 = (size_t)T * D / 8;
    for (size_t idx = (size_t)gw * 64 + lane; idx < n8; idx += (size_t)NGW * 64) { const f32x4 v0 = *(const GAS f32x4*)(a.x + idx * 8), v1 = *(const GAS f32x4*)(a.x + idx * 8 + 4);
        v4u o; o.x = pk2(v0.x, v0.y); o.y = pk2(v0.z, v0.w); o.z = pk2(v1.x, v1.y); o.w = pk2(v1.z, v1.w); *(GAS v4u*)(a.xb + idx * 8) = o; }
}

constexpr int P2_PITCH = 136;
__device__ __forceinline__ void p2_gmlp(const bf16* UV, bf16* SG, const bf16* SGW, const float* ln_g, const float* ln_b, const float* sg_b, LAS unsigned char* lds, int G) {
    typedef float f32x2v __attribute__((ext_vector_type(2)));
    LAS bf16* vnT = (LAS bf16*)lds;
    LAS f32x2v* red = (LAS f32x2v*)(lds + 256 * P2_PITCH * 2);
    const int tid = threadIdx.x, lane = tid & 63, wave = __builtin_amdgcn_readfirstlane(tid >> 6), fr = lane & 15, fq = lane >> 4;
    for (int unit = blockIdx.x; unit < 1024; unit += G) {
        const int blk = unit >> 1, half = unit & 1, row0 = blk * 128;
        const int s = tid & 127, cg = __builtin_amdgcn_readfirstlane(tid >> 7);
        const bf16* vrow = UV + (size_t)(row0 + s) * 1024 + 512;
        float s1 = 0.f, s2 = 0.f;
#pragma unroll
        for (int q = 0; q < 16; ++q) { const v4u w = *(const GAS v4u*)(vrow + cg * 128 + q * 8);
#pragma unroll
            for (int e = 0; e < 4; ++e) { const float a = __uint_as_float(w[e] << 16), b = __uint_as_float(w[e] & 0xffff0000u); s1 += a + b; s2 += a * a + b * b; } }
        red[cg * 128 + s] = (f32x2v){s1, s2};
        __syncthreads();
        float t1 = 0.f, t2 = 0.f;
#pragma unroll
        for (int k = 0; k < 4; ++k) { const f32x2v p = red[k * 128 + s]; t1 += p.x; t2 += p.y; }
        const float mean = t1 * (1.f / 512.f), var = fmaxf(t2 * (1.f / 512.f) - mean * mean, 0.f), rstd = 1.0f / sqrtf(var + LN_EPS);
        const int g = half * 4 + cg;
#pragma unroll
        for (int q = 0; q < 8; ++q) { const v4u w = *(const GAS v4u*)(vrow + g * 64 + q * 8);
#pragma unroll
            for (int e = 0; e < 4; ++e) { const int c0 = q * 8 + 2 * e;
                const float a = (__uint_as_float(w[e] << 16) - mean) * rstd * ln_g[g * 64 + c0] + ln_b[g * 64 + c0];
                const float b = (__uint_as_float(w[e] & 0xffff0000u) - mean) * rstd * ln_g[g * 64 + c0 + 1] + ln_b[g * 64 + c0 + 1];
                vnT[(cg * 64 + c0) * P2_PITCH + s] = (bf16)f2bf(a); vnT[(cg * 64 + c0 + 1) * P2_PITCH + s] = (bf16)f2bf(b); } }
        __syncthreads();
        const int gl = wave >> 1, th = wave & 1, gg = half * 4 + gl;
        f32x4 acc[4][4];
#pragma unroll
        for (int a = 0; a < 4; ++a)
#pragma unroll
            for (int b = 0; b < 4; ++b) acc[a][b] = (f32x4){0.f, 0.f, 0.f, 0.f};
        const int nks = th ? 4 : 2;
        for (int ks = 0; ks < nks; ++ks) {
            bf16x8 wf[4], vf[4];
#pragma unroll
            for (int tt = 0; tt < 4; ++tt) wf[tt] = *(const GAS bf16x8*)(SGW + ((size_t)(gg * 128 + th * 64 + tt * 16 + fr) * 128 + ks * 32 + fq * 8));
#pragma unroll
            for (int ct = 0; ct < 4; ++ct) vf[ct] = *(const LAS bf16x8*)(vnT + (gl * 64 + ct * 16 + fr) * P2_PITCH + ks * 32 + fq * 8);
#pragma unroll
            for (int tt = 0; tt < 4; ++tt)
#pragma unroll
                for (int ct = 0; ct < 4; ++ct) acc[tt][ct] = __builtin_amdgcn_mfma_f32_16x16x32_bf16(vf[ct], wf[tt], acc[tt][ct], 0, 0, 0);
        }
#pragma unroll
        for (int tt = 0; tt < 4; ++tt) { const int t = th * 64 + tt * 16 + fr; const float bs = sg_b[gg * 128 + t];
#pragma unroll
            for (int ct = 0; ct < 4; ++ct) { const int c0 = gg * 64 + ct * 16 + 4 * fq;
                const v2u uw = *(const GAS v2u*)(UV + (size_t)(row0 + t) * 1024 + c0);
                const f32x4 a = acc[tt][ct];
                const float r0 = __uint_as_float(uw.x << 16) * (a[0] + bs), r1 = __uint_as_float(uw.x & 0xffff0000u) * (a[1] + bs);
                const float r2 = __uint_as_float(uw.y << 16) * (a[2] + bs), r3 = __uint_as_float(uw.y & 0xffff0000u) * (a[3] + bs);
                v2u o; o.x = pk2(r0, r1); o.y = pk2(r2, r3);
                *(GAS v2u*)(SG + (size_t)(row0 + t) * 512 + c0) = o; } }
        __syncthreads();
    }
}

constexpr int P7_WPITCH = 52;
__device__ __forceinline__ void p7_ln_route(float* H, bf16* H1B, const float* ln_g, const float* ln_b, const float* w_group, const float* b_group, const float* w_expert, const float* b_expert,
                                            int* route_e, float* route_w, unsigned* cnt, LAS unsigned char* lds, int G) {
    LAS float* WL = (LAS float*)lds;
    LAS float* LG = (LAS float*)(lds + 256 * P7_WPITCH * 4);
    LAS unsigned* hist = (LAS unsigned*)(lds + 256 * P7_WPITCH * 4 + 8 * 16 * 48 * 4);
    const int tid = threadIdx.x, lane = tid & 63, wave = __builtin_amdgcn_readfirstlane(tid >> 6), li = lane & 15, kq = lane >> 4;
    if (tid < 32) hist[tid] = 0u;
    __syncthreads();
    for (int rd = blockIdx.x; rd < T / 128; rd += G) {
        const int R0 = rd * 128 + wave * 16;
        float* hrow = H + (size_t)(R0 + li) * D + 4 * kq;
        float s1 = 0.f, s2 = 0.f;
#pragma unroll 8
        for (int j = 0; j < 64; ++j) { const f32x4 v = *(const GAS f32x4*)(hrow + 16 * j); s1 += (v.x + v.y) + (v.z + v.w); s2 += (v.x * v.x + v.y * v.y) + (v.z * v.z + v.w * v.w); }
        s1 += __shfl_xor(s1, 16); s1 += __shfl_xor(s1, 32); s2 += __shfl_xor(s2, 16); s2 += __shfl_xor(s2, 32);
        const float mean = s1 * (1.f / D), var = fmaxf(s2 * (1.f / D) - mean * mean, 0.f), rstd = 1.0f / sqrtf(var + LN_EPS);
        f32x4 acc[3];
#pragma unroll
        for (int n = 0; n < 3; ++n) acc[n] = (f32x4){0.f, 0.f, 0.f, 0.f};
        for (int ch = 0; ch < 4; ++ch) {
            __syncthreads();
            for (int idx = tid; idx < 256 * 48; idx += NTHREADS) { const int kl = idx / 48, n = idx % 48, k = ch * 256 + kl;
                float w = 0.f; if (n < 4) w = w_group[k * 4 + n]; else if (n < 36) w = w_expert[k * 32 + (n - 4)];
                WL[kl * P7_WPITCH + n] = w; }
            __syncthreads();
#pragma unroll 2
            for (int jj = 0; jj < 16; ++jj) { const int j = ch * 16 + jj; const int col = 16 * j + 4 * kq;
                const f32x4 v = *(const GAS f32x4*)(hrow + 16 * j); const f32x4 gv = *(const GAS f32x4*)(ln_g + col), bv = *(const GAS f32x4*)(ln_b + col);
                f32x4 h; h.x = (v.x - mean) * rstd * gv.x + bv.x; h.y = (v.y - mean) * rstd * gv.y + bv.y; h.z = (v.z - mean) * rstd * gv.z + bv.z; h.w = (v.w - mean) * rstd * gv.w + bv.w;
                *(GAS f32x4*)(hrow + 16 * j) = h;
                v2u o; o.x = pk2(h.x, h.y); o.y = pk2(h.z, h.w); *(GAS v2u*)(H1B + (size_t)(R0 + li) * D + col) = o;
#pragma unroll
                for (int e = 0; e < 4; ++e) { const LAS float* wl = WL + (16 * jj + 4 * kq + e) * P7_WPITCH + li;
#pragma unroll
                    for (int n = 0; n < 3; ++n) acc[n] = __builtin_amdgcn_mfma_f32_16x16x4f32(h[e], wl[16 * n], acc[n], 0, 0, 0); } }
        }
        LAS float* lg = LG + wave * 16 * 48;
#pragma unroll
        for (int n = 0; n < 3; ++n)
#pragma unroll
            for (int r = 0; r < 4; ++r) lg[(4 * kq + r) * 48 + 16 * n + li] = acc[n][r];
        LDS_WAIT(); asm volatile("" ::: "memory");
        if (lane < 16) {
            const LAS float* l = lg + lane * 48; const int tok = R0 + lane;
            float gl[4]; int gs = 0; float gm;
#pragma unroll
            for (int q = 0; q < 4; ++q) gl[q] = l[q] + b_group[q];
            gm = gl[0];
#pragma unroll
            for (int q = 1; q < 4; ++q) if (gl[q] > gm) { gm = gl[q]; gs = q; }
            float den = 0.f;
#pragma unroll
            for (int q = 0; q < 4; ++q) den += __expf(gl[q] - gm);
            const float gwt = 1.0f / den;
            float ev[8];
#pragma unroll
            for (int q = 0; q < 8; ++q) ev[q] = l[4 + gs * 8 + q] + b_expert[gs * 8 + q];
            int i0 = 0; float v0 = ev[0];
#pragma unroll
            for (int q = 1; q < 8; ++q) if (ev[q] > v0) { v0 = ev[q]; i0 = q; }
            int i1 = -1; float v1 = -3.0e38f;
#pragma unroll
            for (int q = 0; q < 8; ++q) if (q != i0 && ev[q] > v1) { v1 = ev[q]; i1 = q; }
            const float ex = __expf(v1 - v0), p0 = 1.0f / (1.0f + ex), p1 = ex * p0;
            const int e0 = gs * 8 + i0, e1 = gs * 8 + i1;
            route_e[tok * 2] = e0; route_e[tok * 2 + 1] = e1; route_w[tok * 2] = p0 * gwt; route_w[tok * 2 + 1] = p1 * gwt;
            __hip_atomic_fetch_add(&hist[e0], 1u, __ATOMIC_RELAXED, __HIP_MEMORY_SCOPE_WORKGROUP); __hip_atomic_fetch_add(&hist[e1], 1u, __ATOMIC_RELAXED, __HIP_MEMORY_SCOPE_WORKGROUP);
        }
    }
    __syncthreads();
    if (tid < 32) { const unsigned h = hist[tid]; if (h) __hip_atomic_fetch_add(cnt + tid, h, RLX_AGENT); }
}

__device__ __forceinline__ void p8_dispatch(const bf16* H1B, bf16* XS, const int* route_e, const float* route_w, unsigned* cnt, unsigned* cur, int* slot_tok, float* slot_w, int* tile_e, int* tile_rows,
                                            LAS unsigned char* lds, int G) {
    LAS int* pad_start = (LAS int*)lds;
    LAS unsigned* lh = (LAS unsigned*)(lds + 128);
    LAS int* basee = (LAS int*)(lds + 256);
    LAS int* slots = (LAS int*)(lds + 512);
    const int tid = threadIdx.x, lane = tid & 63, wave = __builtin_amdgcn_readfirstlane(tid >> 6);
    if (tid == 0) { int run = 0;
        for (int e = 0; e < NEXP; ++e) { const int c = (int)__hip_atomic_load(cnt + e, RLX_AGENT); const int nt = (c + 255) >> 8; pad_start[e] = run * 256;
            if (blockIdx.x == 0) for (int t = 0; t < nt; ++t) { tile_e[run + t] = e; const int rem = c - t * 256; tile_rows[run + t] = rem < 256 ? rem : 256; }
            run += nt; }
        if (blockIdx.x == 0) tile_e[MAXTILES] = run; }
    if (tid < 32) lh[tid] = 0u;
    __syncthreads();
    for (int ck = blockIdx.x; ck < NASSIGN / NTHREADS; ck += G) {
        const int a = ck * NTHREADS + tid; const int e = route_e[a];
        const unsigned rank = __hip_atomic_fetch_add(&lh[e], 1u, __ATOMIC_RELAXED, __HIP_MEMORY_SCOPE_WORKGROUP);
        __syncthreads();
        if (tid < 32) { const unsigned n = lh[tid]; basee[tid] = n ? (int)__hip_atomic_fetch_add(cur + tid, n, RLX_AGENT) : 0; }
        __syncthreads();
        const int slot = pad_start[e] + basee[e] + (int)rank;
        slot_tok[slot] = a; slot_w[slot] = route_w[a]; slots[tid] = slot;
        __syncthreads();
        if (tid < 32) lh[tid] = 0u;
        for (int q = 0; q < 64; ++q) { const int aa = wave * 64 + q; const int sl = slots[aa]; const int tok = (ck * NTHREADS + aa) >> 1;
            const v4u* src = (const v4u*)(H1B + (size_t)tok * D); v4u* dst = (v4u*)(XS + (size_t)sl * D);
            const v4u v0 = src[lane], v1 = src[64 + lane]; dst[lane] = v0; dst[64 + lane] = v1; }
        __syncthreads();
    }
}

__device__ __forceinline__ void p11_final(float* H, const bf16* FFN, const float* ln_g, const float* ln_b, int gw, int NGW, int lane) {
    for (int m = gw; m < T; m += NGW) {
        GAS f32x4* hr = (GAS f32x4*)(H + (size_t)m * D) + lane;
        const GAS v2u* f0 = (const GAS v2u*)(FFN + (size_t)(2 * m) * D) + lane; const GAS v2u* f1 = (const GAS v2u*)(FFN + (size_t)(2 * m + 1) * D) + lane;
        f32x4 v[4]; float s = 0.f;
#pragma unroll
        for (int j = 0; j < 4; ++j) { const f32x4 h = hr[64 * j]; const v2u a = f0[64 * j], b = f1[64 * j];
            v[j].x = h.x * ALPHA + (__uint_as_float(a.x << 16) + __uint_as_float(b.x << 16)); v[j].y = h.y * ALPHA + (__uint_as_float(a.x & 0xffff0000u) + __uint_as_float(b.x & 0xffff0000u));
            v[j].z = h.z * ALPHA + (__uint_as_float(a.y << 16) + __uint_as_float(b.y << 16)); v[j].w = h.w * ALPHA + (__uint_as_float(a.y & 0xffff0000u) + __uint_as_float(b.y & 0xffff0000u));
            s += (v[j].x + v[j].y) + (v[j].z + v[j].w); }
        const float mean = wave_sum(s) * (1.f / D); float s2 = 0.f;
#pragma unroll
        for (int j = 0; j < 4; ++j) { v[j] = v[j] - mean; s2 += (v[j].x * v[j].x + v[j].y * v[j].y) + (v[j].z * v[j].z + v[j].w * v[j].w); }
        const float rstd = 1.f / sqrtf(wave_sum(s2) * (1.f / D) + LN_EPS);
#pragma unroll
        for (int j = 0; j < 4; ++j) { const f32x4 g = *((const GAS f32x4*)ln_g + lane + 64 * j), b = *((const GAS f32x4*)ln_b + lane + 64 * j);
            f32x4 o; o.x = v[j].x * rstd * g.x + b.x; o.y = v[j].y * rstd * g.y + b.y; o.z = v[j].z * rstd * g.z + b.z; o.w = v[j].w * rstd * g.w + b.w; hr[64 * j] = o; }
    }
}

enum { I_X = 0, I_WIN, I_BIN, I_SGLNG, I_SGLNB, I_SGW, I_SGB, I_WA, I_LQ1, I_LK1, I_LQ2, I_LK2, I_SUBLN, I_WB, I_WOUT, I_LN1G, I_LN1B, I_WGRP, I_BGRP, I_WEXP, I_BEXP, I_WGATE, I_WUP, I_WDOWN, I_LN2G, I_LN2B, N_IN };
struct Args { const float* in[N_IN]; float* out; unsigned char* ws; int ph_lo, ph_hi; };
static_assert(sizeof(Args) == (N_IN + 2) * 8 + 8, "no padding bytes in Args");

__global__ void __launch_bounds__(NTHREADS, 2) mk_fwd(Args args) {
    extern __shared__ __attribute__((aligned(16))) unsigned char lds[];
    LAS unsigned char* L = (LAS unsigned char*)lds;
    volatile LAS unsigned* MISC = (volatile LAS unsigned*)(L + MISC_OFF);
    const int tid = threadIdx.x, lane = tid & 63, wave = __builtin_amdgcn_readfirstlane(tid >> 6);
    const int G = gridDim.x; const int bx = blockIdx.x; const int vcu = (G % 8 == 0) ? (bx % 8) * (G / 8) + bx / 8 : bx;
    unsigned char* ws = args.ws;
    gu32* ctl = (gu32*)(ws + WS_CTL);
    for (int u = tid; u < (LDS_BYTES - LDSCTL_OFF) / 4; u += NTHREADS) ((LAS unsigned*)(L + LDSCTL_OFF))[u] = 0u;
    __syncthreads();
    XcdBarrier bar; bar.bar = (unsigned*)(ctl + CW_BAR); bar.x = 0; bar.st = nullptr;
#if MK_ONE_LAUNCH
    bar = xcd_barrier_post((unsigned*)(ctl + CW_BAR), MISC + 8);
#define GRID_BAR() xcd_barrier(bar)
#else
#define GRID_BAR() do {} while (0)
#endif
    const int lo = args.ph_lo, hi = args.ph_hi;
#ifndef MK_PHASE_MASK
#define MK_PHASE_MASK 0xFFF
#endif
#define IN(k) (((MK_PHASE_MASK >> (k)) & 1) && lo <= (k) && (k) < hi)
#define BOTH(k) (IN(k) && IN((k) + 1))
    const int gw = vcu * NWAVES + wave, NGW = G * NWAVES;
    bf16* win_t = (bf16*)(ws + WS_WIN); bf16* wa_t = (bf16*)(ws + WS_WA); bf16* wb_t = (bf16*)(ws + WS_WB); bf16* wo_t = (bf16*)(ws + WS_WO);
    bf16* sgw = (bf16*)(ws + WS_SGW); bf16* wgu_t = (bf16*)(ws + WS_WGU); bf16* wd_t = (bf16*)(ws + WS_WD);
    bf16* XB = (bf16*)(ws + WS_XB); bf16* QB = (bf16*)(ws + WS_Q); bf16* KB = (bf16*)(ws + WS_K); bf16* VB = (bf16*)(ws + WS_VAL); bf16* GA = (bf16*)(ws + WS_GA); bf16* GB = (bf16*)(ws + WS_GB);
    bf16* XS = (bf16*)(ws + WS_XS); bf16* HB = (bf16*)(ws + WS_HB); bf16* FFN = (bf16*)(ws + WS_FFN);
    bf16* UV = (bf16*)((unsigned char*)args.out + OUT_UV); bf16* SG = (bf16*)((unsigned char*)args.out + OUT_SG);
    int* route_e = (int*)(ws + WS_ROUTE_E); float* route_w = (float*)(ws + WS_ROUTE_W); int* slot_tok = (int*)(ws + WS_SLOT_TOK); float* slot_w = (float*)(ws + WS_SLOT_W);
    int* tile_e = (int*)(ws + WS_TILE_E); int* tile_rows = (int*)(ws + WS_TILE_ROWS);

    if (IN(0)) {
        P0Args a{args.in[I_X], args.in[I_WIN], args.in[I_WA], args.in[I_WB], args.in[I_WOUT], args.in[I_SGW], args.in[I_WGATE], args.in[I_WUP], args.in[I_WDOWN], win_t, wa_t, wb_t, wo_t, sgw, wgu_t, wd_t, XB};
        p0_prologue(a, L, gw, NGW, wave, lane);
        if (BOTH(0)) GRID_BAR();
    }
    if (IN(1)) {
        pg8::Gemm g{XB, win_t, T, INW, D}; pg8::StaticOrder S; S.init(T, INW, G, bx);
        pg8::EpiInProj E{UV, QB, (size_t)(WS_K - WS_Q) / 2, args.in[I_BIN], C2};
        pg8::gemm_phase<pg8::EpiInProj, pg8::StaticOrder, true, true>(L + RING_OFF, g, S, E);
        if (BOTH(1)) GRID_BAR();
    }
    if (IN(2)) {
        p2_gmlp(UV, SG, sgw, args.in[I_SGLNG], args.in[I_SGLNB], args.in[I_SGB], L, G);
        if (BOTH(2)) GRID_BAR();
    }
    if (IN(3)) {
        pg8::Gemm g{SG, wa_t, T, D, GW}; pg8::StaticOrder S; S.init(T, D, G, bx);
        pg8::EpiGateMix<0> E{GA, nullptr};
        pg8::gemm_phase<pg8::EpiGateMix<0>, pg8::StaticOrder, true, true>(L + RING_OFF, g, S, E);
        if (BOTH(3)) GRID_BAR();
    }
    if (IN(4)) {
        float lam;
        { const float a = args.in[I_LQ1][lane] * args.in[I_LK1][lane], b = args.in[I_LQ2][lane] * args.in[I_LK2][lane];
          lam = __expf(wave_sum(a)) - __expf(wave_sum(b)) + 0.2f; }
        for (int pid = vcu; pid < BATCH * NHEAD * 32; pid += G) {
            const int bh = pid >> 5, p = pid & 31, b = bh >> 3, h = bh & 7;
            const float nslope2 = -exp2f(-(float)(h + 1)) * 1.4426950408889634f;
            const bf16* Kh = KB + (size_t)b * SEQ * D + h * 128; const bf16* Vh = VB + (size_t)b * SEQ * D + h * 128;
#pragma unroll 1
            for (int s = 0; s < 2; ++s) { const int i = s ? p : 63 - p;
                bf16* Qb = QB + ((size_t)b * SEQ + (size_t)i * 128) * D + h * 128;
                att::attn_unit(Qb, Kh, Vh, Qb, i, nslope2, lam, args.in[I_SUBLN], (char*)lds + RING_OFF); }
        }
        if (BOTH(4)) GRID_BAR();
    }
    if (IN(5)) {
        pg8::Gemm g{QB, wb_t, T, D, D}; pg8::StaticOrder S; S.init(T, D, G, bx);
        pg8::EpiGateMix<1> E{GA, GB};
        pg8::gemm_phase<pg8::EpiGateMix<1>, pg8::StaticOrder, true, true>(L + RING_OFF, g, S, E);
        if (BOTH(5)) GRID_BAR();
    }
    if (IN(6)) {
        pg8::Gemm g{GA, wo_t, T, D, D}; pg8::StaticOrder S; S.init(T, D, G, bx);
        pg8::EpiResid E{args.in[I_X], args.out, ALPHA};
        pg8::gemm_phase<pg8::EpiResid, pg8::StaticOrder, true, true>(L + RING_OFF, g, S, E);
        if (BOTH(6)) GRID_BAR();
    }
    if (IN(7)) {
        p7_ln_route(args.out, XB, args.in[I_LN1G], args.in[I_LN1B], args.in[I_WGRP], args.in[I_BGRP], args.in[I_WEXP], args.in[I_BEXP], route_e, route_w, (unsigned*)(ctl + CW_CNT), L, G);
        if (BOTH(7)) GRID_BAR();
    }
    if (IN(8)) {
        p8_dispatch(XB, XS, route_e, route_w, (unsigned*)(ctl + CW_CNT), (unsigned*)(ctl + CW_CUR), slot_tok, slot_w, tile_e, tile_rows, L, G);
        if (BOTH(8)) GRID_BAR();
    }
    if (IN(9)) {
        const int ntiles = __builtin_amdgcn_readfirstlane(tile_e[MAXTILES]);
        pg8::Gemm g{XS, wgu_t, 0, 0, D}; pg8::MoeOrder S{tile_e, ntiles, G, bx};
        pg8::EpiGateUp E{HB};
        pg8::gemm_phase<pg8::EpiGateUp, pg8::MoeOrder, true, true>(L + RING_OFF, g, S, E);
        if (BOTH(9)) GRID_BAR();
    }
    if (IN(10)) {
        const int ntiles = __builtin_amdgcn_readfirstlane(tile_e[MAXTILES]);
        pg8::Gemm g{HB, wd_t, 0, 0, EHID}; pg8::MoeOrder S{tile_e, ntiles, G, bx};
        pg8::EpiDown E{FFN, slot_tok, slot_w, tile_rows};
        pg8::gemm_phase<pg8::EpiDown, pg8::MoeOrder, true, true>(L + RING_OFF, g, S, E);
        if (BOTH(10)) GRID_BAR();
    }
    if (IN(11)) {
        p11_final(args.out, FFN, args.in[I_LN2G], args.in[I_LN2B], gw, NGW, lane);
    }
#undef IN
#undef BOTH
}

extern "C" void kernel_launch(void* const* d_in, const int* in_sizes, int n_in, void* d_out, int out_size, void* d_ws, size_t ws_size, hipStream_t stream) {
    static int grid = 0;
    if (grid == 0) {
        if (n_in != N_IN || in_sizes[0] != T * D || out_size != T * D || ws_size < WS_END) {
            fprintf(stderr, "kernel_launch: shape mismatch: n_in %d in0 %d out %d ws %zu (need %zu)\n", n_in, n_in > 0 ? in_sizes[0] : -1, out_size, ws_size, (size_t)WS_END); grid = -1; return; }
        int dev = 0, cus = 0, per_cu = 0;
        if (hipGetDevice(&dev) != hipSuccess || hipDeviceGetAttribute(&cus, hipDeviceAttributeMultiprocessorCount, dev) != hipSuccess) { grid = -1; return; }
        if (hipFuncSetAttribute((const void*)mk_fwd, hipFuncAttributeMaxDynamicSharedMemorySize, LDS_BYTES) != hipSuccess) { fprintf(stderr, "kernel_launch: hipFuncSetAttribute failed\n"); grid = -1; return; }
        if (hipOccupancyMaxActiveBlocksPerMultiprocessor(&per_cu, (const void*)mk_fwd, NTHREADS, LDS_BYTES) != hipSuccess || per_cu < 1)
            fprintf(stderr, "kernel_launch: note: occupancy query reports %d workgroups per CU\n", per_cu);
        (void)hipGetLastError();
        grid = cus;
    }
    if (grid < 0) return;
    if (hipMemsetAsync((char*)d_ws + WS_CTL, 0, CTL_ZERO_BYTES, stream) != hipSuccess) { fprintf(stderr, "kernel_launch: memset failed\n"); return; }
    Args a{};
    for (int i = 0; i < N_IN; ++i) a.in[i] = (const float*)d_in[i];
    a.out = (float*)d_out; a.ws = (unsigned char*)d_ws;
#if MK_ONE_LAUNCH
    a.ph_lo = 0; a.ph_hi = NPHASE;
    hipLaunchKernelGGL(mk_fwd, dim3(grid), dim3(NTHREADS), LDS_BYTES, stream, a);
#else
    for (int p = 0; p < NPHASE; ++p) { a.ph_lo = p; a.ph_hi = p + 1; hipLaunchKernelGGL(mk_fwd, dim3(grid), dim3(NTHREADS), LDS_BYTES, stream, a); }
#endif
    const hipError_t le = hipPeekAtLastError();
    if (le != hipSuccess) fprintf(stderr, "kernel_launch: launch failed: %s\n", hipGetErrorName(le));
}
```

```cpp
#include <hip/hip_runtime.h>
#include <cstdio>
#include <cstdint>
namespace pg8 {
#define PG8_LAS __attribute__((address_space(3)))
typedef unsigned short bf16_t;
typedef short bf16x8 __attribute__((ext_vector_type(8)));
typedef float f32x4 __attribute__((ext_vector_type(4)));
typedef unsigned u32x4 __attribute__((ext_vector_type(4)));
constexpr int BM = 256, BK = 64, HALF = 128, HTB = HALF * BK * 2  , STAGE_BYTES = 8 * HTB, NXCD = 8, WGM = 8;

__host__ __device__ __forceinline__ int lds_byte(int r, int c) { const int st = (r >> 4) * 2 + (c >> 5), rr = r & 15, cc = c & 31, ob = rr * 64 + cc * 2; return st * 1024 + (ob ^ (((ob >> 9) & 1) << 5)); }
__host__ __device__ __forceinline__ void stage_rc(int b, int& R, int& C) { const int st = b / 1024, sb = b % 1024, swz = sb ^ (((sb >> 9) & 1) << 5); R = (st >> 1) * 16 + swz / 64; C = (st & 1) * 32 + (swz % 64) / 2; }
__host__ __device__ __forceinline__ int perm32(int rho) { const int n = rho >> 4, i = rho & 15; return 8 * (i >> 2) + 4 * n + (i & 3); }

struct Unit { int pm, pn, sl; };
struct Gemm { const bf16_t* A; const bf16_t* Bt; int M, N, K; };

struct StaticOrder {
    int nM, nN, nwg, G, c;
    __host__ __device__ void init(int M, int N, int G_, int c_) { nM = M / BM; nN = N / BM; nwg = nM * nN; G = G_; c = c_; }
    __host__ __device__ bool next(int i, Unit& u) const {
        const long L = (long)i * G + c; if (L >= nwg) return false;
        int wgid = (int)L; { const int q = nwg / NXCD, r = nwg % NXCD, xcd = wgid % NXCD, off = wgid / NXCD; wgid = (xcd < r ? xcd * (q + 1) : r * (q + 1) + (xcd - r) * q) + off; }
        const int nig = WGM * nN, gid = wgid / nig, fm = gid * WGM, gsz = (nM - fm) < WGM ? (nM - fm) : WGM;
        u.pm = fm + ((wgid % nig) % gsz); u.pn = (wgid % nig) / gsz; return true;
    }
    __device__ __forceinline__ void a_ready(const Unit&) const {}
    __device__ __forceinline__ void done(const Unit&) const {}
    __device__ __forceinline__ void stage(const Unit&, int, int) const {}
    static constexpr bool GATHER = false;
    __device__ __forceinline__ unsigned arow(const Unit&, int) const { return 0u; }
};

struct RowOwnerOrder {
    int nM, nN, G, c;
    __host__ __device__ void init(int M, int N, int G_, int c_) { nM = M / BM; nN = N / BM; G = G_; c = c_; }
    __host__ __device__ bool next(int i, Unit& u) const { const int pm = c + (i / nN) * G; if (pm >= nM) return false; u.pm = pm; u.pn = i % nN; return true; }
    __device__ __forceinline__ void a_ready(const Unit&) const {}
    __device__ __forceinline__ void done(const Unit&) const {}
    __device__ __forceinline__ void stage(const Unit&, int, int) const {}
    static constexpr bool GATHER = false;
    __device__ __forceinline__ unsigned arow(const Unit&, int) const { return 0u; }
};
__device__ __forceinline__ unsigned cvt_pk_bf16(float lo, float hi) { unsigned r; asm volatile("v_cvt_pk_bf16_f32 %0, %1, %2" : "=v"(r) : "v"(lo), "v"(hi)); return r; }
typedef float f32x2 __attribute__((ext_vector_type(2)));
__device__ __forceinline__ f32x2 gelu_pk(f32x2 v) {
    const f32x2 av = __builtin_elementwise_abs(v), d = av * 0.2316418882f + 1.0f;
    f32x2 t; t.x = __builtin_amdgcn_rcpf(d.x); t.y = __builtin_amdgcn_rcpf(d.y);
    f32x2 q = t * 0.5307027145f + (-0.7265760135f); q = q * t + 0.7107068705f; q = q * t + (-0.142248368f); q = q * t + 0.127414796f; q = q * t;
    const f32x2 s = (v * v) * (-0.72134752044f);
    f32x2 e; e.x = __builtin_amdgcn_exp2f(s.x); e.y = __builtin_amdgcn_exp2f(s.y);
    const f32x2 m = v * (q * e), r = v - m;
    f32x2 o; o.x = v.x < 0.f ? m.x : r.x; o.y = v.y < 0.f ? m.y : r.y; return o;
}
typedef unsigned u32x2 __attribute__((ext_vector_type(2)));
__device__ __forceinline__ float bf_lo(unsigned w) { return __uint_as_float(w << 16); }
__device__ __forceinline__ float bf_hi(unsigned w) { return __uint_as_float(w & 0xffff0000u); }
__device__ __forceinline__ float sigmoid_f(float x) { return __builtin_amdgcn_rcpf(1.0f + __builtin_amdgcn_exp2f(-1.4426950408889634f * x)); }

struct EpiInProj {
    static constexpr bool PERM = true, AFTER_DRAIN = false; static constexpr int VMEM_MIN = 16;
    bf16_t* uv; bf16_t* g1; size_t gstride; const PG8_LAS float* bias; float qscale;
    __device__ __forceinline__ void operator()(const f32x4 (&acc)[2][2][4][2], const Unit& u, int wr, int wc, int fr, int fq) const {
        asm volatile("" : "+v"(fr), "+v"(fq));
        const int t = u.pn >> 2;
        bf16_t* base = (t == 0) ? uv : g1 + (size_t)(t - 1) * gstride;
        const int row0 = u.pm * BM + wr * 64 + fr;
        const int col0 = (u.pn & 3) * BM + wc * 32 + 8 * fq, bcol0 = u.pn * BM + wc * 32 + 8 * fq;
        const float sc = (t == 1) ? qscale : 1.0f;
#pragma unroll
        for (int bj = 0; bj < 2; ++bj) {
            const f32x4 bv0 = *(const PG8_LAS f32x4*)(bias + bcol0 + bj * HALF), bv1 = *(const PG8_LAS f32x4*)(bias + bcol0 + bj * HALF + 4);
#pragma unroll
        for (int ai = 0; ai < 2; ++ai)
#pragma unroll
            for (int m = 0; m < 4; ++m) { bf16_t* rowp = base + (size_t)(row0 + ai * HALF + m * 16) * 1024 + col0;
                { f32x4 v0 = acc[ai][bj][m][0] + bv0, v1 = acc[ai][bj][m][1] + bv1;
                    if (t == 0) { const f32x2 a = gelu_pk((f32x2){v0[0], v0[1]}), b = gelu_pk((f32x2){v0[2], v0[3]}); v0 = (f32x4){a.x, a.y, b.x, b.y}; __builtin_amdgcn_sched_barrier(0);
                        const f32x2 c = gelu_pk((f32x2){v1[0], v1[1]}), d = gelu_pk((f32x2){v1[2], v1[3]}); v1 = (f32x4){c.x, c.y, d.x, d.y}; }
                    else if (t >= 4) {
#pragma unroll
                        for (int e = 0; e < 4; ++e) { v0[e] = sigmoid_f(v0[e]); v1[e] = sigmoid_f(v1[e]); } }
                    else if (t == 3) {
                        const int h = (u.pn & 3) * 2 + bj; const float w = __builtin_amdgcn_exp2f(__builtin_amdgcn_exp2f(-(float)(h + 1)) * 1.4426950408889634f * (float)(16 * m + fr));
                        v0 = v0 * w; v1 = v1 * w; }
                    else { v0 = v0 * sc; v1 = v1 * sc; }
                    u32x4 w; w.x = cvt_pk_bf16(v0[0], v0[1]); w.y = cvt_pk_bf16(v0[2], v0[3]); w.z = cvt_pk_bf16(v1[0], v1[1]); w.w = cvt_pk_bf16(v1[2], v1[3]);
                    *(u32x4*)(rowp + bj * HALF) = w; } }
        }
    }
};

template <int MODE  > struct EpiGateMix {
    static constexpr bool PERM = true, AFTER_DRAIN = false; static constexpr int VMEM_MIN = MODE ? 40 : 24;
    const bf16_t* io; const bf16_t* g2; bf16_t* outp;
    __device__ __forceinline__ void operator()(const f32x4 (&acc)[2][2][4][2], const Unit& u, int wr, int wc, int fr, int fq) const {
        asm volatile("" : "+v"(fr), "+v"(fq));
        const int row0 = u.pm * BM + wr * 64 + fr, col0 = u.pn * BM + wc * 32 + 8 * fq;
#pragma unroll
        for (int ai = 0; ai < 2; ++ai) {
            u32x4 xi[4][2], xg[4][2];
#pragma unroll
            for (int m = 0; m < 4; ++m)
#pragma unroll
                for (int bj = 0; bj < 2; ++bj) { const size_t off = (size_t)(row0 + ai * HALF + m * 16) * 1024 + col0 + bj * HALF;
                    xi[m][bj] = *(const u32x4*)(io + off); if (MODE == 1) xg[m][bj] = *(const u32x4*)(g2 + off); }
            __builtin_amdgcn_sched_barrier(0);
#pragma unroll
            for (int m = 0; m < 4; ++m)
#pragma unroll
                for (int bj = 0; bj < 2; ++bj) { const size_t off = (size_t)(row0 + ai * HALF + m * 16) * 1024 + col0 + bj * HALF;
                    const f32x4 a0 = acc[ai][bj][m][0], a1 = acc[ai][bj][m][1]; const u32x4 x = xi[m][bj];
                    float r[8];
                    if (MODE == 0) {
                        r[0] = bf_lo(x.x) * a0[0]; r[1] = bf_hi(x.x) * a0[1]; r[2] = bf_lo(x.y) * a0[2]; r[3] = bf_hi(x.y) * a0[3];
                        r[4] = bf_lo(x.z) * a1[0]; r[5] = bf_hi(x.z) * a1[1]; r[6] = bf_lo(x.w) * a1[2]; r[7] = bf_hi(x.w) * a1[3];
                    } else {
                        const u32x4 g = xg[m][bj];
                        r[0] = bf_lo(x.x) + bf_lo(g.x) * a0[0]; r[1] = bf_hi(x.x) + bf_hi(g.x) * a0[1]; r[2] = bf_lo(x.y) + bf_lo(g.y) * a0[2]; r[3] = bf_hi(x.y) + bf_hi(g.y) * a0[3];
                        r[4] = bf_lo(x.z) + bf_lo(g.z) * a1[0]; r[5] = bf_hi(x.z) + bf_hi(g.z) * a1[1]; r[6] = bf_lo(x.w) + bf_lo(g.w) * a1[2]; r[7] = bf_hi(x.w) + bf_hi(g.w) * a1[3];
                    }
                    u32x4 w; w.x = cvt_pk_bf16(r[0], r[1]); w.y = cvt_pk_bf16(r[2], r[3]); w.z = cvt_pk_bf16(r[4], r[5]); w.w = cvt_pk_bf16(r[6], r[7]);
                    *(u32x4*)(outp + off) = w; }
            __builtin_amdgcn_sched_barrier(0);
        }
    }
};

struct EpiResid {
    static constexpr bool PERM = false, AFTER_DRAIN = false; static constexpr int VMEM_MIN = 32;
    const float* x; float* out; float alpha; f32x2* part;
    __device__ __forceinline__ void operator()(const f32x4 (&acc)[2][2][4][2], const Unit& u, int wr, int wc, int fr, int fq) const {
        asm volatile("" : "+v"(fr), "+v"(fq));
        const int row0 = u.pm * BM + wr * 64 + fr, col0 = u.pn * BM + wc * 32 + 4 * fq;
#define ER_LOAD(xv, blk) do { _Pragma("unroll") for (int mm = 0; mm < 2; ++mm) _Pragma("unroll") for (int bj = 0; bj < 2; ++bj) _Pragma("unroll") for (int n = 0; n < 2; ++n) \
            xv[mm][bj][n] = *(const f32x4*)(x + (size_t)(row0 + ((blk) >> 1) * HALF + (2 * ((blk) & 1) + mm) * 16) * 1024 + col0 + bj * HALF + n * 16); } while (0)
#define ER_DO(xv, blk) do { constexpr int ai = (blk) >> 1, mp = (blk) & 1; _Pragma("unroll") for (int mm = 0; mm < 2; ++mm) { const int m = 2 * mp + mm; const int row = row0 + ai * HALF + m * 16; const size_t off = (size_t)row * 1024 + col0; float s1 = 0.f, s2 = 0.f; \
            _Pragma("unroll") for (int bj = 0; bj < 2; ++bj) _Pragma("unroll") for (int n = 0; n < 2; ++n) { const f32x4 r = xv[mm][bj][n] * alpha + acc[ai][bj][m][n]; \
                *(f32x4*)(out + off + bj * HALF + n * 16) = r; s1 += (r[0] + r[1]) + (r[2] + r[3]); s2 += (r[0] * r[0] + r[1] * r[1]) + (r[2] * r[2] + r[3] * r[3]); } \
            s1 += __shfl_xor(s1, 16); s1 += __shfl_xor(s1, 32); s2 += __shfl_xor(s2, 16); s2 += __shfl_xor(s2, 32); \
            if (fq == 0) part[(size_t)row * 16 + (u.pn & 3) * 4 + wc] = (f32x2){s1, s2}; } } while (0)
        f32x4 xa[2][2][2], xb[2][2][2];
        ER_LOAD(xa, 0); ER_LOAD(xb, 1); __builtin_amdgcn_sched_barrier(0);
        ER_DO(xa, 0); __builtin_amdgcn_sched_barrier(0); ER_LOAD(xa, 2); __builtin_amdgcn_sched_barrier(0);
        ER_DO(xb, 1); __builtin_amdgcn_sched_barrier(0); ER_LOAD(xb, 3); __builtin_amdgcn_sched_barrier(0);
        ER_DO(xa, 2); __builtin_amdgcn_sched_barrier(0);
        ER_DO(xb, 3);
#undef ER_LOAD
#undef ER_DO
    }
};

struct EpiGateUp {
    static constexpr bool PERM = true, AFTER_DRAIN = false; static constexpr int VMEM_MIN = 8;
    bf16_t* hb;
    __device__ __forceinline__ void operator()(const f32x4 (&acc)[2][2][4][2], const Unit& u, int wr, int wc, int fr, int fq) const {
        asm volatile("" : "+v"(fr), "+v"(fq));
        const int row0 = u.pm * BM + wr * 64 + fr, col0 = (u.pn & 3) * HALF + wc * 32 + 8 * fq;
#pragma unroll
        for (int ai = 0; ai < 2; ++ai)
#pragma unroll
            for (int m = 0; m < 4; ++m) { bf16_t* p = hb + (size_t)(row0 + ai * HALF + m * 16) * 512 + col0;
                float r[8];
#pragma unroll
                for (int n = 0; n < 2; ++n)
#pragma unroll
                    for (int e = 0; e < 4; ++e) { const float g = acc[ai][0][m][n][e], up = acc[ai][1][m][n][e]; r[n * 4 + e] = g * sigmoid_f(g) * up; }
                u32x4 w; w.x = cvt_pk_bf16(r[0], r[1]); w.y = cvt_pk_bf16(r[2], r[3]); w.z = cvt_pk_bf16(r[4], r[5]); w.w = cvt_pk_bf16(r[6], r[7]);
                *(u32x4*)p = w; }
    }
};

constexpr int MOE_LDS_TE = 0, MOE_LDS_TR = 2304, MOE_LDS_TB = 4608, MOE_LDS_SL = 6912, MOE_LDS_BYTES = 6912 + 3 * 2048;
struct EpiDown {
    static constexpr bool PERM = true, AFTER_DRAIN = false; static constexpr int VMEM_MIN = 0;
    bf16_t* ffn; const PG8_LAS int* ltr; const PG8_LAS int* lsl;
    __device__ __forceinline__ void operator()(const f32x4 (&acc)[2][2][4][2], const Unit& u, int wr, int wc, int fr, int fq) const {
        asm volatile("" : "+v"(fr), "+v"(fq));
        const int nvalid = ltr[u.pm];
        const int col0 = (u.pn & 3) * BM + wc * 32 + 8 * fq;
        const PG8_LAS int* sl = lsl + u.sl * 512;
        int aa[2][4]; float ww[2][4];
#pragma unroll
        for (int ai = 0; ai < 2; ++ai)
#pragma unroll
            for (int m = 0; m < 4; ++m) { const int rl = ai * HALF + wr * 64 + m * 16 + fr; aa[ai][m] = sl[rl]; ww[ai][m] = __int_as_float(sl[256 + rl]); }
#pragma unroll
        for (int ai = 0; ai < 2; ++ai)
#pragma unroll
            for (int m = 0; m < 4; ++m) { const int rl = ai * HALF + wr * 64 + m * 16 + fr;
                if (rl < nvalid) { const float wt = ww[ai][m];
                    bf16_t* p = ffn + (size_t)aa[ai][m] * 1024 + col0;
#pragma unroll
                    for (int bj = 0; bj < 2; ++bj) { const f32x4 v0 = acc[ai][bj][m][0] * wt, v1 = acc[ai][bj][m][1] * wt;
                        u32x4 w; w.x = cvt_pk_bf16(v0[0], v0[1]); w.y = cvt_pk_bf16(v0[2], v0[3]); w.z = cvt_pk_bf16(v1[0], v1[1]); w.w = cvt_pk_bf16(v1[2], v1[3]);
                        *(u32x4*)(p + bj * HALF) = w; } } }
    }
};

template <bool GATHER_> struct MoeOrder {
    static constexpr bool GATHER = GATHER_;
    const int* list_tok; const float* list_w; int ntiles, G, c;
    PG8_LAS int* lte; PG8_LAS int* ltr; PG8_LAS int* ltb; PG8_LAS int* lsl;
    static __device__ __forceinline__ int prime(const unsigned* cnt, const int* list_tok_, const float* list_w_, int cap, int c_, PG8_LAS int* lte_, PG8_LAS int* ltr_, PG8_LAS int* ltb_, PG8_LAS int* lsl_, PG8_LAS int* lnt, int tid) {
        if (tid < 64) { const int ln = tid;
            const int cn = (ln < 32) ? (int)__hip_atomic_load(cnt + (ln & 31), __ATOMIC_RELAXED, __HIP_MEMORY_SCOPE_AGENT) : 0; const int nt = (cn + 255) >> 8;
            int incl = nt;
#pragma unroll
            for (int off = 1; off < 32; off <<= 1) { const int t = __shfl_up(incl, off); if (ln >= off) incl += t; }
            const int excl = incl - nt;
            if (ln < 32) for (int t = 0; t < nt; ++t) { lte_[excl + t] = ln; const int rem = cn - t * 256; ltr_[excl + t] = rem < 256 ? rem : 256; ltb_[excl + t] = ln * cap + t * 256; }
            if (ln == 31) *lnt = incl; }
        __syncthreads();
        const int ntl = *lnt;
        if (c_ < ntl * 4 && tid < 256) { const int base = ltb_[c_ >> 2]; lsl_[tid] = list_tok_[base + tid]; lsl_[256 + tid] = __float_as_int(list_w_[base + tid]); }
        __syncthreads();
        return ntl;
    }
    __device__ bool next(int i, Unit& u) const {
        const long L = (long)i * G + c; if (L >= (long)ntiles * 4) return false;
        const int rt = (int)(L >> 2), ct = (int)(L & 3);
        u.pm = rt; u.pn = __builtin_amdgcn_readfirstlane(lte[rt]) * 4 + ct; u.sl = i % 3; return true;
    }
    __device__ __forceinline__ void stage(const Unit& n, int wid, int lane) const {
        if (wid == 0) { const int base = __builtin_amdgcn_readfirstlane(ltb[n.pm]);
            __builtin_amdgcn_global_load_lds((const unsigned*)(list_tok + base + lane * 4), (PG8_LAS unsigned*)(lsl + n.sl * 512), 16, 0, 0);
            if (!GATHER) __builtin_amdgcn_global_load_lds((const unsigned*)(list_w + base + lane * 4), (PG8_LAS unsigned*)(lsl + n.sl * 512 + 256), 16, 0, 0);
        }
    }
    __device__ __forceinline__ unsigned arow(const Unit& u, int rl) const { return rl < ltr[u.pm] ? (unsigned)(lsl[u.sl * 512 + rl] >> 1) : 0u; }
    __device__ __forceinline__ void a_ready(const Unit&) const {}
    __device__ __forceinline__ void done(const Unit&) const {}
};

template <class Epi, class Sched, bool ALIGN_EPI = false, bool SP2 = false>
__device__ __forceinline__ void gemm_phase(PG8_LAS unsigned char* lds, const Gemm g, const Sched& S, const Epi& E) {
    int tid = threadIdx.x; asm volatile("" : "+v"(tid));
    const int wid = __builtin_amdgcn_readfirstlane(tid >> 6), lane = tid & 63, wr = wid >> 2, wc = wid & 3, fr = lane & 15, fq = lane >> 4;
    const int K = g.K, nt = K / BK;
    unsigned voffA[2], voffB[2]; int gR[2], gC[2];
    static_assert(!Sched::GATHER || SP2, "gathered A rows: SP2 loop only");
    unsigned gvo[2][2] = {{0u, 0u}, {0u, 0u}}, ngvo[2][2] = {{0u, 0u}, {0u, 0u}}, pvo[2][2] = {{0u, 0u}, {0u, 0u}};
#pragma unroll
    for (int i = 0; i < 2; ++i) { int R, C; stage_rc(tid * 16 + i * 8192, R, C); const int Rb = Epi::PERM ? ((R & ~31) + perm32(R & 31)) : R;
        voffA[i] = (unsigned)(R * K + C) * 2u; voffB[i] = (unsigned)(Rb * K + C) * 2u; gR[i] = R; gC[i] = C; }
    const size_t kstep = (size_t)(BK * 2);
    const size_t hstep = (size_t)HALF * K * 2;
    const size_t tstep = 2 * hstep;
    const unsigned ldsw = (unsigned)wid * 1024u;
    const int aoff = lds_byte(wr * 64 + fr, fq * 8), boff = lds_byte(wc * 32 + fr, fq * 8);
#define PG8_SA(b, h) (((b) * 2 + (h)) * HTB)
#define PG8_SB(b, h) ((4 + (b) * 2 + (h)) * HTB)
#define PG8_STAGE(bufoff, gbase, voff) do { _Pragma("unroll") for (int _i = 0; _i < 2; ++_i) \
        __builtin_amdgcn_global_load_lds((const unsigned*)((const char*)(gbase) + (voff)[_i]), (PG8_LAS unsigned*)(lds + (bufoff) + ldsw + _i * 8192), 16, 0, 0); } while (0)
#define PG8_STAGEA(bufoff, kptr, half, VO) do { if constexpr (Sched::GATHER) { PG8_STAGE(bufoff, kptr, (VO)[half]); } else { PG8_STAGE(bufoff, (kptr) + (half) * hstep, voffA); } } while (0)
#define PG8_GOFF(dst, un) do { _Pragma("unroll") for (int h_ = 0; h_ < 2; ++h_) _Pragma("unroll") for (int i_ = 0; i_ < 2; ++i_) dst[h_][i_] = (unsigned)(((size_t)S.arow(un, h_ * HALF + gR[i_]) * K + gC[i_]) * 2u); } while (0)
#define PG8_LDA(dst, b, h) do { _Pragma("unroll") for (int m = 0; m < 4; ++m) _Pragma("unroll") for (int k = 0; k < 2; ++k) dst[m][k] = *(const PG8_LAS bf16x8*)(lds + PG8_SA(b, h) + aoff + m * 2048 + k * 1024); } while (0)
#define PG8_LDB(dst, b, h) do { _Pragma("unroll") for (int n = 0; n < 2; ++n) _Pragma("unroll") for (int k = 0; k < 2; ++k) dst[n][k] = *(const PG8_LAS bf16x8*)(lds + PG8_SB(b, h) + boff + n * 2048 + k * 1024); } while (0)
#define PG8_MMA(ai, bj, At, Bt) do { __builtin_amdgcn_s_setprio(1); _Pragma("unroll") for (int m = 0; m < 4; ++m) _Pragma("unroll") for (int n = 0; n < 2; ++n) _Pragma("unroll") for (int k = 0; k < 2; ++k) \
        acc[ai][bj][m][n] = __builtin_amdgcn_mfma_f32_16x16x32_bf16(Bt[n][k], At[m][k], acc[ai][bj][m][n], 0, 0, 0); __builtin_amdgcn_s_setprio(0); } while (0)
#define PG8_WAIT_V(n) asm volatile("s_waitcnt vmcnt(" #n ")" ::: "memory")
#define PG8_WAIT_L(n) asm volatile("s_waitcnt lgkmcnt(" #n ")" ::: "memory")
#define PG8_BAR __builtin_amdgcn_s_barrier()
#define PG8_SCHED __builtin_amdgcn_sched_barrier(0)
    Unit cur, nxt; int ui = 0;
    if (!S.next(0, cur)) return;
    f32x4 acc[2][2][4][2];
#pragma unroll
    for (int a = 0; a < 2; ++a)
#pragma unroll
        for (int b = 0; b < 2; ++b)
#pragma unroll
            for (int m = 0; m < 4; ++m)
#pragma unroll
                for (int n = 0; n < 2; ++n) acc[a][b][m][n] = (f32x4){0.f, 0.f, 0.f, 0.f};
    bf16x8 At[4][2], B0[2][2], B1[2][2];
    const char* cA = Sched::GATHER ? (const char*)g.A : (const char*)g.A + (size_t)cur.pm * tstep; const char* cB = (const char*)g.Bt + (size_t)cur.pn * tstep;
    if constexpr (Sched::GATHER) PG8_GOFF(gvo, cur);
    S.a_ready(cur);
    if constexpr (SP2) {
        PG8_STAGE(PG8_SB(0, 0), cB, voffB); PG8_STAGE(PG8_SB(0, 1), cB + hstep, voffB); PG8_STAGEA(PG8_SA(0, 0), cA, 0, gvo); PG8_STAGEA(PG8_SA(0, 1), cA, 1, gvo);
        if (wr == 1) PG8_BAR;
        PG8_WAIT_V(2); PG8_BAR;
        PG8_STAGE(PG8_SB(1, 0), cB + kstep, voffB); PG8_STAGEA(PG8_SA(1, 0), cA + kstep, 0, gvo); PG8_STAGE(PG8_SB(1, 1), cB + hstep + kstep, voffB);
        PG8_WAIT_V(6); PG8_BAR;
    } else {
        PG8_STAGE(PG8_SB(0, 0), cB, voffB); PG8_STAGE(PG8_SA(0, 0), cA, voffA); PG8_STAGE(PG8_SB(0, 1), cB + hstep, voffB); PG8_STAGE(PG8_SA(0, 1), cA + hstep, voffA);
        if (wr == 1) PG8_BAR;
        PG8_WAIT_V(4); PG8_BAR;
        PG8_STAGE(PG8_SB(1, 0), cB + kstep, voffB); PG8_STAGE(PG8_SA(1, 0), cA + kstep, voffA); PG8_STAGE(PG8_SB(1, 1), cB + hstep + kstep, voffB);
        PG8_WAIT_V(6); PG8_BAR;
    }
    for (;;) {
        const bool has_next = S.next(ui + 1, nxt);
        const char* nA = (has_next && !Sched::GATHER) ? (const char*)g.A + (size_t)nxt.pm * tstep : cA; const char* nB = has_next ? (const char*)g.Bt + (size_t)nxt.pn * tstep : cB;
        if (has_next) S.stage(nxt, wid, lane);
        if constexpr (Sched::GATHER) { _Pragma("unroll") for (int h_ = 0; h_ < 2; ++h_) _Pragma("unroll") for (int i_ = 0; i_ < 2; ++i_) ngvo[h_][i_] = gvo[h_][i_]; }
        for (int t = 0; t < nt; t += 2) {
            const bool last = (t == nt - 2);
            const char* a1 = cA + (size_t)(t + 1) * kstep;
            const char* a2 = last ? nA : cA + (size_t)(t + 2) * kstep; const char* b2 = last ? nB : cB + (size_t)(t + 2) * kstep;
            const char* a3 = a2 + kstep; const char* b3 = b2 + kstep;
            if (last && has_next) { if constexpr (Sched::GATHER) { PG8_GOFF(ngvo, nxt); } S.a_ready(nxt); }
            if constexpr (Sched::GATHER) { _Pragma("unroll") for (int h_ = 0; h_ < 2; ++h_) _Pragma("unroll") for (int i_ = 0; i_ < 2; ++i_) pvo[h_][i_] = last ? ngvo[h_][i_] : gvo[h_][i_]; }
            if constexpr (SP2) {
            PG8_LDB(B0, 0, 0); PG8_LDB(B1, 0, 1); PG8_SCHED; PG8_LDA(At, 0, 0); PG8_STAGEA(PG8_SA(1, 1), a1, 1, gvo);
            PG8_WAIT_V(8); PG8_WAIT_L(0); PG8_BAR; PG8_MMA(0, 0, At, B0); PG8_MMA(0, 1, At, B1); PG8_BAR; PG8_SCHED;
            PG8_LDA(At, 0, 1); PG8_STAGE(PG8_SB(0, 0), b2, voffB); PG8_STAGE(PG8_SB(0, 1), b2 + hstep, voffB); PG8_STAGEA(PG8_SA(0, 0), a2, 0, pvo);
            PG8_WAIT_V(8); PG8_WAIT_L(0); PG8_BAR; PG8_MMA(1, 0, At, B0); PG8_MMA(1, 1, At, B1); PG8_BAR; PG8_SCHED;
            PG8_LDB(B0, 1, 0); PG8_LDB(B1, 1, 1); PG8_SCHED; PG8_LDA(At, 1, 0); PG8_STAGEA(PG8_SA(0, 1), a2, 1, pvo);
            PG8_WAIT_V(8); PG8_WAIT_L(0); PG8_BAR; PG8_MMA(0, 0, At, B0); PG8_MMA(0, 1, At, B1); PG8_BAR; PG8_SCHED;
            PG8_LDA(At, 1, 1); PG8_STAGE(PG8_SB(1, 0), b3, voffB); PG8_STAGE(PG8_SB(1, 1), b3 + hstep, voffB); PG8_STAGEA(PG8_SA(1, 0), a3, 0, pvo);
            PG8_WAIT_V(8); PG8_WAIT_L(0); PG8_BAR; PG8_MMA(1, 0, At, B0); PG8_MMA(1, 1, At, B1); PG8_BAR; PG8_SCHED;
            } else {
            PG8_LDB(B0, 0, 0); PG8_SCHED; PG8_LDA(At, 0, 0); PG8_STAGE(PG8_SA(1, 1), a1 + hstep, voffA);
            PG8_WAIT_L(8); PG8_BAR; PG8_WAIT_L(0); PG8_MMA(0, 0, At, B0); PG8_BAR; PG8_SCHED;
            PG8_LDB(B1, 0, 1); PG8_STAGE(PG8_SB(0, 0), b2, voffB);
            PG8_BAR; PG8_WAIT_L(0); PG8_MMA(0, 1, At, B1); PG8_BAR;
            PG8_LDA(At, 0, 1); PG8_STAGE(PG8_SA(0, 0), a2, voffA);
            PG8_BAR; PG8_WAIT_L(0); PG8_MMA(1, 0, At, B0); PG8_BAR; PG8_SCHED;
            PG8_STAGE(PG8_SB(0, 1), b2 + hstep, voffB);
            PG8_WAIT_V(6); PG8_BAR; PG8_MMA(1, 1, At, B1); PG8_BAR;
            PG8_LDB(B0, 1, 0); PG8_SCHED; PG8_LDA(At, 1, 0); PG8_STAGE(PG8_SA(0, 1), a2 + hstep, voffA);
            PG8_WAIT_L(8); PG8_BAR; PG8_WAIT_L(0); PG8_MMA(0, 0, At, B0); PG8_BAR; PG8_SCHED;
            PG8_LDB(B1, 1, 1); PG8_STAGE(PG8_SB(1, 0), b3, voffB);
            PG8_BAR; PG8_WAIT_L(0); PG8_MMA(0, 1, At, B1); PG8_BAR;
            PG8_LDA(At, 1, 1); PG8_STAGE(PG8_SA(1, 0), a3, voffA);
            PG8_BAR; PG8_WAIT_L(0); PG8_MMA(1, 0, At, B0); PG8_BAR; PG8_SCHED;
            PG8_STAGE(PG8_SB(1, 1), b3 + hstep, voffB);
            PG8_WAIT_V(6); PG8_BAR; PG8_MMA(1, 1, At, B1); PG8_BAR;
            }
        }
        if constexpr (ALIGN_EPI) { if (wr == 0) PG8_BAR; }
        if constexpr (!Epi::AFTER_DRAIN) { E(acc, cur, wr, wc, fr, fq); S.done(cur); }
        if (!has_next) break;
#pragma unroll
        for (int a = 0; a < 2; ++a)
#pragma unroll
            for (int b = 0; b < 2; ++b)
#pragma unroll
                for (int m = 0; m < 4; ++m)
#pragma unroll
                    for (int n = 0; n < 2; ++n) acc[a][b][m][n] = (f32x4){0.f, 0.f, 0.f, 0.f};
        cur = nxt; cA = nA; cB = nB; ++ui;
        if constexpr (Sched::GATHER) { _Pragma("unroll") for (int h_ = 0; h_ < 2; ++h_) _Pragma("unroll") for (int i_ = 0; i_ < 2; ++i_) gvo[h_][i_] = ngvo[h_][i_]; }
        if constexpr (ALIGN_EPI) { if (wr == 1) PG8_BAR; }
    }
    PG8_WAIT_V(0);
    if constexpr (!ALIGN_EPI) { if (wr == 0) PG8_BAR; }
    PG8_BAR;
    if constexpr (Epi::AFTER_DRAIN) { E.fused(acc, cur, wr, wc, fr, fq, lds, wid, lane); S.done(cur); }
#undef PG8_SA
#undef PG8_SB
#undef PG8_STAGE
#undef PG8_LDA
#undef PG8_STAGEA
#undef PG8_GOFF
#undef PG8_LDB
#undef PG8_MMA
#undef PG8_WAIT_V
#undef PG8_WAIT_L
#undef PG8_BAR
#undef PG8_SCHED
}
}
namespace att {
using bf16x8 = __attribute__((ext_vector_type(8))) short;
using s16x4  = __attribute__((ext_vector_type(4))) short;
using f32x16 = __attribute__((ext_vector_type(16))) float;
using u32x4  = __attribute__((ext_vector_type(4))) unsigned;
typedef unsigned short bf16;
constexpr int NW = 8, QBLK = 32, KVBLK = 64, LD = 1024, SEQ = 8192;
constexpr int SLOT = KVBLK * 128 * 2;
constexpr int KSL = 4, VSL = 5;
constexpr int LDS_K = 0, LDS_V = KSL * SLOT, LDS_WS = (KSL + VSL) * SLOT, LDS_FLG = LDS_WS + NW * 64 * 4, LDS_NXT = LDS_FLG + 64, LDS_PMX = LDS_NXT + 16, LDS_TCH = LDS_PMX + 1024, LDS_BYTES = LDS_TCH + NW * 256;
constexpr float THR2 = 11.5f;
constexpr float EXIT_ARG = -152.0f;
#define SBAR() __builtin_amdgcn_sched_barrier(0)
#define WAIT_BAR(N) asm volatile("s_waitcnt vmcnt(" #N ") lgkmcnt(0)\n\ts_barrier" ::: "memory")
template <int M> __device__ __forceinline__ float swz_xor(float v) {
  return __int_as_float(__builtin_amdgcn_ds_swizzle(__float_as_int(v), (M << 10) | 0x1f)); }
__device__ __forceinline__ int crow(int r, int hi) { return (r & 3) + 8 * (r >> 2) + 4 * hi; }
__device__ __forceinline__ unsigned cvtpk(float lo, float hi) { unsigned r; asm volatile("v_cvt_pk_bf16_f32 %0, %1, %2" : "=v"(r) : "v"(lo), "v"(hi)); return r; }
__device__ __forceinline__ void glds16s(unsigned voff, const void* sbase, unsigned lds_dst) { unsigned keep;
  asm volatile("s_mov_b32 %0, m0\n\ts_mov_b32 m0, %3\n\ts_nop 0\n\tglobal_load_lds_dwordx4 %1, %2\n\ts_mov_b32 m0, %0" : "=&s"(keep) : "v"(voff), "s"(sbase), "s"(lds_dst) : "memory"); }

__device__ __forceinline__ void glds4(const void* vaddr, unsigned lds_dst) { unsigned keep;
  asm volatile("s_mov_b32 %0, m0\n\ts_mov_b32 m0, %2\n\ts_nop 0\n\tglobal_load_lds_dword %1, off\n\ts_mov_b32 m0, %0" : "=&s"(keep) : "v"(vaddr), "s"(lds_dst) : "memory"); }
__device__ __forceinline__ void partialSM(f32x16& p0, f32x16& p1, float& m_reg, float& alpha, float bt, bool diag, float qrel4, float slope2x2) {
  if (diag) {
#pragma unroll
    for (int r = 0; r < 16; ++r) { const float kk = (float)((r & 3) + 8 * (r >> 2));
      p0[r] -= slope2x2 * fmaxf(kk - qrel4, 0.f); p1[r] -= slope2x2 * fmaxf(kk + 32.0f - qrel4, 0.f); }
  }
  float pmax = p0[0];
#pragma unroll
  for (int r = 1; r < 16; ++r) pmax = fmaxf(pmax, p0[r]);
#pragma unroll
  for (int r = 0; r < 16; ++r) pmax = fmaxf(pmax, p1[r]);
  { auto rr = __builtin_amdgcn_permlane32_swap(__float_as_uint(pmax), __float_as_uint(pmax), false, false);
    pmax = fmaxf(__uint_as_float(rr[0]), __uint_as_float(rr[1])); }
  const float b = pmax + bt; float mn;
  if (__builtin_expect(__all(b - m_reg <= THR2), 1)) { mn = m_reg; alpha = 1.f; }
  else { mn = fmaxf(m_reg, b); alpha = __builtin_amdgcn_exp2f(m_reg - mn); m_reg = mn; }
  const float sh = bt - mn;
#pragma unroll
  for (int r = 0; r < 16; ++r) p0[r] = p0[r] + sh;
#pragma unroll
  for (int r = 0; r < 16; ++r) p1[r] = p1[r] + sh;
#pragma unroll
  for (int r = 0; r < 16; ++r) p0[r] = __builtin_amdgcn_exp2f(p0[r]);
}
__device__ __forceinline__ void finishSM(f32x16& p0, f32x16& p1, float alpha, float& l_reg, const float (&u)[16], float whi, float w32, bf16x8& pa0, bf16x8& pa1, bf16x8& pa2, bf16x8& pa3) {
#pragma unroll
  for (int r = 0; r < 16; ++r) p1[r] = __builtin_amdgcn_exp2f(p1[r]);
  float s0 = 0.f, s1 = 0.f;
#pragma unroll
  for (int r = 0; r < 16; ++r) s0 = fmaf(p0[r], u[r], s0);
#pragma unroll
  for (int r = 0; r < 16; ++r) s1 = fmaf(p1[r], u[r], s1);
  float ps = fmaf(s1, w32, s0) * whi;
  { auto rr = __builtin_amdgcn_permlane32_swap(__float_as_uint(ps), __float_as_uint(ps), false, false);
    ps = __uint_as_float(rr[0]) + __uint_as_float(rr[1]); }
  l_reg = l_reg * alpha + ps;
#define PK4(P, BASE, OUT) do { unsigned a0 = cvtpk(P[BASE + 0], P[BASE + 1]), a1 = cvtpk(P[BASE + 2], P[BASE + 3]);   \
    unsigned b0 = cvtpk(P[BASE + 4], P[BASE + 5]), b1 = cvtpk(P[BASE + 6], P[BASE + 7]);                              \
    auto r0 = __builtin_amdgcn_permlane32_swap(a0, b0, false, false); auto r1 = __builtin_amdgcn_permlane32_swap(a1, b1, false, false); \
    u32x4 w = {r0[0], r1[0], r0[1], r1[1]}; OUT = *reinterpret_cast<bf16x8*>(&w); } while (0)
  PK4(p0, 0, pa0); PK4(p0, 8, pa1); PK4(p1, 0, pa2); PK4(p1, 8, pa3);
#undef PK4
}
__device__ __forceinline__ void qkt(f32x16& p0, f32x16& p1, const char* Ks, const bf16x8* qr, int r32, const int (&kq)[4]) {
  p0 = f32x16{}; p1 = f32x16{};
#pragma unroll
  for (int d0 = 0; d0 < 4; ++d0) {
    const bf16x8 b0 = *reinterpret_cast<const bf16x8*>(Ks + r32 * 256 + kq[d0]);
    const bf16x8 b1 = *reinterpret_cast<const bf16x8*>(Ks + (32 + r32) * 256 + kq[d0]);
    p0 = __builtin_amdgcn_mfma_f32_32x32x16_bf16(b0, qr[d0], p0, 0, 0, 0);
    p1 = __builtin_amdgcn_mfma_f32_32x32x16_bf16(b1, qr[d0], p1, 0, 0, 0); }
}
__device__ __forceinline__ int v_rd_base(int lane) { return ((lane & 3) << 3) | (((lane >> 2) & 3) << 6) | (((lane >> 4) & 1) << 5) | (((lane >> 5) & 1) << 8); }
constexpr int v_rd_off(int d0, int ks, int half) { return d0 * 512 + ks * 4096 + half * 2048; }
typedef short v4i16_t __attribute__((ext_vector_type(4)));
template <int OFF> __device__ __forceinline__ s16x4 tr_read(int vb) {
  return __builtin_bit_cast(s16x4, __builtin_amdgcn_ds_read_tr16_b64_v4i16((__attribute__((address_space(3))) v4i16_t*)(uintptr_t)(unsigned)(vb + OFF)));
}
template <int D0> __device__ __forceinline__ void pv_one(f32x16& od, int vb, bf16x8 pa0, bf16x8 pa1, bf16x8 pa2, bf16x8 pa3) {
  const s16x4 l0 = tr_read<v_rd_off(D0, 0, 0)>(vb), h0 = tr_read<v_rd_off(D0, 0, 1)>(vb), l1 = tr_read<v_rd_off(D0, 1, 0)>(vb), h1 = tr_read<v_rd_off(D0, 1, 1)>(vb);
  const s16x4 l2 = tr_read<v_rd_off(D0, 2, 0)>(vb), h2 = tr_read<v_rd_off(D0, 2, 1)>(vb), l3 = tr_read<v_rd_off(D0, 3, 0)>(vb), h3 = tr_read<v_rd_off(D0, 3, 1)>(vb);
  asm volatile("s_waitcnt lgkmcnt(0)" ::: "memory"); SBAR();
#define PK(L, H) (bf16x8){L[0], L[1], L[2], L[3], H[0], H[1], H[2], H[3]}
  od = __builtin_amdgcn_mfma_f32_32x32x16_bf16(pa0, PK(l0, h0), od, 0, 0, 0);
  od = __builtin_amdgcn_mfma_f32_32x32x16_bf16(pa1, PK(l1, h1), od, 0, 0, 0);
  od = __builtin_amdgcn_mfma_f32_32x32x16_bf16(pa2, PK(l2, h2), od, 0, 0, 0);
  od = __builtin_amdgcn_mfma_f32_32x32x16_bf16(pa3, PK(l3, h3), od, 0, 0, 0);
#undef PK
}
__device__ __forceinline__ void pv_d0(f32x16* o, int vb, bf16x8 pa0, bf16x8 pa1, bf16x8 pa2, bf16x8 pa3) {
  pv_one<0>(o[0], vb, pa0, pa1, pa2, pa3); pv_one<1>(o[1], vb, pa0, pa1, pa2, pa3); pv_one<2>(o[2], vb, pa0, pa1, pa2, pa3); pv_one<3>(o[3], vb, pa0, pa1, pa2, pa3);
}

__device__ __forceinline__ void softmax_tile(f32x16& p0, f32x16& p1, float& m_reg, float& mmin, float& l_reg, f32x16* o, float bt, bool diag, float qrel4, float slope2x2, const float (&u)[16], float whi, float w32,
                                             float* al_l, int r32, int hi, bf16x8& pa0, bf16x8& pa1, bf16x8& pa2, bf16x8& pa3) {
  if (diag) {
#pragma unroll
    for (int r = 0; r < 16; ++r) { const float kk = (float)((r & 3) + 8 * (r >> 2));
      p0[r] -= slope2x2 * fmaxf(kk - qrel4, 0.f); p1[r] -= slope2x2 * fmaxf(kk + 32.0f - qrel4, 0.f); }
  }
  float pmax = p0[0];
#pragma unroll
  for (int r = 1; r < 16; ++r) pmax = fmaxf(pmax, p0[r]);
#pragma unroll
  for (int r = 0; r < 16; ++r) pmax = fmaxf(pmax, p1[r]);
  { auto rr = __builtin_amdgcn_permlane32_swap(__float_as_uint(pmax), __float_as_uint(pmax), false, false);
    pmax = fmaxf(__uint_as_float(rr[0]), __uint_as_float(rr[1])); }
  const float b = pmax + bt;
  if (__builtin_expect(!__all(b - m_reg <= THR2), 0)) {
    const float mn = fmaxf(m_reg, b), alpha = __builtin_amdgcn_exp2f(m_reg - mn); m_reg = mn; l_reg *= alpha;
    { float mm = m_reg;
      mm = fminf(mm, swz_xor<1>(mm)); mm = fminf(mm, swz_xor<2>(mm)); mm = fminf(mm, swz_xor<4>(mm)); mm = fminf(mm, swz_xor<8>(mm)); mm = fminf(mm, swz_xor<16>(mm));
      mmin = __uint_as_float(__builtin_amdgcn_readfirstlane(__float_as_uint(mm))); }
    if (hi == 0) al_l[r32] = alpha; asm volatile("s_waitcnt lgkmcnt(0)" ::: "memory");
#pragma unroll
    for (int d = 0; d < 4; ++d)
#pragma unroll
      for (int r = 0; r < 16; ++r) o[d][r] *= al_l[crow(r, hi)];
  }
  const float sh = bt - m_reg;
#pragma unroll
  for (int r = 0; r < 16; ++r) p0[r] = __builtin_amdgcn_exp2f(p0[r] + sh);
#pragma unroll
  for (int r = 0; r < 16; ++r) p1[r] = __builtin_amdgcn_exp2f(p1[r] + sh);
  float s0 = 0.f, s1 = 0.f;
#pragma unroll
  for (int r = 0; r < 16; ++r) s0 = fmaf(p0[r], u[r], s0);
#pragma unroll
  for (int r = 0; r < 16; ++r) s1 = fmaf(p1[r], u[r], s1);
  float ps = fmaf(s1, w32, s0) * whi;
  { auto rr = __builtin_amdgcn_permlane32_swap(__float_as_uint(ps), __float_as_uint(ps), false, false);
    ps = __uint_as_float(rr[0]) + __uint_as_float(rr[1]); }
  l_reg += ps;
#define PK4(P, BASE, OUT) do { unsigned a0 = cvtpk(P[BASE + 0], P[BASE + 1]), a1 = cvtpk(P[BASE + 2], P[BASE + 3]);   \
    unsigned b0 = cvtpk(P[BASE + 4], P[BASE + 5]), b1 = cvtpk(P[BASE + 6], P[BASE + 7]);                              \
    auto r0 = __builtin_amdgcn_permlane32_swap(a0, b0, false, false); auto r1 = __builtin_amdgcn_permlane32_swap(a1, b1, false, false); \
    u32x4 w = {r0[0], r1[0], r0[1], r1[1]}; OUT = *reinterpret_cast<bf16x8*>(&w); } while (0)
  PK4(p0, 0, pa0); PK4(p0, 8, pa1); PK4(p1, 0, pa2); PK4(p1, 8, pa3);
#undef PK4
}
template <int D0> __device__ __forceinline__ void vload8(bf16x8 (&vf)[8], int vb) {
#define VF1(i, d0, ks) do { const s16x4 l_ = tr_read<v_rd_off(d0, ks, 0)>(vb), h_ = tr_read<v_rd_off(d0, ks, 1)>(vb); vf[i] = (bf16x8){l_[0], l_[1], l_[2], l_[3], h_[0], h_[1], h_[2], h_[3]}; } while (0)
  VF1(0, D0, 0); VF1(1, D0, 1); VF1(2, D0, 2); VF1(3, D0, 3); VF1(4, D0 + 1, 0); VF1(5, D0 + 1, 1); VF1(6, D0 + 1, 2); VF1(7, D0 + 1, 3);
#undef VF1
}
__device__ __forceinline__ void pv8(f32x16& oa, f32x16& ob, const bf16x8 (&vf)[8], bf16x8 pa0, bf16x8 pa1, bf16x8 pa2, bf16x8 pa3) {
  oa = __builtin_amdgcn_mfma_f32_32x32x16_bf16(pa0, vf[0], oa, 0, 0, 0); ob = __builtin_amdgcn_mfma_f32_32x32x16_bf16(pa0, vf[4], ob, 0, 0, 0);
  oa = __builtin_amdgcn_mfma_f32_32x32x16_bf16(pa1, vf[1], oa, 0, 0, 0); ob = __builtin_amdgcn_mfma_f32_32x32x16_bf16(pa1, vf[5], ob, 0, 0, 0);
  oa = __builtin_amdgcn_mfma_f32_32x32x16_bf16(pa2, vf[2], oa, 0, 0, 0); ob = __builtin_amdgcn_mfma_f32_32x32x16_bf16(pa2, vf[6], ob, 0, 0, 0);
  oa = __builtin_amdgcn_mfma_f32_32x32x16_bf16(pa3, vf[3], oa, 0, 0, 0); ob = __builtin_amdgcn_mfma_f32_32x32x16_bf16(pa3, vf[7], ob, 0, 0, 0);
}

__device__ __forceinline__ int attn_unit(const bf16* Qb, const bf16* __restrict__ Kh, const bf16* __restrict__ Vh, bf16* Ob, int i, float slope2, const float (&u)[16], float w4, float w32, float lam,
                                          const float* __restrict__ subln_g, const float* pmx, unsigned* qctr, char* lds, const char* pfQ, const char* pfK, int probe = 0) {
  int tid = threadIdx.x; asm volatile("" : "+v"(tid));
  const int wid = __builtin_amdgcn_readfirstlane(tid >> 6), lane = tid & 63, r32 = lane & 31, hi = lane >> 5;
  const int c = wid & 1, rb = wid >> 1, grp = wid >> 2;
  const unsigned lds0 = (unsigned)(uintptr_t)lds;
  char* K_lds = lds + LDS_K;
  float* ws = (float*)(lds + LDS_WS) + wid * 64; float* li_l = ws; float* al_l = ws + 32;
  float m_reg = -1e30f, l_reg = 0; f32x16 o[4] = {}; bf16x8 qr[4];
  const bf16* Qw = Qb + (long)(rb * QBLK + r32) * LD + c * 64 + hi * 8;
#pragma unroll
  for (int d0 = 0; d0 < 4; ++d0) qr[d0] = *reinterpret_cast<const bf16x8*>(Qw + d0 * 16);
  float qn;
  unsigned* flg = (unsigned*)(lds + LDS_FLG);
  unsigned kvo, vvo;
  { const int p = wid;
    { const int row = 4 * p + (lane >> 4), ch = (lane & 15) ^ (row & 15); kvo = (unsigned)((row * LD + ch * 8) * 2); }
    { const int lp = lane & 31, kk = 8 * (p >> 1) + (lp >> 2), key = (kk & ~0xC) | ((kk & 4) << 1) | ((kk & 8) >> 1), col = 32 * (2 * (p & 1) + (lane >> 5)) + 8 * (lp & 3); vvo = (unsigned)((key * LD + col) * 2); } }
  const unsigned kdst = lds0 + LDS_K + wid * 1024, vdst = lds0 + LDS_V + wid * 1024;
  const int NT = 2 * i + 2;
#define DMA_K(n, slotoff) do { const char* sb_ = (const char*)Kh + (size_t)(NT - 1 - (n)) * (KVBLK * LD * 2); \
    glds16s(kvo, sb_, (unsigned)__builtin_amdgcn_readfirstlane(kdst + (slotoff))); glds16s(kvo, sb_ + 32 * LD * 2, (unsigned)__builtin_amdgcn_readfirstlane(kdst + (slotoff) + 8192)); } while (0)
#define DMA_V(n, slotoff) do { const char* sb_ = (const char*)Vh + (size_t)(NT - 1 - (n)) * (KVBLK * LD * 2); \
    glds16s(vvo, sb_, (unsigned)__builtin_amdgcn_readfirstlane(vdst + (slotoff))); glds16s(vvo, sb_ + 32 * LD * 2, (unsigned)__builtin_amdgcn_readfirstlane(vdst + (slotoff) + 8192)); } while (0)
#define WAITB(cnt) do { SBAR(); const int c_ = (cnt); if (c_ >= 8) { WAIT_BAR(8); } else if (c_ >= 6) { WAIT_BAR(6); } else if (c_ >= 4) { WAIT_BAR(4); } else if (c_ >= 2) { WAIT_BAR(2); } else { WAIT_BAR(0); } SBAR(); } while (0)
#define BSZ(j) (((j) + 4 < NT ? 2 : 0) + ((j) + 3 < NT ? 2 : 0))
  const int kq0 = r32 * 256 + (((c * 8 + hi) ^ (r32 & 15)) * 16);
  const int vb0 = (int)(lds0 + LDS_V) + v_rd_base(lane);
  const bool skiplast = rb < 2;
  const float qloc = (float)(rb * QBLK + r32 - 4 * hi);
  const float whi = hi ? w4 : 1.0f;
  const float slope64 = slope2 * 64.0f, slope2x2 = 2.0f * slope2;
  bf16x8 kf[8], vfa[8], vfb[8], pa0, pa1, pa2, pa3; f32x16 p0, p1;
#define KLOAD(slotoff) do { const char* ks_ = K_lds + (slotoff); _Pragma("unroll") for (int d0 = 0; d0 < 4; ++d0) { \
    kf[2 * d0] = *reinterpret_cast<const bf16x8*>(ks_ + (kq0 ^ (32 * d0))); kf[2 * d0 + 1] = *reinterpret_cast<const bf16x8*>(ks_ + (kq0 ^ (32 * d0)) + 8192); } } while (0)
  if (wid == 0) glds16s((unsigned)lane * 16u, pmx, (unsigned)__builtin_amdgcn_readfirstlane(lds0 + LDS_PMX));
  DMA_K(0, 0);
  { float s = 0.f;
#pragma unroll
    for (int d0 = 0; d0 < 4; ++d0)
#pragma unroll
      for (int e = 0; e < 8; ++e) { const float v = __uint_as_float(((unsigned)(unsigned short)qr[d0][e]) << 16); s = fmaf(v, v, s); }
    { auto rr = __builtin_amdgcn_permlane32_swap(__float_as_uint(s), __float_as_uint(s), false, false); s = __uint_as_float(rr[0]) + __uint_as_float(rr[1]); }
    s = fmaxf(s, swz_xor<1>(s)); s = fmaxf(s, swz_xor<2>(s)); s = fmaxf(s, swz_xor<4>(s)); s = fmaxf(s, swz_xor<8>(s)); s = fmaxf(s, swz_xor<16>(s));
    qn = __uint_as_float(__builtin_amdgcn_readfirstlane(__float_as_uint(sqrtf(s) * 1.001f))); }
  DMA_K(1, SLOT); DMA_V(0, 0);
  if (2 < NT) { DMA_K(2, 2 * SLOT); } DMA_V(1, SLOT);
  if (3 < NT) { DMA_K(3, 3 * SLOT); } if (2 < NT) { DMA_V(2, 2 * SLOT); }
  SBAR(); if (2 < NT) { WAIT_BAR(12); } else { WAIT_BAR(6); } SBAR();
  KLOAD(0);
  if (wid < 2) {
    float* pm_ = (float*)(lds + LDS_PMX) + wid * 128;
    float a = pm_[lane], b2 = pm_[64 + lane];
#define DPP_MAX(v, ctrl, rmask) v = fmaxf(v, __int_as_float(__builtin_amdgcn_update_dpp(__float_as_int(v), __float_as_int(v), ctrl, rmask, 0xf, false)))
    DPP_MAX(a, 0x111, 0xf); DPP_MAX(a, 0x112, 0xf); DPP_MAX(a, 0x114, 0xf); DPP_MAX(a, 0x118, 0xf); DPP_MAX(a, 0x142, 0xa); DPP_MAX(a, 0x143, 0xc);
    DPP_MAX(b2, 0x111, 0xf); DPP_MAX(b2, 0x112, 0xf); DPP_MAX(b2, 0x114, 0xf); DPP_MAX(b2, 0x118, 0xf); DPP_MAX(b2, 0x142, 0xa); DPP_MAX(b2, 0x143, 0xc);
#undef DPP_MAX
    b2 = fmaxf(b2, __int_as_float(__builtin_amdgcn_readlane(__float_as_int(a), 63)));
    pm_[lane] = sqrtf(a) * 1.001f; pm_[64 + lane] = sqrtf(b2) * 1.001f;
  }
  if (grp == 1) WAITB(BSZ(-2) + BSZ(-1));
  int v5 = 0;
  float mmin = -1e30f;
  for (int n = 0; n < NT; ++n) {
    const int v5p = (v5 == 0) ? 4 : v5 - 1, v5n2 = (v5 >= 3) ? v5 - 3 : v5 + 2;
    int vbp = vb0 + v5p * SLOT; asm volatile("" : "+v"(vbp));
    p0 = f32x16{}; p1 = f32x16{};
#define QKM(i) do { if ((i) & 1) p1 = __builtin_amdgcn_mfma_f32_32x32x16_bf16(kf[i], qr[(i) >> 1], p1, 0, 0, 0); else p0 = __builtin_amdgcn_mfma_f32_32x32x16_bf16(kf[i], qr[(i) >> 1], p0, 0, 0, 0); } while (0)
#define VFR(vf, i, D0) do { const s16x4 l_ = tr_read<v_rd_off((D0) + ((i) >> 2), (i) & 3, 0)>(vbp), h_ = tr_read<v_rd_off((D0) + ((i) >> 2), (i) & 3, 1)>(vbp); vf[i] = (bf16x8){l_[0], l_[1], l_[2], l_[3], h_[0], h_[1], h_[2], h_[3]}; } while (0)
#define PVM(oo, pa, vf, i) oo = __builtin_amdgcn_mfma_f32_32x32x16_bf16(pa, vf[i], oo, 0, 0, 0)
    if (n > 0) {
      QKM(0); SBAR(); VFR(vfa, 0, 0); SBAR(); QKM(1); SBAR(); VFR(vfa, 4, 0); SBAR(); QKM(2); SBAR(); VFR(vfa, 1, 0); SBAR(); QKM(3); SBAR(); VFR(vfa, 5, 0); SBAR();
      QKM(4); SBAR(); VFR(vfa, 2, 0); SBAR(); QKM(5); SBAR(); VFR(vfa, 6, 0); SBAR(); QKM(6); SBAR(); VFR(vfa, 3, 0); SBAR(); QKM(7); SBAR(); VFR(vfa, 7, 0); SBAR();
      if (n + 3 < NT) DMA_K(n + 3, ((n + 3) & 3) * SLOT);
      SBAR();
      PVM(o[0], pa0, vfa, 0); SBAR(); VFR(vfb, 0, 2); SBAR(); PVM(o[1], pa0, vfa, 4); SBAR(); VFR(vfb, 4, 2); SBAR(); PVM(o[0], pa1, vfa, 1); SBAR(); VFR(vfb, 1, 2); SBAR(); PVM(o[1], pa1, vfa, 5); SBAR(); VFR(vfb, 5, 2); SBAR();
      PVM(o[0], pa2, vfa, 2); SBAR(); VFR(vfb, 2, 2); SBAR(); PVM(o[1], pa2, vfa, 6); SBAR(); VFR(vfb, 6, 2); SBAR(); PVM(o[0], pa3, vfa, 3); SBAR(); VFR(vfb, 3, 2); SBAR(); PVM(o[1], pa3, vfa, 7); SBAR(); VFR(vfb, 7, 2); SBAR();
      if (n + 2 < NT) DMA_V(n + 2, v5n2 * SLOT);
      SBAR();
      pv8(o[2], o[3], vfb, pa0, pa1, pa2, pa3);
    } else {
#pragma unroll
      for (int d0 = 0; d0 < 4; ++d0) { p0 = __builtin_amdgcn_mfma_f32_32x32x16_bf16(kf[2 * d0], qr[d0], p0, 0, 0, 0); p1 = __builtin_amdgcn_mfma_f32_32x32x16_bf16(kf[2 * d0 + 1], qr[d0], p1, 0, 0, 0); }
    }
#undef QKM
#undef VFR
#undef PVM
    WAITB(BSZ(n - 2) + BSZ(n - 1));
    __builtin_amdgcn_s_setprio(1);
    u32x4 f0 = {0u, 0u, 0u, 0u}, f1 = {0u, 0u, 0u, 0u};
    if (n > 0) { f0 = *(const u32x4*)(flg + ((n - 1) & 1) * 8); f1 = *(const u32x4*)(flg + ((n - 1) & 1) * 8 + 4); }
    const int tn = NT - 1 - n;
    const float pmv = ((const float*)(lds + LDS_PMX))[c * 128 + (tn > 0 ? tn - 1 : 0)];
    KLOAD(((n + 1) & 3) * SLOT); SBAR();
    if (!(skiplast && n == 0))
      softmax_tile(p0, p1, m_reg, mmin, l_reg, o, slope64 * (float)(NT - 1 - n), (n == 0) || (skiplast && n == 1), (n == 0) ? qloc - 64.0f : qloc, slope2x2, u, whi, w32, al_l, r32, hi, pa0, pa1, pa2, pa3);
    else { pa0 = bf16x8{}; pa1 = bf16x8{}; pa2 = bf16x8{}; pa3 = bf16x8{}; }
    { const float argb = (tn > 0) ? fmaf(qn, pmv, slope64 * (float)(tn - 1) - mmin) : 0.f;
      if (lane == 0) flg[(n & 1) * 8 + wid] = (argb + slope64 < EXIT_ARG) ? 1u : 0u; }
    const bool stop = __builtin_amdgcn_readfirstlane(f0.x & f0.y & f0.z & f0.w & f1.x & f1.y & f1.z & f1.w) != 0u;
    __builtin_amdgcn_s_setprio(0);
    WAITB(BSZ(n - 1));
    v5 = (v5 == 4) ? 0 : v5 + 1;
    if (stop) break;
  }
  __builtin_amdgcn_s_setprio(0);
  float gsc[4];
#pragma unroll
  for (int d0 = 0; d0 < 4; ++d0) gsc[d0] = subln_g[d0 * 32 + r32] * 0.8f;
  { int vbl = vb0 + ((v5 == 0) ? 4 : v5 - 1) * SLOT; asm volatile("" : "+v"(vbl));
    vload8<0>(vfa, vbl); vload8<2>(vfb, vbl); SBAR();
    pv8(o[0], o[1], vfa, pa0, pa1, pa2, pa3);
    SBAR(); asm volatile("s_waitcnt lgkmcnt(0)" ::: "memory"); SBAR();
    pv8(o[2], o[3], vfb, pa0, pa1, pa2, pa3); }
  if (grp == 0) WAITB(0);
  if (probe == 2) {
    WAITB(0);
    if (wid == 1 && lane == 0) *(unsigned*)(lds + LDS_NXT) = __hip_atomic_fetch_add(qctr, 1u, __ATOMIC_RELAXED, __HIP_MEMORY_SCOPE_AGENT);
    if (wid == 0 && lane == 0) Ob[0] = (bf16)__float_as_uint(o[0][0] + o[1][1] + o[2][2] + o[3][3] + l_reg);
    WAITB(0);
    return (int)__builtin_amdgcn_readfirstlane(*(const unsigned*)(lds + LDS_NXT));
  }
  if (hi == 0) li_l[r32] = l_reg; asm volatile("s_waitcnt lgkmcnt(0)" ::: "memory");
  const float sgn = c ? lam : 1.0f;
#pragma unroll
  for (int r = 0; r < 16; ++r) { const float rl = __builtin_amdgcn_rcpf(li_l[crow(r, hi)]) * sgn;
#pragma unroll
    for (int d0 = 0; d0 < 4; ++d0) o[d0][r] *= rl; }
  WAITB(0);
  float* ex = (float*)lds + (size_t)rb * (4 * 16 * 64);
#define EPI_SEND(RS) do { _Pragma("unroll") for (int d0 = 0; d0 < 4; ++d0) _Pragma("unroll") for (int r8 = 0; r8 < 8; ++r8) ex[((c * 4 + d0) * 8 + r8) * 64 + lane] = o[d0][(RS) + r8]; } while (0)
  if (c == 0) { EPI_SEND(8); } else { EPI_SEND(0); }
#undef EPI_SEND
  WAITB(0);
  if (wid == 1 && lane == 0) *(unsigned*)(lds + LDS_NXT) = __hip_atomic_fetch_add(qctr, 1u, __ATOMIC_RELAXED, __HIP_MEMORY_SCOPE_AGENT);
  if (pfQ) {
    int t2 = threadIdx.x; asm volatile("" : "+v"(t2));
    const int id = t2 & 255; const char* a_ = ((t2 < 256) ? pfQ : pfK) + (size_t)(id >> 1) * (LD * 2) + (id & 1) * 128;
    glds4(a_, (unsigned)__builtin_amdgcn_readfirstlane(lds0 + LDS_TCH + wid * 256)); }
  float ss[8]; float vo[4][8];
#define EPI_COMBINE(RK) do { _Pragma("unroll") for (int r8 = 0; r8 < 8; ++r8) { float s_ = 0.f; _Pragma("unroll") for (int d0 = 0; d0 < 4; ++d0) { \
      const float oth_ = ex[(((1 - c) * 4 + d0) * 8 + r8) * 64 + lane]; const float v_ = (c == 0) ? o[d0][(RK) + r8] - oth_ : oth_ - o[d0][(RK) + r8]; vo[d0][r8] = v_; s_ = fmaf(v_, v_, s_); } ss[r8] = s_; } } while (0)
  if (c == 0) { EPI_COMBINE(0); } else { EPI_COMBINE(8); }
#undef EPI_COMBINE
#define RSTEP(M) do { float t_[8]; _Pragma("unroll") for (int r = 0; r < 8; ++r) t_[r] = swz_xor<M>(ss[r]); _Pragma("unroll") for (int r = 0; r < 8; ++r) ss[r] += t_[r]; SBAR(); } while (0)
  RSTEP(1); RSTEP(2); RSTEP(4); RSTEP(8); RSTEP(16);
#undef RSTEP
  bf16* stg = (bf16*)(lds + LDS_V) + wid * (16 * 136);
#pragma unroll
  for (int r8 = 0; r8 < 8; ++r8) { const float rs = __builtin_amdgcn_rsqf(ss[r8] * (1.0f / 128.0f) + 1e-5f); const int orow = (r8 & 3) + 8 * (r8 >> 2) + 4 * hi;
#pragma unroll
    for (int d0 = 0; d0 < 4; ++d0) { const float v = vo[d0][r8] * rs * gsc[d0]; stg[orow * 136 + d0 * 32 + r32] = (bf16)(cvtpk(v, v) & 0xffffu); } }
  asm volatile("s_waitcnt lgkmcnt(0)" ::: "memory");
  { bf16* Ow = Ob + (long)(rb * QBLK + c * 16) * LD;
    int lane2 = lane; asm volatile("" : "+v"(lane2));
    const int srow = lane2 >> 4, sch = lane2 & 15; const bf16* sp = stg + srow * 136 + sch * 8; bf16* gp = Ow + (long)srow * LD + sch * 8;
#pragma unroll
    for (int q = 0; q < 4; ++q) { const u32x4 v = *(const u32x4*)(sp + q * 4 * 136); *(u32x4*)(gp + (long)q * 4 * LD) = v; } }
  SBAR(); asm volatile("s_waitcnt lgkmcnt(0)\n\ts_barrier" ::: "memory"); SBAR();
  return (int)__builtin_amdgcn_readfirstlane(*(const unsigned*)(lds + LDS_NXT));
#undef DMA_K
#undef DMA_V
#undef WAITB
#undef BSZ
#undef KLOAD
}
#undef SBAR
#undef WAIT_BAR
}

#define GAS __attribute__((address_space(1)))
#define LAS __attribute__((address_space(3)))
typedef unsigned short bf16;
typedef unsigned v4u __attribute__((ext_vector_type(4)));
typedef float f32x4 __attribute__((ext_vector_type(4)));
typedef short bf16x8 __attribute__((ext_vector_type(8)));
typedef GAS unsigned gu32;
typedef GAS unsigned long long gu64;
#define RLX_AGENT __ATOMIC_RELAXED, __HIP_MEMORY_SCOPE_AGENT
#define LDS_WAIT() asm volatile("s_waitcnt lgkmcnt(0)" ::: "memory")
#define VM_WAIT() asm volatile("s_waitcnt vmcnt(0)" ::: "memory")
__device__ __forceinline__ unsigned long long rt() { return __builtin_amdgcn_s_memrealtime(); }
__device__ __forceinline__ unsigned f2bf(float f) { unsigned u = __builtin_bit_cast(unsigned, f); return (u + 0x7fffu + ((u >> 16) & 1u)) >> 16; }
__device__ __forceinline__ unsigned pk2(float lo, float hi) { unsigned r; asm("v_cvt_pk_bf16_f32 %0, %1, %2" : "=v"(r) : "v"(lo), "v"(hi)); return r; }

#define XB_TMO      128
#define XB_XCNT(j)  (256  + 64 * (j))
#define XB_XSUB(j)  (1280 + 64 * (j))
#define XB_XGEN(j)  (2304 + 64 * (j))
#define XB_TOP      3328
#define XB_TOPGEN   3392
#define XCD_BAR_WORDS 3456
#define XB_SPIN_CAP (1u << 18)

__device__ __forceinline__ unsigned xb_ld(unsigned* p)              { return __hip_atomic_load(p, __ATOMIC_RELAXED, __HIP_MEMORY_SCOPE_AGENT); }
__device__ __forceinline__ unsigned xb_add(unsigned* p, unsigned v) { return __hip_atomic_fetch_add(p, v, __ATOMIC_RELAXED, __HIP_MEMORY_SCOPE_AGENT); }
__device__ __forceinline__ unsigned xb_xcc_id() { return (unsigned)__builtin_amdgcn_s_getreg((3 << 11) | 20) & 0xFu; }
#define XB_SPIN(cond, bar) do { unsigned _sp = 0; while (cond) { __builtin_amdgcn_s_sleep(1); \
    if ((++_sp & 255u) == 0u) { if (xb_ld(&(bar)[XB_TMO])) break; if (_sp > XB_SPIN_CAP) { atomicAdd(&(bar)[XB_TMO], 1u); break; } } } } while (0)

struct XcdBarrier {
    unsigned* bar; unsigned x;
    volatile LAS unsigned* st;
};

__device__ __forceinline__ XcdBarrier xcd_barrier_post(unsigned* bar, volatile LAS unsigned* st) {
    XcdBarrier b; b.bar = bar; b.x = xb_xcc_id(); b.st = st;
    if (threadIdx.x == 0) (void)xb_add(&bar[XB_XCNT(b.x)], 1u);
    return b;
}
__device__ __forceinline__ void xcd_barrier_complete(unsigned* bar, unsigned x, unsigned& nloc, unsigned& nx) {
    const unsigned G = gridDim.x * gridDim.y * gridDim.z;
    unsigned sum, cnt, mine, sp = 0u;
    for (;;) {
        sum = 0u; cnt = 0u; mine = 0u;
#pragma unroll
        for (unsigned j = 0; j < 16; ++j) { const unsigned c = xb_ld(&bar[XB_XCNT(j)]); sum += c; cnt += (c > 0u) ? 1u : 0u; mine = (j == x) ? c : mine; }
        if (sum == G) break;
        __builtin_amdgcn_s_sleep(1);
        if ((++sp & 255u) == 0u) { if (xb_ld(&bar[XB_TMO])) break; if (sp > XB_SPIN_CAP) { atomicAdd(&bar[XB_TMO], 1u); break; } }
    }
    nloc = mine > 0u ? mine : 1u; nx = cnt > 0u ? cnt : 1u;
}

__device__ __forceinline__ void xcd_barrier(const XcdBarrier& b) {
    asm volatile("s_waitcnt vmcnt(0)" ::: "memory");
    __syncthreads();
    if (threadIdx.x == 0) {
        unsigned* bar = b.bar;
        __builtin_amdgcn_s_waitcnt(0);
        unsigned nloc = b.st[0], nx = b.st[1];
        if (nloc == 0u) { xcd_barrier_complete(bar, b.x, nloc, nx); b.st[0] = nloc; b.st[1] = nx; }
        const unsigned old = xb_add(&bar[XB_XSUB(b.x)], 1u);
        const unsigned gen = old / nloc;
        if (old + 1u == (gen + 1u) * nloc) {
            __builtin_amdgcn_fence(__ATOMIC_RELEASE, "agent");
            asm volatile("s_waitcnt vmcnt(0)" ::: "memory");
            const unsigned og = xb_add(&bar[XB_TOP], 1u);
            const unsigned tg = og / nx;
            if (og + 1u == (tg + 1u) * nx) xb_add(&bar[XB_TOPGEN], 1u);
            else XB_SPIN(xb_ld(&bar[XB_TOPGEN]) == tg, bar);
            __builtin_amdgcn_fence(__ATOMIC_ACQUIRE, "agent");
            xb_add(&bar[XB_XGEN(b.x)], 1u);
            asm volatile("s_waitcnt vmcnt(0)" ::: "memory");
        } else {
            XB_SPIN(xb_ld(&bar[XB_XGEN(b.x)]) == gen, bar);
            __builtin_amdgcn_fence(__ATOMIC_ACQUIRE, "agent");
            asm volatile("s_waitcnt vmcnt(0)" ::: "memory");
        }
    }
    __syncthreads();
}

typedef unsigned v2u __attribute__((ext_vector_type(2)));

constexpr int NWAVES = 8, NTHREADS = NWAVES * 64;
constexpr int BATCH = 8, SEQ = 8192, D = 1024, T = BATCH * SEQ;
constexpr int INW = 6144, GW = 512, NHEAD = 8;
constexpr int NEXP = 32, EHID = 512, NASSIGN = T * 2;
constexpr int MAXTILES = (NASSIGN + NEXP * 255) / 256 + 1;
constexpr int MOE_CAP = NASSIGN;
constexpr float LN_EPS = 1e-5f;
constexpr float ALPHA = 1.189207115002721f;
constexpr float C2 = 0.125f * 1.4426950408889634f;
constexpr int NPHASE = 12;
constexpr unsigned STAGGER_P1_TICKS = 900;
#ifndef MK_ONE_LAUNCH
#define MK_ONE_LAUNCH 1
#endif
#ifndef MK_PROBE_PHASE
#define MK_PROBE_PHASE -1
#endif

constexpr size_t MiB = 1u << 20;
constexpr size_t WS_CTL = 0, CTL_ZERO_BYTES = 64 * 1024;
constexpr size_t WS_ROUTE_E = 1 * MiB;
constexpr size_t WS_ROUTE_W = WS_ROUTE_E + (size_t)NASSIGN * 4;
constexpr size_t WS_SLOT_TOK = WS_ROUTE_W + (size_t)NASSIGN * 4;
constexpr size_t WS_SLOT_W = WS_SLOT_TOK + (size_t)MAXTILES * 256 * 4;
constexpr size_t WS_TILE_E = WS_SLOT_W + (size_t)MAXTILES * 256 * 4;
constexpr size_t WS_TILE_ROWS = WS_TILE_E + 4096;
constexpr size_t WS_KN2 = WS_TILE_ROWS + 4096;
constexpr size_t WS_PMX = WS_KN2 + 8 * 8 * 2 * 128 * 4;
constexpr size_t WS_MISC_END = WS_PMX + 8 * 8 * 2 * 128 * 4;
static_assert(WS_MISC_END <= 4 * MiB, "misc tables");
constexpr size_t WS_WIN = 4 * MiB;
constexpr size_t WS_WA = 16 * MiB;
constexpr size_t WS_WB = 17 * MiB;
constexpr size_t WS_WO = 19 * MiB;
constexpr size_t WS_SGW = 21 * MiB;
constexpr size_t WS_WGU = 22 * MiB;
constexpr size_t WS_WD = 86 * MiB;
constexpr size_t WS_XB = 128 * MiB;
constexpr size_t WS_Q = 256 * MiB;
constexpr size_t WS_K = 384 * MiB, WS_VAL = 512 * MiB, WS_GA = 640 * MiB, WS_GB = 768 * MiB;
constexpr size_t WS_LIST_TOK = 384 * MiB, WS_LIST_W = 416 * MiB;
static_assert((size_t)NEXP * MOE_CAP * 4 + 1024 <= 32 * MiB, "dispatch lists");
constexpr size_t WS_PART = 256 * MiB;
constexpr size_t WS_STATS = 272 * MiB;
constexpr size_t WS_XS = 256 * MiB;
constexpr size_t WS_HB = 528 * MiB;
constexpr size_t WS_FFN = 664 * MiB;
constexpr size_t WS_END = 920 * MiB;
static_assert(WS_XS + (size_t)MAXTILES * 256 * 1024 * 2 <= WS_HB && WS_HB + (size_t)MAXTILES * 256 * 512 * 2 <= WS_FFN && WS_FFN + (size_t)NASSIGN * 1024 * 2 <= WS_END, "moe buffers");
constexpr size_t OUT_UV = 0, OUT_SG = 128 * MiB;
constexpr int CW_BAR = 1024;
constexpr int CW_CNT = 12288;
constexpr int CW_CUR = 12288 + 64;
constexpr int CW_AQ = 12288 + 128;
static_assert((CW_BAR + 3 * 3456) <= CW_CNT && (CW_AQ + 3 * 512) * 4 <= (int)CTL_ZERO_BYTES, "ctl map");

constexpr int RING_OFF = 0, RING_BYTES = 155648;
constexpr int LDSCTL_OFF = RING_BYTES, MISC_OFF = LDSCTL_OFF + 320;
constexpr int MOE_LDS_OFF = 131072;
static_assert(MOE_LDS_OFF + pg8::MOE_LDS_BYTES <= RING_BYTES && MOE_LDS_OFF + INW * 4 <= RING_BYTES, "MoE LDS tables / P1 bias copy");
constexpr int LDS_BYTES = 163840;
static_assert(MISC_OFF + 128 <= LDS_BYTES, "LDS map");

__device__ __forceinline__ float wave_sum(float v) {
#pragma unroll
    for (int o = 1; o < 64; o <<= 1) v += __shfl_xor(v, o);
    return v;
}

__device__ __forceinline__ void p0_transpose_item(const float* W, int K, int N, bf16* WT, int row_off, LAS float* scr, int item, int lane) {
    const int nblk = N / 32, kb = item / nblk, nb = item % nblk, k0 = 64 * kb, n0 = 32 * nb;
    float tv[32];
#pragma unroll
    for (int i = 0; i < 32; ++i) tv[i] = W[(size_t)(k0 + 2 * i + (lane >> 5)) * N + n0 + (lane & 31)];
#pragma unroll
    for (int i = 0; i < 32; ++i) scr[(2 * i + (lane >> 5)) * 33 + (lane & 31)] = tv[i];
    LDS_WAIT(); asm volatile("" ::: "memory");
    const int c = lane & 7;
#pragma unroll
    for (int j = 0; j < 4; ++j) { const int n = (lane >> 3) + 8 * j; const LAS float* s = scr + (8 * c) * 33 + n;
        v4u o; o.x = pk2(s[0 * 33], s[1 * 33]); o.y = pk2(s[2 * 33], s[3 * 33]); o.z = pk2(s[4 * 33], s[5 * 33]); o.w = pk2(s[6 * 33], s[7 * 33]);
        *(GAS v4u*)(WT + (size_t)(row_off + n0 + n) * K + k0 + 8 * c) = o; }
    LDS_WAIT(); asm volatile("" ::: "memory");
}
struct P0Args { const float *x, *w_in, *w_a, *w_b, *w_out, *sg_w, *w_gate, *w_up, *w_down; bf16 *win_t, *wa_t, *wb_t, *wo_t, *sgw, *wgu_t, *wd_t, *xb; };
__device__ __forceinline__ void p0_prologue(const P0Args& a, LAS unsigned char* lds, int gw, int NGW, int wave, int lane) {
    LAS float* scr = (LAS float*)(lds + RING_OFF + wave * 16384);
    constexpr int I_IN = (D / 64) * (INW / 32), I_A = (GW / 64) * (D / 32), I_B = (D / 64) * (D / 32), I_O = I_B;
    constexpr int I_G1 = (D / 64) * (EHID / 32), I_G = NEXP * I_G1, I_D1 = (EHID / 64) * (D / 32), I_DN = NEXP * I_D1;
    constexpr int NITEMS = I_IN + I_A + I_B + I_O + 2 * I_G + I_DN;
    for (int it = gw; it < NITEMS; it += NGW) {
        int r = it;
        if (r < I_IN) { p0_transpose_item(a.w_in, D, INW, a.win_t, 0, scr, r, lane); continue; } r -= I_IN;
        if (r < I_A) { p0_transpose_item(a.w_a, GW, D, a.wa_t, 0, scr, r, lane); continue; } r -= I_A;
        if (r < I_B) { p0_transpose_item(a.w_b, D, D, a.wb_t, 0, scr, r, lane); continue; } r -= I_B;
        if (r < I_O) { p0_transpose_item(a.w_out, D, D, a.wo_t, 0, scr, r, lane); continue; } r -= I_O;
        if (r < 2 * I_G) {
            const int which = r >= I_G; if (which) r -= I_G;
            const int e = r / I_G1, item = r % I_G1, nb = item % (EHID / 32), n0 = nb * 32, ct = n0 >> 7;
            const int row_off = e * 1024 + ct * 128 + which * 128;
            p0_transpose_item((which ? a.w_up : a.w_gate) + (size_t)e * D * EHID, D, EHID, a.wgu_t, row_off, scr, item, lane); continue; }
        r -= 2 * I_G;
        { const int e = r / I_D1, item = r % I_D1; p0_transpose_item(a.w_down + (size_t)e * EHID * D, EHID, D, a.wd_t, e * 1024, scr, item, lane); }
    }
    for (int idx = gw * 64 + lane; idx < 8 * 128 * 128; idx += NGW * 64) { const int s = idx & 127, t = (idx >> 7) & 127; const float w = a.sg_w[idx]; a.sgw[idx] = (bf16)f2bf(((t >> 6) >= (s >> 6)) ? w : 0.f); }
    const size_t n8 = (size_t)T * D / 8;
    for (size_t idx = (size_t)gw * 64 + lane; idx < n8; idx += (size_t)NGW * 64) { const f32x4 v0 = *(const GAS f32x4*)(a.x + idx * 8), v1 = *(const GAS f32x4*)(a.x + idx * 8 + 4);
        v4u o; o.x = pk2(v0.x, v0.y); o.y = pk2(v0.z, v0.w); o.z = pk2(v1.x, v1.y); o.w = pk2(v1.z, v1.w); *(GAS v4u*)(a.xb + idx * 8) = o; }
}

__device__ __forceinline__ void p2_knorm(const bf16* KB, float* kn2, int gw, int NGW, int lane) {
    for (int it = gw; it < BATCH * NHEAD * 2 * 128; it += NGW) {
        const int t = it & 127, c = (it >> 7) & 1, h = (it >> 8) & 7, b = it >> 11;
        const GAS v4u* kp = (const GAS v4u*)(KB + ((size_t)b * SEQ + (size_t)t * 64 + lane) * D + h * 128 + c * 64);
        float s = 0.f;
#pragma unroll
        for (int q = 0; q < 8; ++q) { const v4u w = kp[q];
#pragma unroll
            for (int e = 0; e < 4; ++e) { const float x = __uint_as_float(w[e] << 16), y = __uint_as_float(w[e] & 0xffff0000u); s = fmaf(x, x, s); s = fmaf(y, y, s); } }
#pragma unroll
        for (int o = 1; o < 64; o <<= 1) s = fmaxf(s, __shfl_xor(s, o));
        if (lane == 0) kn2[it] = s;
    }
}

__device__ __forceinline__ void p3_pmx(const float* kn2, float* pmx, int gw, int lane) {
    if (gw < BATCH * NHEAD * 2) {
        float a = kn2[gw * 128 + lane], b2 = kn2[gw * 128 + 64 + lane];
#pragma unroll
        for (int off = 1; off < 64; off <<= 1) { const float ta = __shfl_up(a, off), tb = __shfl_up(b2, off); if (lane >= off) { a = fmaxf(a, ta); b2 = fmaxf(b2, tb); } }
        const float tot = __shfl(a, 63); b2 = fmaxf(b2, tot);
        pmx[gw * 128 + lane] = sqrtf(a) * 1.001f; pmx[gw * 128 + 64 + lane] = sqrtf(b2) * 1.001f;
    }
}

constexpr int P2_PITCH = 136;
__device__ __forceinline__ void p2_gmlp(const bf16* UV, bf16* SG, const bf16* SGW, const float* ln_g, const float* ln_b, const float* sg_b, LAS unsigned char* lds, int G) {
    typedef float f32x2v __attribute__((ext_vector_type(2)));
    LAS bf16* vnT = (LAS bf16*)lds;
    LAS f32x2v* red = (LAS f32x2v*)(lds + 256 * P2_PITCH * 2);
    const int tid = threadIdx.x, lane = tid & 63, wave = __builtin_amdgcn_readfirstlane(tid >> 6), fr = lane & 15, fq = lane >> 4;
    for (int unit = blockIdx.x; unit < 1024; unit += G) {
        const int blk = unit >> 1, half = unit & 1, row0 = blk * 128;
        const int s = tid & 127, cg = __builtin_amdgcn_readfirstlane(tid >> 7);
        const bf16* vrow = UV + (size_t)(row0 + s) * 1024 + 512;
        float s1 = 0.f, s2 = 0.f;
#pragma unroll
        for (int q = 0; q < 16; ++q) { const v4u w = *(const GAS v4u*)(vrow + cg * 128 + q * 8);
#pragma unroll
            for (int e = 0; e < 4; ++e) { const float a = __uint_as_float(w[e] << 16), b = __uint_as_float(w[e] & 0xffff0000u); s1 += a + b; s2 += a * a + b * b; } }
        red[cg * 128 + s] = (f32x2v){s1, s2};
        __syncthreads();
        float t1 = 0.f, t2 = 0.f;
#pragma unroll
        for (int k = 0; k < 4; ++k) { const f32x2v p = red[k * 128 + s]; t1 += p.x; t2 += p.y; }
        const float mean = t1 * (1.f / 512.f), var = fmaxf(t2 * (1.f / 512.f) - mean * mean, 0.f), rstd = 1.0f / sqrtf(var + LN_EPS);
        const int g = half * 4 + cg;
#pragma unroll
        for (int q = 0; q < 8; ++q) { const v4u w = *(const GAS v4u*)(vrow + g * 64 + q * 8);
#pragma unroll
            for (int e = 0; e < 4; ++e) { const int c0 = q * 8 + 2 * e;
                const float a = (__uint_as_float(w[e] << 16) - mean) * rstd * ln_g[g * 64 + c0] + ln_b[g * 64 + c0];
                const float b = (__uint_as_float(w[e] & 0xffff0000u) - mean) * rstd * ln_g[g * 64 + c0 + 1] + ln_b[g * 64 + c0 + 1];
                vnT[(cg * 64 + c0) * P2_PITCH + s] = (bf16)f2bf(a); vnT[(cg * 64 + c0 + 1) * P2_PITCH + s] = (bf16)f2bf(b); } }
        __syncthreads();
        const int gl = wave >> 1, th = wave & 1, gg = half * 4 + gl;
        f32x4 acc[4][4];
#pragma unroll
        for (int a = 0; a < 4; ++a)
#pragma unroll
            for (int b = 0; b < 4; ++b) acc[a][b] = (f32x4){0.f, 0.f, 0.f, 0.f};
        const int nks = th ? 4 : 2;
        for (int ks = 0; ks < nks; ++ks) {
            bf16x8 wf[4], vf[4];
#pragma unroll
            for (int tt = 0; tt < 4; ++tt) wf[tt] = *(const GAS bf16x8*)(SGW + ((size_t)(gg * 128 + th * 64 + tt * 16 + fr) * 128 + ks * 32 + fq * 8));
#pragma unroll
            for (int ct = 0; ct < 4; ++ct) vf[ct] = *(const LAS bf16x8*)(vnT + (gl * 64 + 32 * (ct >> 1) + 8 * (fr >> 2) + 4 * (ct & 1) + (fr & 3)) * P2_PITCH + ks * 32 + fq * 8);
#pragma unroll
            for (int tt = 0; tt < 4; ++tt)
#pragma unroll
                for (int ct = 0; ct < 4; ++ct) acc[tt][ct] = __builtin_amdgcn_mfma_f32_16x16x32_bf16(vf[ct], wf[tt], acc[tt][ct], 0, 0, 0);
        }
#pragma unroll
        for (int tt = 0; tt < 4; ++tt) { const int t = th * 64 + tt * 16 + fr; const float bs = sg_b[gg * 128 + t];
#pragma unroll
            for (int cp = 0; cp < 2; ++cp) { const int c0 = gg * 64 + 32 * cp + 8 * fq;
                const v4u uw = *(const GAS v4u*)(UV + (size_t)(row0 + t) * 1024 + c0);
                const f32x4 a = acc[tt][2 * cp], b = acc[tt][2 * cp + 1];
                v4u o;
                o.x = pk2(__uint_as_float(uw.x << 16) * (a[0] + bs), __uint_as_float(uw.x & 0xffff0000u) * (a[1] + bs));
                o.y = pk2(__uint_as_float(uw.y << 16) * (a[2] + bs), __uint_as_float(uw.y & 0xffff0000u) * (a[3] + bs));
                o.z = pk2(__uint_as_float(uw.z << 16) * (b[0] + bs), __uint_as_float(uw.z & 0xffff0000u) * (b[1] + bs));
                o.w = pk2(__uint_as_float(uw.w << 16) * (b[2] + bs), __uint_as_float(uw.w & 0xffff0000u) * (b[3] + bs));
                *(GAS v4u*)(SG + (size_t)(row0 + t) * 512 + c0) = o; } }
        __syncthreads();
    }
}

typedef float f32x2v __attribute__((ext_vector_type(2)));
constexpr int P7_WPITCH = 52;
__device__ __forceinline__ void p7_ln_route(const float* H, const float* part, float* stats, bf16* H1B, const float* ln_g, const float* ln_b, const float* w_group, const float* b_group, const float* w_expert, const float* b_expert,
                                            int* list_tok, float* list_w, unsigned* cnt, LAS unsigned char* lds, int G, bool dry = false) {
    constexpr int WLB = 256 * P7_WPITCH * 4;
    LAS float* WL0 = (LAS float*)lds;
    LAS float* LG = (LAS float*)(lds + 2 * WLB);
    LAS unsigned* hist = (LAS unsigned*)(lds + 2 * WLB + 8 * 16 * 48 * 4);
    LAS unsigned* ebase = hist + 32;
    LAS float* LNG = (LAS float*)(lds + 2 * WLB + 8 * 16 * 48 * 4 + 256);
    LAS float* LBI = LNG + 2 * D;
    static_assert(2 * WLB + 8 * 16 * 48 * 4 + 256 + 2 * D * 4 + 256 <= RING_BYTES, "P7 LDS map");
    const int tid = threadIdx.x, lane = tid & 63, wave = __builtin_amdgcn_readfirstlane(tid >> 6), li = lane & 15, kq = lane >> 4;
    if (tid < 32) hist[tid] = 0u;
    for (int i = tid; i < 2 * 256 * 3; i += NTHREADS) *(LAS f32x4*)(WL0 + (i / 3) * P7_WPITCH + 36 + 4 * (i % 3)) = (f32x4){0.f, 0.f, 0.f, 0.f};
    for (int i = tid; i < D / 4; i += NTHREADS) { ((LAS f32x4*)LNG)[i] = ((const GAS f32x4*)ln_g)[i]; ((LAS f32x4*)(LNG + D))[i] = ((const GAS f32x4*)ln_b)[i]; }
    if (tid < 4) LBI[tid] = b_group[tid]; else if (tid < 36) LBI[tid] = b_expert[tid - 4];
#define P7_WLOAD(we, wg, ch_) do { _Pragma("unroll") for (int q = 0; q < 4; ++q) we[q] = *((const GAS f32x4*)(w_expert + (size_t)(ch_) * 256 * 32) + tid + q * NTHREADS); \
        wg = (f32x4){0.f, 0.f, 0.f, 0.f}; if (tid < 256) wg = *((const GAS f32x4*)(w_group + (size_t)(ch_) * 256 * 4) + tid); } while (0)
#define P7_WSTORE(we, wg, buf) do { LAS float* W_ = WL0 + (buf) * (WLB / 4); _Pragma("unroll") for (int q = 0; q < 4; ++q) { const int f = (tid + q * NTHREADS) * 4, kl = f >> 5, n = f & 31; *(LAS f32x4*)(W_ + kl * P7_WPITCH + 4 + n) = we[q]; } \
        if (tid < 256) *(LAS f32x4*)(W_ + tid * P7_WPITCH) = wg; } while (0)
#define P7_VLOAD(vv, hrow_, ch_) do { _Pragma("unroll") for (int g = 0; g < 8; ++g) { vv[2 * g] = *(const GAS f32x4*)((hrow_) + (ch_) * 256 + 32 * g); vv[2 * g + 1] = *(const GAS f32x4*)((hrow_) + (ch_) * 256 + 32 * g + 4); } } while (0)
    f32x4 vc[16], we[4], wg;
    const int rd0 = blockIdx.x;
    if (rd0 < T / 128) { P7_WLOAD(we, wg, 0); P7_VLOAD(vc, H + (size_t)(rd0 * 128 + wave * 16 + li) * D + 8 * kq, 0); P7_WSTORE(we, wg, 0); }
    __syncthreads();
    for (int rd = blockIdx.x; rd < T / 128; rd += G) {
        const int R0 = rd * 128 + wave * 16;
        const float* hrow = H + (size_t)(R0 + li) * D + 8 * kq;
        const int rdn = (rd + G < T / 128) ? rd + G : rd;
        const float* hrown = H + (size_t)(rdn * 128 + wave * 16 + li) * D + 8 * kq;
        float s1 = 0.f, s2 = 0.f;
        { const f32x4 pa = *(const GAS f32x4*)(part + (size_t)(R0 + li) * 32 + kq * 8), pb = *(const GAS f32x4*)(part + (size_t)(R0 + li) * 32 + kq * 8 + 4);
          s1 = (pa.x + pa.z) + (pb.x + pb.z); s2 = (pa.y + pa.w) + (pb.y + pb.w); }
        s1 += __shfl_xor(s1, 16); s1 += __shfl_xor(s1, 32); s2 += __shfl_xor(s2, 16); s2 += __shfl_xor(s2, 32);
        const float mean = s1 * (1.f / D), var = fmaxf(s2 * (1.f / D) - mean * mean, 0.f), rstd = 1.0f / sqrtf(var + LN_EPS);
        if (kq == 0) *(GAS f32x2v*)(stats + (size_t)(R0 + li) * 2) = (f32x2v){mean, rstd};
        f32x4 acc[3];
#pragma unroll
        for (int n = 0; n < 3; ++n) acc[n] = (f32x4){0.f, 0.f, 0.f, 0.f};
#pragma unroll 1
        for (int ch = 0; ch < 4; ++ch) {
            f32x4 vn[16];
            P7_WLOAD(we, wg, (ch + 1) & 3); P7_VLOAD(vn, (ch == 3) ? hrown : hrow, (ch + 1) & 3);
            __builtin_amdgcn_sched_barrier(0);
            const LAS float* W = WL0 + (ch & 1) * (WLB / 4);
#pragma unroll
            for (int g = 0; g < 8; ++g) { const int cl = 32 * g + 8 * kq, col = ch * 256 + cl;
                float wv[24];
#pragma unroll
                for (int e8 = 0; e8 < 8; ++e8)
#pragma unroll
                    for (int n = 0; n < 3; ++n) wv[e8 * 3 + n] = W[(cl + e8) * P7_WPITCH + li + 16 * n];
                __builtin_amdgcn_sched_barrier(0);
                float h[8];
#pragma unroll
                for (int q = 0; q < 2; ++q) { const f32x4 v = vc[2 * g + q]; const f32x4 gv = *(const LAS f32x4*)(LNG + col + 4 * q), bv = *(const LAS f32x4*)(LNG + D + col + 4 * q);
                    h[4 * q] = (v.x - mean) * rstd * gv.x + bv.x; h[4 * q + 1] = (v.y - mean) * rstd * gv.y + bv.y; h[4 * q + 2] = (v.z - mean) * rstd * gv.z + bv.z; h[4 * q + 3] = (v.w - mean) * rstd * gv.w + bv.w; }
                v4u o; o.x = pk2(h[0], h[1]); o.y = pk2(h[2], h[3]); o.z = pk2(h[4], h[5]); o.w = pk2(h[6], h[7]); *(GAS v4u*)(H1B + (size_t)(R0 + li) * D + col) = o;
#pragma unroll
                for (int e8 = 0; e8 < 8; ++e8)
#pragma unroll
                    for (int n = 0; n < 3; ++n) acc[n] = __builtin_amdgcn_mfma_f32_16x16x4f32(h[e8], wv[e8 * 3 + n], acc[n], 0, 0, 0); }
            __builtin_amdgcn_sched_barrier(0);
            P7_WSTORE(we, wg, (ch + 1) & 1);
#pragma unroll
            for (int q = 0; q < 16; ++q) vc[q] = vn[q];
            __syncthreads();
        }
        LAS float* lg = LG + wave * 16 * 48;
#pragma unroll
        for (int n = 0; n < 3; ++n)
#pragma unroll
            for (int r = 0; r < 4; ++r) lg[(4 * kq + r) * 48 + 16 * n + li] = acc[n][r];
        LDS_WAIT(); asm volatile("" ::: "memory");
        int e0 = 0, e1 = 0; unsigned r0 = 0u, r1 = 0u; float wt0 = 0.f, wt1 = 0.f;
        if (lane < 16) {
            const LAS float* l = lg + lane * 48;
            float gl[4]; int gs = 0; float gm;
#pragma unroll
            for (int q = 0; q < 4; ++q) gl[q] = l[q] + LBI[q];
            gm = gl[0];
#pragma unroll
            for (int q = 1; q < 4; ++q) if (gl[q] > gm) { gm = gl[q]; gs = q; }
            float den = 0.f;
#pragma unroll
            for (int q = 0; q < 4; ++q) den += __expf(gl[q] - gm);
            const float gwt = 1.0f / den;
            float ev[8];
#pragma unroll
            for (int q = 0; q < 8; ++q) ev[q] = l[4 + gs * 8 + q] + LBI[4 + gs * 8 + q];
            int i0 = 0; float v0 = ev[0];
#pragma unroll
            for (int q = 1; q < 8; ++q) if (ev[q] > v0) { v0 = ev[q]; i0 = q; }
            int i1 = -1; float v1 = -3.0e38f;
#pragma unroll
            for (int q = 0; q < 8; ++q) if (q != i0 && ev[q] > v1) { v1 = ev[q]; i1 = q; }
            const float ex = __expf(v1 - v0), p0 = 1.0f / (1.0f + ex), p1 = ex * p0;
            e0 = gs * 8 + i0; e1 = gs * 8 + i1; wt0 = p0 * gwt; wt1 = p1 * gwt;
            r0 = __hip_atomic_fetch_add(&hist[e0], 1u, __ATOMIC_RELAXED, __HIP_MEMORY_SCOPE_WORKGROUP); r1 = __hip_atomic_fetch_add(&hist[e1], 1u, __ATOMIC_RELAXED, __HIP_MEMORY_SCOPE_WORKGROUP);
        }
        __syncthreads();
        if (tid < 32) { const unsigned n = hist[tid]; hist[tid] = 0u; ebase[tid] = (n && !dry) ? __hip_atomic_fetch_add(cnt + tid, n, RLX_AGENT) : 0u; }
        __syncthreads();
        if (lane < 16 && !dry) { const int tok = R0 + lane;
            const size_t s0 = (size_t)e0 * MOE_CAP + ebase[e0] + r0, s1 = (size_t)e1 * MOE_CAP + ebase[e1] + r1;
            list_tok[s0] = tok * 2; list_w[s0] = wt0; list_tok[s1] = tok * 2 + 1; list_w[s1] = wt1; }
    }
}

#undef P7_WLOAD
#undef P7_WSTORE
#undef P7_VLOAD
__device__ __forceinline__ void p11_final(float* H, const bf16* H1, const bf16* FFN, const float* ln_g, const float* ln_b, int gw, int NGW, int lane) {
    f32x4 G4[4], B4[4];
#pragma unroll
    for (int j = 0; j < 4; ++j) { G4[j] = *((const GAS f32x4*)ln_g + lane + 64 * j); B4[j] = *((const GAS f32x4*)ln_b + lane + 64 * j); }
    v2u nh[4], na[4], nb[4];
    if (gw < T) {
        const GAS v2u* hp = (const GAS v2u*)(H1 + (size_t)gw * D) + lane; const GAS v2u* f0 = (const GAS v2u*)(FFN + (size_t)(2 * gw) * D) + lane; const GAS v2u* f1 = (const GAS v2u*)(FFN + (size_t)(2 * gw + 1) * D) + lane;
#pragma unroll
        for (int j = 0; j < 4; ++j) { nh[j] = hp[64 * j]; na[j] = f0[64 * j]; nb[j] = f1[64 * j]; }
    }
    for (int m = gw; m < T; m += NGW) {
        GAS f32x4* hr = (GAS f32x4*)(H + (size_t)m * D) + lane;
        v2u ch[4], ca[4], cb[4];
#pragma unroll
        for (int j = 0; j < 4; ++j) { ch[j] = nh[j]; ca[j] = na[j]; cb[j] = nb[j]; }
        { const int mn = (m + NGW < T) ? m + NGW : m;
          const GAS v2u* hp = (const GAS v2u*)(H1 + (size_t)mn * D) + lane; const GAS v2u* f0 = (const GAS v2u*)(FFN + (size_t)(2 * mn) * D) + lane; const GAS v2u* f1 = (const GAS v2u*)(FFN + (size_t)(2 * mn + 1) * D) + lane;
#pragma unroll
          for (int j = 0; j < 4; ++j) { nh[j] = hp[64 * j]; na[j] = f0[64 * j]; nb[j] = f1[64 * j]; } }
        f32x4 v[4]; float s = 0.f;
#pragma unroll
        for (int j = 0; j < 4; ++j) { const v2u hb = ch[j]; const v2u a = ca[j], b = cb[j];
            v[j].x = __uint_as_float(hb.x << 16) * ALPHA + (__uint_as_float(a.x << 16) + __uint_as_float(b.x << 16)); v[j].y = __uint_as_float(hb.x & 0xffff0000u) * ALPHA + (__uint_as_float(a.x & 0xffff0000u) + __uint_as_float(b.x & 0xffff0000u));
            v[j].z = __uint_as_float(hb.y << 16) * ALPHA + (__uint_as_float(a.y << 16) + __uint_as_float(b.y << 16)); v[j].w = __uint_as_float(hb.y & 0xffff0000u) * ALPHA + (__uint_as_float(a.y & 0xffff0000u) + __uint_as_float(b.y & 0xffff0000u));
            s += (v[j].x + v[j].y) + (v[j].z + v[j].w); }
        const float mean = wave_sum(s) * (1.f / D); float s2 = 0.f;
#pragma unroll
        for (int j = 0; j < 4; ++j) { v[j] = v[j] - mean; s2 += (v[j].x * v[j].x + v[j].y * v[j].y) + (v[j].z * v[j].z + v[j].w * v[j].w); }
        const float rstd = 1.f / sqrtf(wave_sum(s2) * (1.f / D) + LN_EPS);
#pragma unroll
        for (int j = 0; j < 4; ++j) { const f32x4 g = G4[j], b = B4[j];
            f32x4 o; o.x = v[j].x * rstd * g.x + b.x; o.y = v[j].y * rstd * g.y + b.y; o.z = v[j].z * rstd * g.z + b.z; o.w = v[j].w * rstd * g.w + b.w; hr[64 * j] = o; }
    }
}
#ifndef PROBE_SHORT_UNITS
#define PROBE_SHORT_UNITS 0
#endif

enum { I_X = 0, I_WIN, I_BIN, I_SGLNG, I_SGLNB, I_SGW, I_SGB, I_WA, I_LQ1, I_LK1, I_LQ2, I_LK2, I_SUBLN, I_WB, I_WOUT, I_LN1G, I_LN1B, I_WGRP, I_BGRP, I_WEXP, I_BEXP, I_WGATE, I_WUP, I_WDOWN, I_LN2G, I_LN2B, N_IN };
struct Args { const float* in[N_IN]; float* out; unsigned char* ws; int ph_lo, ph_hi, dummy, li; };
static_assert(sizeof(Args) == (N_IN + 2) * 8 + 16, "no padding bytes in Args");

__device__ __forceinline__ const float* karg_ptr(int k) {
    const __attribute__((address_space(4))) unsigned long long* p = (const __attribute__((address_space(4))) unsigned long long*)__builtin_amdgcn_kernarg_segment_ptr();
    asm volatile("" : "+s"(p));
    return (const float*)p[k];
}
#define KARG(k) karg_ptr(k)
__device__ __forceinline__ int fresh_lane() { int t = threadIdx.x; asm volatile("" : "+v"(t)); return t & 63; }
__global__ void __launch_bounds__(NTHREADS, 2) mk_fwd(Args args) {
    extern __shared__ __attribute__((aligned(16))) unsigned char lds[];
    LAS unsigned char* L = (LAS unsigned char*)lds;
    volatile LAS unsigned* MISC = (volatile LAS unsigned*)(L + MISC_OFF);
    const int tid = threadIdx.x, wave = __builtin_amdgcn_readfirstlane(tid >> 6);
#define lane fresh_lane()
    const int G = gridDim.x; const int bx = blockIdx.x; const int vcu = (G % 8 == 0) ? (bx % 8) * (G / 8) + bx / 8 : bx;
    unsigned char* ws = args.ws;
    gu32* ctl = (gu32*)(ws + WS_CTL);
    for (int u = tid; u < (LDS_BYTES - LDSCTL_OFF) / 4; u += NTHREADS) ((LAS unsigned*)(L + LDSCTL_OFF))[u] = 0u;
    __syncthreads();
    XcdBarrier bar; bar.bar = (unsigned*)(ctl + CW_BAR) + args.li * XCD_BAR_WORDS; bar.x = 0; bar.st = nullptr;
#if MK_ONE_LAUNCH
    bar = xcd_barrier_post((unsigned*)(ctl + CW_BAR) + args.li * XCD_BAR_WORDS, MISC + 8);
#define GRID_BAR() xcd_barrier(bar)
#else
#define GRID_BAR() do {} while (0)
#endif
    const int lo = args.ph_lo, hi = args.ph_hi;
#ifndef MK_PHASE_MASK
#define MK_PHASE_MASK 0xFFF
#endif
#define IN(k) (((MK_PHASE_MASK >> (k)) & 1) && lo <= (k) && (k) < hi)
#define BOTH(k) (IN(k) && IN((k) + 1))
#define CHAIN_SYNC() do { asm volatile("s_waitcnt vmcnt(0)" ::: "memory"); __syncthreads(); \
        if (tid == 0) { __builtin_amdgcn_fence(__ATOMIC_ACQUIRE, "agent"); asm volatile("s_waitcnt vmcnt(0)" ::: "memory"); } __syncthreads(); } while (0)
#define SEAM(k, chained) do { if (BOTH(k)) { if (chained) CHAIN_SYNC(); else GRID_BAR(); } } while (0)
    const bool dummy = args.dummy != 0;
    const int gw = vcu * NWAVES + wave, NGW = G * NWAVES;
    bf16* win_t = (bf16*)(ws + WS_WIN); bf16* wa_t = (bf16*)(ws + WS_WA); bf16* wb_t = (bf16*)(ws + WS_WB); bf16* wo_t = (bf16*)(ws + WS_WO);
    bf16* sgw = (bf16*)(ws + WS_SGW); bf16* wgu_t = (bf16*)(ws + WS_WGU); bf16* wd_t = (bf16*)(ws + WS_WD);
    bf16* XB = (bf16*)(ws + WS_XB); bf16* QB = (bf16*)(ws + WS_Q); bf16* KB = (bf16*)(ws + WS_K); bf16* VB = (bf16*)(ws + WS_VAL); bf16* GA = (bf16*)(ws + WS_GA); bf16* GB = (bf16*)(ws + WS_GB);
    bf16* XS = (bf16*)(ws + WS_XS); bf16* HB = (bf16*)(ws + WS_HB); bf16* FFN = (bf16*)(ws + WS_FFN);
    bf16* UV = (bf16*)((unsigned char*)args.out + OUT_UV); bf16* SG = (bf16*)((unsigned char*)args.out + OUT_SG);
    int* list_tok = (int*)(ws + WS_LIST_TOK); float* list_w = (float*)(ws + WS_LIST_W);
    float* kn2 = (float*)(ws + WS_KN2); float* pmx = (float*)(ws + WS_PMX);

    if (IN(0)) {
        P0Args a{KARG(I_X), KARG(I_WIN), KARG(I_WA), KARG(I_WB), KARG(I_WOUT), KARG(I_SGW), KARG(I_WGATE), KARG(I_WUP), KARG(I_WDOWN), win_t, wa_t, wb_t, wo_t, sgw, wgu_t, wd_t, XB};
        p0_prologue(a, L, gw, NGW, wave, lane);
        if (BOTH(0)) GRID_BAR();
    }
    if (IN(1)) {
        pg8::Gemm g{XB, win_t, T, INW, D}; pg8::StaticOrder S; S.init(T, INW, G, bx);
        LAS float* lbias = (LAS float*)(L + RING_OFF + MOE_LDS_OFF);
        { const float* bin = KARG(I_BIN); for (int i = tid; i < INW / 4; i += NTHREADS) ((LAS f32x4*)lbias)[i] = ((const f32x4*)bin)[i]; }
        __syncthreads();
        pg8::EpiInProj E{UV, QB, (size_t)(WS_K - WS_Q) / 2, lbias, C2};
        pg8::gemm_phase<pg8::EpiInProj, pg8::StaticOrder, true, true>(L + RING_OFF, g, S, E);
        if (BOTH(1)) GRID_BAR();
    }
    if (IN(2)) {
        p2_knorm(KB, kn2, gw, NGW, lane);
        p2_gmlp(UV, SG, sgw, KARG(I_SGLNG), KARG(I_SGLNB), KARG(I_SGB), L, G);
        if (BOTH(2)) GRID_BAR();
    }
    if (IN(3)) {
        pg8::Gemm g{SG, wa_t, T, D, GW}; pg8::StaticOrder S; S.init(T, D, G, bx);
        pg8::EpiGateMix<0> E{GA, nullptr, dummy ? XB : GA};
        pg8::gemm_phase<pg8::EpiGateMix<0>, pg8::StaticOrder, true, true>(L + RING_OFF, g, S, E);
    }
    if (IN(4)) {
        float lam;
        { const float a = KARG(I_LQ1)[lane] * KARG(I_LK1)[lane], b = KARG(I_LQ2)[lane] * KARG(I_LK2)[lane];
          lam = __expf(wave_sum(a)) - __expf(wave_sum(b)) + 0.2f; lam = __uint_as_float(__builtin_amdgcn_readfirstlane(__float_as_uint(lam))); }
        unsigned* aq = (unsigned*)(ctl + CW_AQ) + args.li * 512;
        int q = (int)(((long)vcu * 8) / G) & 7, tries = 0;
#define ATT_POP_SYNC(dst) do { if (tid == 0) *(LAS unsigned*)(L + RING_OFF + att::LDS_NXT) = __hip_atomic_fetch_add(aq + 64 * q, 1u, RLX_AGENT); __syncthreads(); \
            dst = (int)__builtin_amdgcn_readfirstlane(*(LAS unsigned*)(L + RING_OFF + att::LDS_NXT)); __syncthreads(); } while (0)
#define ATT_NORMALIZE(it, iq) do { while (it >= 512 && tries < 7) { ++tries; q = (q + 1) & 7; ATT_POP_SYNC(it); } iq = q; } while (0)
        int itA, qA, itB, qB;
        ATT_POP_SYNC(itA); ATT_NORMALIZE(itA, qA);
        itB = 512; qB = q; if (itA < 512) { ATT_POP_SYNC(itB); ATT_NORMALIZE(itB, qB); }
        while (itA < 512) {
            const int b = itA >> 6, i = 63 - (itA & 63), h = (qA + b) & 7;
#define UNI_F(x) __uint_as_float(__builtin_amdgcn_readfirstlane(__float_as_uint(x)))
            const float slope2 = UNI_F(exp2f(-(float)(h + 1)) * 1.4426950408889634f);
            float u[16];
#pragma unroll
            for (int r = 0; r < 16; ++r) u[r] = __uint_as_float(__builtin_amdgcn_readfirstlane(__float_as_uint(exp2f(slope2 * (float)((r & 3) + 8 * (r >> 2))))));
            const float w4 = UNI_F(exp2f(slope2 * 4.0f)), w32 = UNI_F(exp2f(slope2 * 32.0f));
            const bf16* Kh = KB + (size_t)b * SEQ * D + h * 128; const bf16* Vh = VB + (size_t)b * SEQ * D + h * 128;
            bf16* Qb = QB + ((size_t)b * SEQ + (size_t)i * 128) * D + h * 128;
            bf16* Ob = dummy ? XB + ((size_t)b * SEQ + (size_t)i * 128) * D + h * 128 : Qb;
            const char* pfQ = nullptr; const char* pfK = nullptr;
            if (itB < 512) { const int bB = itB >> 6, iB = PROBE_SHORT_UNITS && dummy ? 0 : 63 - (itB & 63), hB = (qB + bB) & 7;
                pfQ = (const char*)(QB + ((size_t)bB * SEQ + (size_t)(63 - (itB & 63)) * 128) * D + hB * 128);
                pfK = (const char*)(KB + ((size_t)bB * SEQ + (size_t)(2 * iB) * 64) * D + hB * 128); }
            int itC = att::attn_unit(Qb, Kh, Vh, Ob, PROBE_SHORT_UNITS && dummy ? 0 : i, slope2, u, w4, w32, lam, KARG(I_SUBLN), kn2 + (size_t)(b * 8 + h) * 256, aq + 64 * q, (char*)lds + RING_OFF, pfQ, pfK, PROBE_SHORT_UNITS && dummy ? PROBE_SHORT_UNITS : 0);
            int qC; if (itB >= 512) itC = 512;
            ATT_NORMALIZE(itC, qC);
            itA = itB; qA = qB; itB = itC; qB = qC;
        }
#undef ATT_POP_SYNC
#undef ATT_NORMALIZE
        if (BOTH(4)) GRID_BAR();
    }
    if (IN(5)) {
        pg8::Gemm g{QB, wb_t, T, D, D}; pg8::StaticOrder S; S.init(T, D, G, bx);
        pg8::EpiGateMix<1> E{GA, GB, dummy ? XB : GA};
        pg8::gemm_phase<pg8::EpiGateMix<1>, pg8::StaticOrder, true, true>(L + RING_OFF, g, S, E);
        SEAM(5, false);
    }
    if (IN(6)) {
        pg8::Gemm g{GA, wo_t, T, D, D}; pg8::StaticOrder S; S.init(T, D, G, bx);
        pg8::EpiResid E{KARG(I_X), args.out, ALPHA, (pg8::f32x2*)(ws + WS_PART)};
        pg8::gemm_phase<pg8::EpiResid, pg8::StaticOrder, true, true>(L + RING_OFF, g, S, E);
        SEAM(6, false);
    }
    if (IN(7)) {
        p7_ln_route(args.out, (const float*)(ws + WS_PART), (float*)(ws + WS_STATS), XB, KARG(I_LN1G), KARG(I_LN1B), KARG(I_WGRP), KARG(I_BGRP), KARG(I_WEXP), KARG(I_BEXP), list_tok, list_w, (unsigned*)(ctl + CW_CNT), L, G, dummy);
        if (BOTH(7)) GRID_BAR();
    }
    if (IN(9)) {
        LAS int* ml = (LAS int*)(L + RING_OFF + MOE_LDS_OFF);
        const int ntiles = pg8::MoeOrder<true>::prime((const unsigned*)(ctl + CW_CNT), list_tok, list_w, MOE_CAP, bx, ml + pg8::MOE_LDS_TE / 4, ml + pg8::MOE_LDS_TR / 4, ml + pg8::MOE_LDS_TB / 4, ml + pg8::MOE_LDS_SL / 4, (LAS int*)(MISC + 12), tid);
        pg8::Gemm g{XB, wgu_t, 0, 0, D}; pg8::MoeOrder<true> S{list_tok, list_w, ntiles, G, bx, ml + pg8::MOE_LDS_TE / 4, ml + pg8::MOE_LDS_TR / 4, ml + pg8::MOE_LDS_TB / 4, ml + pg8::MOE_LDS_SL / 4};
        pg8::EpiGateUp E{HB};
        pg8::gemm_phase<pg8::EpiGateUp, pg8::MoeOrder<true>, true, true>(L + RING_OFF, g, S, E);
        if (BOTH(9)) GRID_BAR();
    }
    if (IN(10)) {
        LAS int* ml = (LAS int*)(L + RING_OFF + MOE_LDS_OFF);
        const int ntiles = pg8::MoeOrder<false>::prime((const unsigned*)(ctl + CW_CNT), list_tok, list_w, MOE_CAP, bx, ml + pg8::MOE_LDS_TE / 4, ml + pg8::MOE_LDS_TR / 4, ml + pg8::MOE_LDS_TB / 4, ml + pg8::MOE_LDS_SL / 4, (LAS int*)(MISC + 12), tid);
        pg8::Gemm g{HB, wd_t, 0, 0, EHID}; pg8::MoeOrder<false> S{list_tok, list_w, ntiles, G, bx, ml + pg8::MOE_LDS_TE / 4, ml + pg8::MOE_LDS_TR / 4, ml + pg8::MOE_LDS_TB / 4, ml + pg8::MOE_LDS_SL / 4};
        pg8::EpiDown E{FFN, ml + pg8::MOE_LDS_TR / 4, ml + pg8::MOE_LDS_SL / 4};
        pg8::gemm_phase<pg8::EpiDown, pg8::MoeOrder<false>, true, true>(L + RING_OFF, g, S, E);
        if (BOTH(10)) GRID_BAR();
    }
    if (IN(11)) {
        p11_final(args.out, XB, FFN, KARG(I_LN2G), KARG(I_LN2B), gw, NGW, lane);
    }
#undef IN
#undef BOTH
#undef lane
}

extern "C" void kernel_launch(void* const* d_in, const int* in_sizes, int n_in, void* d_out, int out_size, void* d_ws, size_t ws_size, hipStream_t stream) {
    static int grid = 0;
    if (grid == 0) {
        if (n_in != N_IN || in_sizes[0] != T * D || out_size != T * D || ws_size < WS_END) {
            fprintf(stderr, "kernel_launch: shape mismatch: n_in %d in0 %d out %d ws %zu (need %zu)\n", n_in, n_in > 0 ? in_sizes[0] : -1, out_size, ws_size, (size_t)WS_END); grid = -1; return; }
        int dev = 0, cus = 0, per_cu = 0;
        if (hipGetDevice(&dev) != hipSuccess || hipDeviceGetAttribute(&cus, hipDeviceAttributeMultiprocessorCount, dev) != hipSuccess) { grid = -1; return; }
        if (hipFuncSetAttribute((const void*)mk_fwd, hipFuncAttributeMaxDynamicSharedMemorySize, LDS_BYTES) != hipSuccess) { fprintf(stderr, "kernel_launch: hipFuncSetAttribute failed\n"); grid = -1; return; }
        if (hipOccupancyMaxActiveBlocksPerMultiprocessor(&per_cu, (const void*)mk_fwd, NTHREADS, LDS_BYTES) != hipSuccess || per_cu < 1)
            fprintf(stderr, "kernel_launch: note: occupancy query reports %d workgroups per CU\n", per_cu);
        (void)hipGetLastError();
        grid = cus;
    }
    if (grid < 0) return;
    if (hipMemsetAsync((char*)d_ws + WS_CTL, 0, CTL_ZERO_BYTES, stream) != hipSuccess) { fprintf(stderr, "kernel_launch: memset failed\n"); return; }
    Args a{};
    for (int i = 0; i < N_IN; ++i) a.in[i] = (const float*)d_in[i];
    a.out = (float*)d_out; a.ws = (unsigned char*)d_ws;
#if MK_ONE_LAUNCH && MK_PROBE_PHASE >= 0
    a.ph_lo = 0; a.ph_hi = MK_PROBE_PHASE; a.li = 0; if (MK_PROBE_PHASE > 0) hipLaunchKernelGGL(mk_fwd, dim3(grid), dim3(NTHREADS), LDS_BYTES, stream, a);
    a.ph_lo = MK_PROBE_PHASE; a.ph_hi = MK_PROBE_PHASE + 1; a.li = 1; a.dummy = 1; hipLaunchKernelGGL(mk_fwd, dim3(grid), dim3(NTHREADS), LDS_BYTES, stream, a);
    a.ph_lo = MK_PROBE_PHASE; a.ph_hi = NPHASE; a.li = 2; a.dummy = 0; hipLaunchKernelGGL(mk_fwd, dim3(grid), dim3(NTHREADS), LDS_BYTES, stream, a);
#elif MK_ONE_LAUNCH
    a.ph_lo = 0; a.ph_hi = NPHASE;
    hipLaunchKernelGGL(mk_fwd, dim3(grid), dim3(NTHREADS), LDS_BYTES, stream, a);
#else
    for (int p = 0; p < NPHASE; ++p) { a.ph_lo = p; a.ph_hi = p + 1; hipLaunchKernelGGL(mk_fwd, dim3(grid), dim3(NTHREADS), LDS_BYTES, stream, a); }
#endif
    const hipError_t le = hipPeekAtLastError();
    if (le != hipSuccess) fprintf(stderr, "kernel_launch: launch failed: %s\n", hipGetErrorName(le));
}
```

```cpp
#include <hip/hip_runtime.h>
#include <cstdio>
#include <cstdint>
namespace pg8 {
#define PG8_LAS __attribute__((address_space(3)))
typedef unsigned short bf16_t;
typedef short bf16x8 __attribute__((ext_vector_type(8)));
typedef float f32x4 __attribute__((ext_vector_type(4)));
typedef unsigned u32x4 __attribute__((ext_vector_type(4)));
constexpr int BM = 256, BK = 64, HALF = 128, HTB = HALF * BK * 2  , STAGE_BYTES = 8 * HTB, NXCD = 8, WGM = 8;

__host__ __device__ __forceinline__ int lds_byte(int r, int c) { const int st = (r >> 4) * 2 + (c >> 5), rr = r & 15, cc = c & 31, ob = rr * 64 + cc * 2; return st * 1024 + (ob ^ (((ob >> 9) & 1) << 5)); }
__host__ __device__ __forceinline__ void stage_rc(int b, int& R, int& C) { const int st = b / 1024, sb = b % 1024, swz = sb ^ (((sb >> 9) & 1) << 5); R = (st >> 1) * 16 + swz / 64; C = (st & 1) * 32 + (swz % 64) / 2; }
__host__ __device__ __forceinline__ int perm32(int rho) { const int n = rho >> 4, i = rho & 15; return 8 * (i >> 2) + 4 * n + (i & 3); }

struct Unit { int pm, pn, sl; };
struct Gemm { const bf16_t* A; const bf16_t* Bt; int M, N, K; };

struct StaticOrder {
    int nM, nN, nwg, G, c;
    __host__ __device__ void init(int M, int N, int G_, int c_) { nM = M / BM; nN = N / BM; nwg = nM * nN; G = G_; c = c_; }
    __host__ __device__ bool next(int i, Unit& u) const {
        const long L = (long)i * G + c; if (L >= nwg) return false;
        int wgid = (int)L; { const int q = nwg / NXCD, r = nwg % NXCD, xcd = wgid % NXCD, off = wgid / NXCD; wgid = (xcd < r ? xcd * (q + 1) : r * (q + 1) + (xcd - r) * q) + off; }
        const int nig = WGM * nN, gid = wgid / nig, fm = gid * WGM, gsz = (nM - fm) < WGM ? (nM - fm) : WGM;
        u.pm = fm + ((wgid % nig) % gsz); u.pn = (wgid % nig) / gsz; return true;
    }
    __device__ __forceinline__ void a_ready(const Unit&) const {}
    __device__ __forceinline__ void done(const Unit&) const {}
    __device__ __forceinline__ void stage(const Unit&, int, int) const {}
    static constexpr bool GATHER = false;
    __device__ __forceinline__ unsigned arow(const Unit&, int) const { return 0u; }
};

struct RowOwnerOrder {
    int nM, nN, G, c;
    __host__ __device__ void init(int M, int N, int G_, int c_) { nM = M / BM; nN = N / BM; G = G_; c = c_; }
    __host__ __device__ bool next(int i, Unit& u) const { const int pm = c + (i / nN) * G; if (pm >= nM) return false; u.pm = pm; u.pn = i % nN; return true; }
    __device__ __forceinline__ void a_ready(const Unit&) const {}
    __device__ __forceinline__ void done(const Unit&) const {}
    __device__ __forceinline__ void stage(const Unit&, int, int) const {}
    static constexpr bool GATHER = false;
    __device__ __forceinline__ unsigned arow(const Unit&, int) const { return 0u; }
};
__device__ __forceinline__ unsigned cvt_pk_bf16(float lo, float hi) { unsigned r; asm volatile("v_cvt_pk_bf16_f32 %0, %1, %2" : "=v"(r) : "v"(lo), "v"(hi)); return r; }
typedef float f32x2 __attribute__((ext_vector_type(2)));
__device__ __forceinline__ f32x2 gelu_pk(f32x2 v) {
    const f32x2 av = __builtin_elementwise_abs(v), d = av * 0.2316418882f + 1.0f;
    f32x2 t; t.x = __builtin_amdgcn_rcpf(d.x); t.y = __builtin_amdgcn_rcpf(d.y);
    f32x2 q = t * 0.5307027145f + (-0.7265760135f); q = q * t + 0.7107068705f; q = q * t + (-0.142248368f); q = q * t + 0.127414796f; q = q * t;
    const f32x2 s = (v * v) * (-0.72134752044f);
    f32x2 e; e.x = __builtin_amdgcn_exp2f(s.x); e.y = __builtin_amdgcn_exp2f(s.y);
    const f32x2 m = v * (q * e), r = v - m;
    f32x2 o; o.x = v.x < 0.f ? m.x : r.x; o.y = v.y < 0.f ? m.y : r.y; return o;
}
typedef unsigned u32x2 __attribute__((ext_vector_type(2)));
__device__ __forceinline__ float bf_lo(unsigned w) { return __uint_as_float(w << 16); }
__device__ __forceinline__ float bf_hi(unsigned w) { return __uint_as_float(w & 0xffff0000u); }
__device__ __forceinline__ float sigmoid_f(float x) { return __builtin_amdgcn_rcpf(1.0f + __builtin_amdgcn_exp2f(-1.4426950408889634f * x)); }

struct EpiInProj {
    static constexpr bool PERM = true, AFTER_DRAIN = false; static constexpr int VMEM_MIN = 16;
    bf16_t* uv; bf16_t* g1; size_t gstride; const PG8_LAS float* bias; float qscale;
    __device__ __forceinline__ void operator()(const f32x4 (&acc)[2][2][4][2], const Unit& u, int wr, int wc, int fr, int fq) const {
        asm volatile("" : "+v"(fr), "+v"(fq));
        const int t = u.pn >> 2;
        bf16_t* base = (t == 0) ? uv : g1 + (size_t)(t - 1) * gstride;
        const int row0 = u.pm * BM + wr * 64 + fr;
        const int col0 = (u.pn & 3) * BM + wc * 32 + 8 * fq, bcol0 = u.pn * BM + wc * 32 + 8 * fq;
        const float sc = (t == 1) ? qscale : 1.0f;
#pragma unroll
        for (int bj = 0; bj < 2; ++bj) {
            const f32x4 bv0 = *(const PG8_LAS f32x4*)(bias + bcol0 + bj * HALF), bv1 = *(const PG8_LAS f32x4*)(bias + bcol0 + bj * HALF + 4);
#pragma unroll
        for (int ai = 0; ai < 2; ++ai)
#pragma unroll
            for (int m = 0; m < 4; ++m) { bf16_t* rowp = base + (size_t)(row0 + ai * HALF + m * 16) * 1024 + col0;
                { f32x4 v0 = acc[ai][bj][m][0] + bv0, v1 = acc[ai][bj][m][1] + bv1;
                    if (t == 0) { const f32x2 a = gelu_pk((f32x2){v0[0], v0[1]}), b = gelu_pk((f32x2){v0[2], v0[3]}); v0 = (f32x4){a.x, a.y, b.x, b.y}; __builtin_amdgcn_sched_barrier(0);
                        const f32x2 c = gelu_pk((f32x2){v1[0], v1[1]}), d = gelu_pk((f32x2){v1[2], v1[3]}); v1 = (f32x4){c.x, c.y, d.x, d.y}; }
                    else if (t >= 4) {
#pragma unroll
                        for (int e = 0; e < 4; ++e) { v0[e] = sigmoid_f(v0[e]); v1[e] = sigmoid_f(v1[e]); } }
                    else if (t == 3) {
                        const int h = (u.pn & 3) * 2 + bj; const float w = __builtin_amdgcn_exp2f(__builtin_amdgcn_exp2f(-(float)(h + 1)) * 1.4426950408889634f * (float)(16 * m + fr));
                        v0 = v0 * w; v1 = v1 * w; }
                    else { v0 = v0 * sc; v1 = v1 * sc; }
                    u32x4 w; w.x = cvt_pk_bf16(v0[0], v0[1]); w.y = cvt_pk_bf16(v0[2], v0[3]); w.z = cvt_pk_bf16(v1[0], v1[1]); w.w = cvt_pk_bf16(v1[2], v1[3]);
                    *(u32x4*)(rowp + bj * HALF) = w; } }
        }
    }
};

template <int MODE  > struct EpiGateMix {
    static constexpr bool PERM = true, AFTER_DRAIN = false; static constexpr int VMEM_MIN = MODE ? 40 : 24;
    const bf16_t* io; const bf16_t* g2; bf16_t* outp;
    __device__ __forceinline__ void operator()(const f32x4 (&acc)[2][2][4][2], const Unit& u, int wr, int wc, int fr, int fq) const {
        asm volatile("" : "+v"(fr), "+v"(fq));
        const int row0 = u.pm * BM + wr * 64 + fr, col0 = u.pn * BM + wc * 32 + 8 * fq;
#pragma unroll
        for (int ai = 0; ai < 2; ++ai) {
            u32x4 xi[4][2], xg[4][2];
#pragma unroll
            for (int m = 0; m < 4; ++m)
#pragma unroll
                for (int bj = 0; bj < 2; ++bj) { const size_t off = (size_t)(row0 + ai * HALF + m * 16) * 1024 + col0 + bj * HALF;
                    xi[m][bj] = *(const u32x4*)(io + off); if (MODE == 1) xg[m][bj] = *(const u32x4*)(g2 + off); }
            __builtin_amdgcn_sched_barrier(0);
#pragma unroll
            for (int m = 0; m < 4; ++m)
#pragma unroll
                for (int bj = 0; bj < 2; ++bj) { const size_t off = (size_t)(row0 + ai * HALF + m * 16) * 1024 + col0 + bj * HALF;
                    const f32x4 a0 = acc[ai][bj][m][0], a1 = acc[ai][bj][m][1]; const u32x4 x = xi[m][bj];
                    float r[8];
                    if (MODE == 0) {
                        r[0] = bf_lo(x.x) * a0[0]; r[1] = bf_hi(x.x) * a0[1]; r[2] = bf_lo(x.y) * a0[2]; r[3] = bf_hi(x.y) * a0[3];
                        r[4] = bf_lo(x.z) * a1[0]; r[5] = bf_hi(x.z) * a1[1]; r[6] = bf_lo(x.w) * a1[2]; r[7] = bf_hi(x.w) * a1[3];
                    } else {
                        const u32x4 g = xg[m][bj];
                        r[0] = bf_lo(x.x) + bf_lo(g.x) * a0[0]; r[1] = bf_hi(x.x) + bf_hi(g.x) * a0[1]; r[2] = bf_lo(x.y) + bf_lo(g.y) * a0[2]; r[3] = bf_hi(x.y) + bf_hi(g.y) * a0[3];
                        r[4] = bf_lo(x.z) + bf_lo(g.z) * a1[0]; r[5] = bf_hi(x.z) + bf_hi(g.z) * a1[1]; r[6] = bf_lo(x.w) + bf_lo(g.w) * a1[2]; r[7] = bf_hi(x.w) + bf_hi(g.w) * a1[3];
                    }
                    u32x4 w; w.x = cvt_pk_bf16(r[0], r[1]); w.y = cvt_pk_bf16(r[2], r[3]); w.z = cvt_pk_bf16(r[4], r[5]); w.w = cvt_pk_bf16(r[6], r[7]);
                    *(u32x4*)(outp + off) = w; }
            __builtin_amdgcn_sched_barrier(0);
        }
    }
};

struct EpiResid {
    static constexpr bool PERM = false, AFTER_DRAIN = false; static constexpr int VMEM_MIN = 32;
    const float* x; float* out; float alpha; f32x2* part;
    __device__ __forceinline__ void operator()(const f32x4 (&acc)[2][2][4][2], const Unit& u, int wr, int wc, int fr, int fq) const {
        asm volatile("" : "+v"(fr), "+v"(fq));
        const int row0 = u.pm * BM + wr * 64 + fr, col0 = u.pn * BM + wc * 32 + 4 * fq;
#define ER_LOAD(xv, blk) do { _Pragma("unroll") for (int mm = 0; mm < 2; ++mm) _Pragma("unroll") for (int bj = 0; bj < 2; ++bj) _Pragma("unroll") for (int n = 0; n < 2; ++n) \
            xv[mm][bj][n] = *(const f32x4*)(x + (size_t)(row0 + ((blk) >> 1) * HALF + (2 * ((blk) & 1) + mm) * 16) * 1024 + col0 + bj * HALF + n * 16); } while (0)
#define ER_DO(xv, blk) do { constexpr int ai = (blk) >> 1, mp = (blk) & 1; _Pragma("unroll") for (int mm = 0; mm < 2; ++mm) { const int m = 2 * mp + mm; const int row = row0 + ai * HALF + m * 16; const size_t off = (size_t)row * 1024 + col0; float s1 = 0.f, s2 = 0.f; \
            _Pragma("unroll") for (int bj = 0; bj < 2; ++bj) _Pragma("unroll") for (int n = 0; n < 2; ++n) { const f32x4 r = xv[mm][bj][n] * alpha + acc[ai][bj][m][n]; \
                *(f32x4*)(out + off + bj * HALF + n * 16) = r; s1 += (r[0] + r[1]) + (r[2] + r[3]); s2 += (r[0] * r[0] + r[1] * r[1]) + (r[2] * r[2] + r[3] * r[3]); } \
            s1 += __shfl_xor(s1, 16); s1 += __shfl_xor(s1, 32); s2 += __shfl_xor(s2, 16); s2 += __shfl_xor(s2, 32); \
            if (fq == 0) part[(size_t)row * 16 + (u.pn & 3) * 4 + wc] = (f32x2){s1, s2}; } } while (0)
        f32x4 xa[2][2][2], xb[2][2][2];
        ER_LOAD(xa, 0); ER_LOAD(xb, 1); __builtin_amdgcn_sched_barrier(0);
        ER_DO(xa, 0); __builtin_amdgcn_sched_barrier(0); ER_LOAD(xa, 2); __builtin_amdgcn_sched_barrier(0);
        ER_DO(xb, 1); __builtin_amdgcn_sched_barrier(0); ER_LOAD(xb, 3); __builtin_amdgcn_sched_barrier(0);
        ER_DO(xa, 2); __builtin_amdgcn_sched_barrier(0);
        ER_DO(xb, 3);
#undef ER_LOAD
#undef ER_DO
    }
};

struct EpiGateUp {
    static constexpr bool PERM = true, AFTER_DRAIN = false; static constexpr int VMEM_MIN = 8;
    bf16_t* hb;
    __device__ __forceinline__ void operator()(const f32x4 (&acc)[2][2][4][2], const Unit& u, int wr, int wc, int fr, int fq) const {
        asm volatile("" : "+v"(fr), "+v"(fq));
        const int row0 = u.pm * BM + wr * 64 + fr, col0 = (u.pn & 3) * HALF + wc * 32 + 8 * fq;
#pragma unroll
        for (int ai = 0; ai < 2; ++ai)
#pragma unroll
            for (int m = 0; m < 4; ++m) { bf16_t* p = hb + (size_t)(row0 + ai * HALF + m * 16) * 512 + col0;
                float r[8];
#pragma unroll
                for (int n = 0; n < 2; ++n)
#pragma unroll
                    for (int e = 0; e < 4; ++e) { const float g = acc[ai][0][m][n][e], up = acc[ai][1][m][n][e]; r[n * 4 + e] = g * sigmoid_f(g) * up; }
                u32x4 w; w.x = cvt_pk_bf16(r[0], r[1]); w.y = cvt_pk_bf16(r[2], r[3]); w.z = cvt_pk_bf16(r[4], r[5]); w.w = cvt_pk_bf16(r[6], r[7]);
                *(u32x4*)p = w; }
    }
};

constexpr int MOE_LDS_TE = 0, MOE_LDS_TR = 2304, MOE_LDS_TB = 4608, MOE_LDS_SL = 6912, MOE_LDS_BYTES = 6912 + 3 * 2048;
struct EpiDown {
    static constexpr bool PERM = true, AFTER_DRAIN = false; static constexpr int VMEM_MIN = 0;
    bf16_t* ffn; const PG8_LAS int* ltr; const PG8_LAS int* lsl;
    __device__ __forceinline__ void operator()(const f32x4 (&acc)[2][2][4][2], const Unit& u, int wr, int wc, int fr, int fq) const {
        asm volatile("" : "+v"(fr), "+v"(fq));
        const int nvalid = ltr[u.pm];
        const int col0 = (u.pn & 3) * BM + wc * 32 + 8 * fq;
        const PG8_LAS int* sl = lsl + u.sl * 512;
        int aa[2][4]; float ww[2][4];
#pragma unroll
        for (int ai = 0; ai < 2; ++ai)
#pragma unroll
            for (int m = 0; m < 4; ++m) { const int rl = ai * HALF + wr * 64 + m * 16 + fr; aa[ai][m] = sl[rl]; ww[ai][m] = __int_as_float(sl[256 + rl]); }
#pragma unroll
        for (int ai = 0; ai < 2; ++ai)
#pragma unroll
            for (int m = 0; m < 4; ++m) { const int rl = ai * HALF + wr * 64 + m * 16 + fr;
                if (rl < nvalid) { const float wt = ww[ai][m];
                    bf16_t* p = ffn + (size_t)aa[ai][m] * 1024 + col0;
#pragma unroll
                    for (int bj = 0; bj < 2; ++bj) { const f32x4 v0 = acc[ai][bj][m][0] * wt, v1 = acc[ai][bj][m][1] * wt;
                        u32x4 w; w.x = cvt_pk_bf16(v0[0], v0[1]); w.y = cvt_pk_bf16(v0[2], v0[3]); w.z = cvt_pk_bf16(v1[0], v1[1]); w.w = cvt_pk_bf16(v1[2], v1[3]);
                        *(u32x4*)(p + bj * HALF) = w; } } }
    }
};

template <bool GATHER_> struct MoeOrder {
    static constexpr bool GATHER = GATHER_;
    const int* list_tok; const float* list_w; int ntiles, G, c;
    PG8_LAS int* lte; PG8_LAS int* ltr; PG8_LAS int* ltb; PG8_LAS int* lsl;
    static __device__ __forceinline__ int prime(const unsigned* cnt, const int* list_tok_, const float* list_w_, int cap, int c_, PG8_LAS int* lte_, PG8_LAS int* ltr_, PG8_LAS int* ltb_, PG8_LAS int* lsl_, PG8_LAS int* lnt, int tid) {
        if (tid < 64) { const int ln = tid;
            const int cn = (ln < 32) ? (int)__hip_atomic_load(cnt + (ln & 31), __ATOMIC_RELAXED, __HIP_MEMORY_SCOPE_AGENT) : 0; const int nt = (cn + 255) >> 8;
            int incl = nt;
#pragma unroll
            for (int off = 1; off < 32; off <<= 1) { const int t = __shfl_up(incl, off); if (ln >= off) incl += t; }
            const int excl = incl - nt;
            if (ln < 32) for (int t = 0; t < nt; ++t) { lte_[excl + t] = ln; const int rem = cn - t * 256; ltr_[excl + t] = rem < 256 ? rem : 256; ltb_[excl + t] = ln * cap + t * 256; }
            if (ln == 31) *lnt = incl; }
        __syncthreads();
        const int ntl = *lnt;
        if (c_ < ntl * 4 && tid < 256) { const int base = ltb_[c_ >> 2]; lsl_[tid] = list_tok_[base + tid]; lsl_[256 + tid] = __float_as_int(list_w_[base + tid]); }
        __syncthreads();
        return ntl;
    }
    __device__ bool next(int i, Unit& u) const {
        const long L = (long)i * G + c; if (L >= (long)ntiles * 4) return false;
        const int rt = (int)(L >> 2), ct = (int)(L & 3);
        u.pm = rt; u.pn = __builtin_amdgcn_readfirstlane(lte[rt]) * 4 + ct; u.sl = i % 3; return true;
    }
    __device__ __forceinline__ void stage(const Unit& n, int wid, int lane) const {
        if (wid == 0) { const int base = __builtin_amdgcn_readfirstlane(ltb[n.pm]);
            __builtin_amdgcn_global_load_lds((const unsigned*)(list_tok + base + lane * 4), (PG8_LAS unsigned*)(lsl + n.sl * 512), 16, 0, 0);
            if (!GATHER) __builtin_amdgcn_global_load_lds((const unsigned*)(list_w + base + lane * 4), (PG8_LAS unsigned*)(lsl + n.sl * 512 + 256), 16, 0, 0);
        }
    }
    __device__ __forceinline__ unsigned arow(const Unit& u, int rl) const { return rl < ltr[u.pm] ? (unsigned)(lsl[u.sl * 512 + rl] >> 1) : 0u; }
    __device__ __forceinline__ void a_ready(const Unit&) const {}
    __device__ __forceinline__ void done(const Unit&) const {}
};

template <class Epi, class Sched, bool ALIGN_EPI = false, bool SP2 = false>
__device__ __forceinline__ void gemm_phase(PG8_LAS unsigned char* lds, const Gemm g, const Sched& S, const Epi& E) {
    int tid = threadIdx.x; asm volatile("" : "+v"(tid));
    const int wid = __builtin_amdgcn_readfirstlane(tid >> 6), lane = tid & 63, wr = wid >> 2, wc = wid & 3, fr = lane & 15, fq = lane >> 4;
    const int K = g.K, nt = K / BK;
    unsigned voffA[2], voffB[2]; int gR[2], gC[2];
    static_assert(!Sched::GATHER || SP2, "gathered A rows: SP2 loop only");
    unsigned gvo[2][2] = {{0u, 0u}, {0u, 0u}}, ngvo[2][2] = {{0u, 0u}, {0u, 0u}}, pvo[2][2] = {{0u, 0u}, {0u, 0u}};
#pragma unroll
    for (int i = 0; i < 2; ++i) { int R, C; stage_rc(tid * 16 + i * 8192, R, C); const int Rb = Epi::PERM ? ((R & ~31) + perm32(R & 31)) : R;
        voffA[i] = (unsigned)(R * K + C) * 2u; voffB[i] = (unsigned)(Rb * K + C) * 2u; gR[i] = R; gC[i] = C; }
    const size_t kstep = (size_t)(BK * 2);
    const size_t hstep = (size_t)HALF * K * 2;
    const size_t tstep = 2 * hstep;
    const unsigned ldsw = (unsigned)wid * 1024u;
    const int aoff = lds_byte(wr * 64 + fr, fq * 8), boff = lds_byte(wc * 32 + fr, fq * 8);
#define PG8_SA(b, h) (((b) * 2 + (h)) * HTB)
#define PG8_SB(b, h) ((4 + (b) * 2 + (h)) * HTB)
#define PG8_STAGE(bufoff, gbase, voff) do { _Pragma("unroll") for (int _i = 0; _i < 2; ++_i) \
        __builtin_amdgcn_global_load_lds((const unsigned*)((const char*)(gbase) + (voff)[_i]), (PG8_LAS unsigned*)(lds + (bufoff) + ldsw + _i * 8192), 16, 0, 0); } while (0)
#define PG8_STAGEA(bufoff, kptr, half, VO) do { if constexpr (Sched::GATHER) { PG8_STAGE(bufoff, kptr, (VO)[half]); } else { PG8_STAGE(bufoff, (kptr) + (half) * hstep, voffA); } } while (0)
#define PG8_GOFF(dst, un) do { _Pragma("unroll") for (int h_ = 0; h_ < 2; ++h_) _Pragma("unroll") for (int i_ = 0; i_ < 2; ++i_) dst[h_][i_] = (unsigned)(((size_t)S.arow(un, h_ * HALF + gR[i_]) * K + gC[i_]) * 2u); } while (0)
#define PG8_LDA(dst, b, h) do { _Pragma("unroll") for (int m = 0; m < 4; ++m) _Pragma("unroll") for (int k = 0; k < 2; ++k) dst[m][k] = *(const PG8_LAS bf16x8*)(lds + PG8_SA(b, h) + aoff + m * 2048 + k * 1024); } while (0)
#define PG8_LDB(dst, b, h) do { _Pragma("unroll") for (int n = 0; n < 2; ++n) _Pragma("unroll") for (int k = 0; k < 2; ++k) dst[n][k] = *(const PG8_LAS bf16x8*)(lds + PG8_SB(b, h) + boff + n * 2048 + k * 1024); } while (0)
#define PG8_MMA(ai, bj, At, Bt) do { __builtin_amdgcn_s_setprio(1); _Pragma("unroll") for (int m = 0; m < 4; ++m) _Pragma("unroll") for (int n = 0; n < 2; ++n) _Pragma("unroll") for (int k = 0; k < 2; ++k) \
        acc[ai][bj][m][n] = __builtin_amdgcn_mfma_f32_16x16x32_bf16(Bt[n][k], At[m][k], acc[ai][bj][m][n], 0, 0, 0); __builtin_amdgcn_s_setprio(0); } while (0)
#define PG8_WAIT_V(n) asm volatile("s_waitcnt vmcnt(" #n ")" ::: "memory")
#define PG8_WAIT_L(n) asm volatile("s_waitcnt lgkmcnt(" #n ")" ::: "memory")
#define PG8_BAR __builtin_amdgcn_s_barrier()
#define PG8_SCHED __builtin_amdgcn_sched_barrier(0)
    Unit cur, nxt; int ui = 0;
    if (!S.next(0, cur)) return;
    f32x4 acc[2][2][4][2];
#pragma unroll
    for (int a = 0; a < 2; ++a)
#pragma unroll
        for (int b = 0; b < 2; ++b)
#pragma unroll
            for (int m = 0; m < 4; ++m)
#pragma unroll
                for (int n = 0; n < 2; ++n) acc[a][b][m][n] = (f32x4){0.f, 0.f, 0.f, 0.f};
    bf16x8 At[4][2], B0[2][2], B1[2][2];
    const char* cA = Sched::GATHER ? (const char*)g.A : (const char*)g.A + (size_t)cur.pm * tstep; const char* cB = (const char*)g.Bt + (size_t)cur.pn * tstep;
    if constexpr (Sched::GATHER) PG8_GOFF(gvo, cur);
    S.a_ready(cur);
    if constexpr (SP2) {
        PG8_STAGE(PG8_SB(0, 0), cB, voffB); PG8_STAGE(PG8_SB(0, 1), cB + hstep, voffB); PG8_STAGEA(PG8_SA(0, 0), cA, 0, gvo); PG8_STAGEA(PG8_SA(0, 1), cA, 1, gvo);
        if (wr == 1) PG8_BAR;
        PG8_WAIT_V(2); PG8_BAR;
        PG8_STAGE(PG8_SB(1, 0), cB + kstep, voffB); PG8_STAGEA(PG8_SA(1, 0), cA + kstep, 0, gvo); PG8_STAGE(PG8_SB(1, 1), cB + hstep + kstep, voffB);
        PG8_WAIT_V(6); PG8_BAR;
    } else {
        PG8_STAGE(PG8_SB(0, 0), cB, voffB); PG8_STAGE(PG8_SA(0, 0), cA, voffA); PG8_STAGE(PG8_SB(0, 1), cB + hstep, voffB); PG8_STAGE(PG8_SA(0, 1), cA + hstep, voffA);
        if (wr == 1) PG8_BAR;
        PG8_WAIT_V(4); PG8_BAR;
        PG8_STAGE(PG8_SB(1, 0), cB + kstep, voffB); PG8_STAGE(PG8_SA(1, 0), cA + kstep, voffA); PG8_STAGE(PG8_SB(1, 1), cB + hstep + kstep, voffB);
        PG8_WAIT_V(6); PG8_BAR;
    }
    for (;;) {
        const bool has_next = S.next(ui + 1, nxt);
        const char* nA = (has_next && !Sched::GATHER) ? (const char*)g.A + (size_t)nxt.pm * tstep : cA; const char* nB = has_next ? (const char*)g.Bt + (size_t)nxt.pn * tstep : cB;
        if (has_next) S.stage(nxt, wid, lane);
        if constexpr (Sched::GATHER) { _Pragma("unroll") for (int h_ = 0; h_ < 2; ++h_) _Pragma("unroll") for (int i_ = 0; i_ < 2; ++i_) ngvo[h_][i_] = gvo[h_][i_]; }
        for (int t = 0; t < nt; t += 2) {
            const bool last = (t == nt - 2);
            const char* a1 = cA + (size_t)(t + 1) * kstep;
            const char* a2 = last ? nA : cA + (size_t)(t + 2) * kstep; const char* b2 = last ? nB : cB + (size_t)(t + 2) * kstep;
            const char* a3 = a2 + kstep; const char* b3 = b2 + kstep;
            if (last && has_next) { if constexpr (Sched::GATHER) { PG8_GOFF(ngvo, nxt); } S.a_ready(nxt); }
            if constexpr (Sched::GATHER) { _Pragma("unroll") for (int h_ = 0; h_ < 2; ++h_) _Pragma("unroll") for (int i_ = 0; i_ < 2; ++i_) pvo[h_][i_] = last ? ngvo[h_][i_] : gvo[h_][i_]; }
            if constexpr (SP2) {
            PG8_LDB(B0, 0, 0); PG8_LDB(B1, 0, 1); PG8_SCHED; PG8_LDA(At, 0, 0); PG8_STAGEA(PG8_SA(1, 1), a1, 1, gvo);
            PG8_WAIT_V(8); PG8_WAIT_L(0); PG8_BAR; PG8_MMA(0, 0, At, B0); PG8_MMA(0, 1, At, B1); PG8_BAR; PG8_SCHED;
            PG8_LDA(At, 0, 1); PG8_STAGE(PG8_SB(0, 0), b2, voffB); PG8_STAGE(PG8_SB(0, 1), b2 + hstep, voffB); PG8_STAGEA(PG8_SA(0, 0), a2, 0, pvo);
            PG8_WAIT_V(8); PG8_WAIT_L(0); PG8_BAR; PG8_MMA(1, 0, At, B0); PG8_MMA(1, 1, At, B1); PG8_BAR; PG8_SCHED;
            PG8_LDB(B0, 1, 0); PG8_LDB(B1, 1, 1); PG8_SCHED; PG8_LDA(At, 1, 0); PG8_STAGEA(PG8_SA(0, 1), a2, 1, pvo);
            PG8_WAIT_V(8); PG8_WAIT_L(0); PG8_BAR; PG8_MMA(0, 0, At, B0); PG8_MMA(0, 1, At, B1); PG8_BAR; PG8_SCHED;
            PG8_LDA(At, 1, 1); PG8_STAGE(PG8_SB(1, 0), b3, voffB); PG8_STAGE(PG8_SB(1, 1), b3 + hstep, voffB); PG8_STAGEA(PG8_SA(1, 0), a3, 0, pvo);
            PG8_WAIT_V(8); PG8_WAIT_L(0); PG8_BAR; PG8_MMA(1, 0, At, B0); PG8_MMA(1, 1, At, B1); PG8_BAR; PG8_SCHED;
            } else {
            PG8_LDB(B0, 0, 0); PG8_SCHED; PG8_LDA(At, 0, 0); PG8_STAGE(PG8_SA(1, 1), a1 + hstep, voffA);
            PG8_WAIT_L(8); PG8_BAR; PG8_WAIT_L(0); PG8_MMA(0, 0, At, B0); PG8_BAR; PG8_SCHED;
            PG8_LDB(B1, 0, 1); PG8_STAGE(PG8_SB(0, 0), b2, voffB);
            PG8_BAR; PG8_WAIT_L(0); PG8_MMA(0, 1, At, B1); PG8_BAR;
            PG8_LDA(At, 0, 1); PG8_STAGE(PG8_SA(0, 0), a2, voffA);
            PG8_BAR; PG8_WAIT_L(0); PG8_MMA(1, 0, At, B0); PG8_BAR; PG8_SCHED;
            PG8_STAGE(PG8_SB(0, 1), b2 + hstep, voffB);
            PG8_WAIT_V(6); PG8_BAR; PG8_MMA(1, 1, At, B1); PG8_BAR;
            PG8_LDB(B0, 1, 0); PG8_SCHED; PG8_LDA(At, 1, 0); PG8_STAGE(PG8_SA(0, 1), a2 + hstep, voffA);
            PG8_WAIT_L(8); PG8_BAR; PG8_WAIT_L(0); PG8_MMA(0, 0, At, B0); PG8_BAR; PG8_SCHED;
            PG8_LDB(B1, 1, 1); PG8_STAGE(PG8_SB(1, 0), b3, voffB);
            PG8_BAR; PG8_WAIT_L(0); PG8_MMA(0, 1, At, B1); PG8_BAR;
            PG8_LDA(At, 1, 1); PG8_STAGE(PG8_SA(1, 0), a3, voffA);
            PG8_BAR; PG8_WAIT_L(0); PG8_MMA(1, 0, At, B0); PG8_BAR; PG8_SCHED;
            PG8_STAGE(PG8_SB(1, 1), b3 + hstep, voffB);
            PG8_WAIT_V(6); PG8_BAR; PG8_MMA(1, 1, At, B1); PG8_BAR;
            }
        }
        if constexpr (ALIGN_EPI) { if (wr == 0) PG8_BAR; }
        if constexpr (!Epi::AFTER_DRAIN) { E(acc, cur, wr, wc, fr, fq); S.done(cur); }
        if (!has_next) break;
#pragma unroll
        for (int a = 0; a < 2; ++a)
#pragma unroll
            for (int b = 0; b < 2; ++b)
#pragma unroll
                for (int m = 0; m < 4; ++m)
#pragma unroll
                    for (int n = 0; n < 2; ++n) acc[a][b][m][n] = (f32x4){0.f, 0.f, 0.f, 0.f};
        cur = nxt; cA = nA; cB = nB; ++ui;
        if constexpr (Sched::GATHER) { _Pragma("unroll") for (int h_ = 0; h_ < 2; ++h_) _Pragma("unroll") for (int i_ = 0; i_ < 2; ++i_) gvo[h_][i_] = ngvo[h_][i_]; }
        if constexpr (ALIGN_EPI) { if (wr == 1) PG8_BAR; }
    }
    PG8_WAIT_V(0);
    if constexpr (!ALIGN_EPI) { if (wr == 0) PG8_BAR; }
    PG8_BAR;
    if constexpr (Epi::AFTER_DRAIN) { E.fused(acc, cur, wr, wc, fr, fq, lds, wid, lane); S.done(cur); }
#undef PG8_SA
#undef PG8_SB
#undef PG8_STAGE
#undef PG8_LDA
#undef PG8_STAGEA
#undef PG8_GOFF
#undef PG8_LDB
#undef PG8_MMA
#undef PG8_WAIT_V
#undef PG8_WAIT_L
#undef PG8_BAR
#undef PG8_SCHED
}
}
namespace att {
using bf16x8 = __attribute__((ext_vector_type(8))) short;
using s16x4  = __attribute__((ext_vector_type(4))) short;
using f32x16 = __attribute__((ext_vector_type(16))) float;
using u32x4  = __attribute__((ext_vector_type(4))) unsigned;
typedef unsigned short bf16;
constexpr int NW = 8, QBLK = 32, KVBLK = 64, LD = 1024, SEQ = 8192;
constexpr int SLOT = KVBLK * 128 * 2;
constexpr int KSL = 4, VSL = 5;
constexpr int LDS_K = 0, LDS_V = KSL * SLOT, LDS_WS = (KSL + VSL) * SLOT, LDS_FLG = LDS_WS + NW * 64 * 4, LDS_NXT = LDS_FLG + 64, LDS_PMX = LDS_NXT + 16, LDS_BYTES = LDS_PMX + 1024;
constexpr float THR2 = 11.5f;
constexpr float EXIT_ARG = -152.0f;
#define SBAR() __builtin_amdgcn_sched_barrier(0)
#define WAIT_BAR(N) asm volatile("s_waitcnt vmcnt(" #N ") lgkmcnt(0)\n\ts_barrier" ::: "memory")
template <int M> __device__ __forceinline__ float swz_xor(float v) {
  return __int_as_float(__builtin_amdgcn_ds_swizzle(__float_as_int(v), (M << 10) | 0x1f)); }
__device__ __forceinline__ int crow(int r, int hi) { return (r & 3) + 8 * (r >> 2) + 4 * hi; }
__device__ __forceinline__ unsigned cvtpk(float lo, float hi) { unsigned r; asm volatile("v_cvt_pk_bf16_f32 %0, %1, %2" : "=v"(r) : "v"(lo), "v"(hi)); return r; }
__device__ __forceinline__ void glds16s(unsigned voff, const void* sbase, unsigned lds_dst) { unsigned keep;
  asm volatile("s_mov_b32 %0, m0\n\ts_mov_b32 m0, %3\n\ts_nop 0\n\tglobal_load_lds_dwordx4 %1, %2\n\ts_mov_b32 m0, %0" : "=&s"(keep) : "v"(voff), "s"(sbase), "s"(lds_dst) : "memory"); }

__device__ __forceinline__ void partialSM(f32x16& p0, f32x16& p1, float& m_reg, float& alpha, float bt, bool diag, float qrel4, float slope2x2) {
  if (diag) {
#pragma unroll
    for (int r = 0; r < 16; ++r) { const float kk = (float)((r & 3) + 8 * (r >> 2));
      p0[r] -= slope2x2 * fmaxf(kk - qrel4, 0.f); p1[r] -= slope2x2 * fmaxf(kk + 32.0f - qrel4, 0.f); }
  }
  float pmax = p0[0];
#pragma unroll
  for (int r = 1; r < 16; ++r) pmax = fmaxf(pmax, p0[r]);
#pragma unroll
  for (int r = 0; r < 16; ++r) pmax = fmaxf(pmax, p1[r]);
  { auto rr = __builtin_amdgcn_permlane32_swap(__float_as_uint(pmax), __float_as_uint(pmax), false, false);
    pmax = fmaxf(__uint_as_float(rr[0]), __uint_as_float(rr[1])); }
  const float b = pmax + bt; float mn;
  if (__builtin_expect(__all(b - m_reg <= THR2), 1)) { mn = m_reg; alpha = 1.f; }
  else { mn = fmaxf(m_reg, b); alpha = __builtin_amdgcn_exp2f(m_reg - mn); m_reg = mn; }
  const float sh = bt - mn;
#pragma unroll
  for (int r = 0; r < 16; ++r) p0[r] = p0[r] + sh;
#pragma unroll
  for (int r = 0; r < 16; ++r) p1[r] = p1[r] + sh;
#pragma unroll
  for (int r = 0; r < 16; ++r) p0[r] = __builtin_amdgcn_exp2f(p0[r]);
}
__device__ __forceinline__ void finishSM(f32x16& p0, f32x16& p1, float alpha, float& l_reg, const float (&u)[16], float whi, float w32, bf16x8& pa0, bf16x8& pa1, bf16x8& pa2, bf16x8& pa3) {
#pragma unroll
  for (int r = 0; r < 16; ++r) p1[r] = __builtin_amdgcn_exp2f(p1[r]);
  float s0 = 0.f, s1 = 0.f;
#pragma unroll
  for (int r = 0; r < 16; ++r) s0 = fmaf(p0[r], u[r], s0);
#pragma unroll
  for (int r = 0; r < 16; ++r) s1 = fmaf(p1[r], u[r], s1);
  float ps = fmaf(s1, w32, s0) * whi;
  { auto rr = __builtin_amdgcn_permlane32_swap(__float_as_uint(ps), __float_as_uint(ps), false, false);
    ps = __uint_as_float(rr[0]) + __uint_as_float(rr[1]); }
  l_reg = l_reg * alpha + ps;
#define PK4(P, BASE, OUT) do { unsigned a0 = cvtpk(P[BASE + 0], P[BASE + 1]), a1 = cvtpk(P[BASE + 2], P[BASE + 3]);   \
    unsigned b0 = cvtpk(P[BASE + 4], P[BASE + 5]), b1 = cvtpk(P[BASE + 6], P[BASE + 7]);                              \
    auto r0 = __builtin_amdgcn_permlane32_swap(a0, b0, false, false); auto r1 = __builtin_amdgcn_permlane32_swap(a1, b1, false, false); \
    u32x4 w = {r0[0], r1[0], r0[1], r1[1]}; OUT = *reinterpret_cast<bf16x8*>(&w); } while (0)
  PK4(p0, 0, pa0); PK4(p0, 8, pa1); PK4(p1, 0, pa2); PK4(p1, 8, pa3);
#undef PK4
}
__device__ __forceinline__ void qkt(f32x16& p0, f32x16& p1, const char* Ks, const bf16x8* qr, int r32, const int (&kq)[4]) {
  p0 = f32x16{}; p1 = f32x16{};
#pragma unroll
  for (int d0 = 0; d0 < 4; ++d0) {
    const bf16x8 b0 = *reinterpret_cast<const bf16x8*>(Ks + r32 * 256 + kq[d0]);
    const bf16x8 b1 = *reinterpret_cast<const bf16x8*>(Ks + (32 + r32) * 256 + kq[d0]);
    p0 = __builtin_amdgcn_mfma_f32_32x32x16_bf16(b0, qr[d0], p0, 0, 0, 0);
    p1 = __builtin_amdgcn_mfma_f32_32x32x16_bf16(b1, qr[d0], p1, 0, 0, 0); }
}
__device__ __forceinline__ int v_rd_base(int lane) { return ((lane & 3) << 3) | (((lane >> 2) & 3) << 6) | (((lane >> 4) & 1) << 5) | (((lane >> 5) & 1) << 8); }
constexpr int v_rd_off(int d0, int ks, int half) { return d0 * 512 + ks * 4096 + half * 2048; }
typedef short v4i16_t __attribute__((ext_vector_type(4)));
template <int OFF> __device__ __forceinline__ s16x4 tr_read(int vb) {
  return __builtin_bit_cast(s16x4, __builtin_amdgcn_ds_read_tr16_b64_v4i16((__attribute__((address_space(3))) v4i16_t*)(uintptr_t)(unsigned)(vb + OFF)));
}
template <int D0> __device__ __forceinline__ void pv_one(f32x16& od, int vb, bf16x8 pa0, bf16x8 pa1, bf16x8 pa2, bf16x8 pa3) {
  const s16x4 l0 = tr_read<v_rd_off(D0, 0, 0)>(vb), h0 = tr_read<v_rd_off(D0, 0, 1)>(vb), l1 = tr_read<v_rd_off(D0, 1, 0)>(vb), h1 = tr_read<v_rd_off(D0, 1, 1)>(vb);
  const s16x4 l2 = tr_read<v_rd_off(D0, 2, 0)>(vb), h2 = tr_read<v_rd_off(D0, 2, 1)>(vb), l3 = tr_read<v_rd_off(D0, 3, 0)>(vb), h3 = tr_read<v_rd_off(D0, 3, 1)>(vb);
  asm volatile("s_waitcnt lgkmcnt(0)" ::: "memory"); SBAR();
#define PK(L, H) (bf16x8){L[0], L[1], L[2], L[3], H[0], H[1], H[2], H[3]}
  od = __builtin_amdgcn_mfma_f32_32x32x16_bf16(pa0, PK(l0, h0), od, 0, 0, 0);
  od = __builtin_amdgcn_mfma_f32_32x32x16_bf16(pa1, PK(l1, h1), od, 0, 0, 0);
  od = __builtin_amdgcn_mfma_f32_32x32x16_bf16(pa2, PK(l2, h2), od, 0, 0, 0);
  od = __builtin_amdgcn_mfma_f32_32x32x16_bf16(pa3, PK(l3, h3), od, 0, 0, 0);
#undef PK
}
__device__ __forceinline__ void pv_d0(f32x16* o, int vb, bf16x8 pa0, bf16x8 pa1, bf16x8 pa2, bf16x8 pa3) {
  pv_one<0>(o[0], vb, pa0, pa1, pa2, pa3); pv_one<1>(o[1], vb, pa0, pa1, pa2, pa3); pv_one<2>(o[2], vb, pa0, pa1, pa2, pa3); pv_one<3>(o[3], vb, pa0, pa1, pa2, pa3);
}

__device__ __forceinline__ void softmax_tile(f32x16& p0, f32x16& p1, float& m_reg, float& mmin, float& l_reg, f32x16* o, float bt, bool diag, float qrel4, float slope2x2, const float (&u)[16], float whi, float w32,
                                             float* al_l, int r32, int hi, bf16x8& pa0, bf16x8& pa1, bf16x8& pa2, bf16x8& pa3) {
  if (diag) {
#pragma unroll
    for (int r = 0; r < 16; ++r) { const float kk = (float)((r & 3) + 8 * (r >> 2));
      p0[r] -= slope2x2 * fmaxf(kk - qrel4, 0.f); p1[r] -= slope2x2 * fmaxf(kk + 32.0f - qrel4, 0.f); }
  }
  float pmax = p0[0];
#pragma unroll
  for (int r = 1; r < 16; ++r) pmax = fmaxf(pmax, p0[r]);
#pragma unroll
  for (int r = 0; r < 16; ++r) pmax = fmaxf(pmax, p1[r]);
  { auto rr = __builtin_amdgcn_permlane32_swap(__float_as_uint(pmax), __float_as_uint(pmax), false, false);
    pmax = fmaxf(__uint_as_float(rr[0]), __uint_as_float(rr[1])); }
  const float b = pmax + bt;
  if (__builtin_expect(!__all(b - m_reg <= THR2), 0)) {
    const float mn = fmaxf(m_reg, b), alpha = __builtin_amdgcn_exp2f(m_reg - mn); m_reg = mn; l_reg *= alpha;
    { float mm = m_reg;
      mm = fminf(mm, swz_xor<1>(mm)); mm = fminf(mm, swz_xor<2>(mm)); mm = fminf(mm, swz_xor<4>(mm)); mm = fminf(mm, swz_xor<8>(mm)); mm = fminf(mm, swz_xor<16>(mm));
      mmin = __uint_as_float(__builtin_amdgcn_readfirstlane(__float_as_uint(mm))); }
    if (hi == 0) al_l[r32] = alpha; asm volatile("s_waitcnt lgkmcnt(0)" ::: "memory");
#pragma unroll
    for (int d = 0; d < 4; ++d)
#pragma unroll
      for (int r = 0; r < 16; ++r) o[d][r] *= al_l[crow(r, hi)];
  }
  const float sh = bt - m_reg;
#pragma unroll
  for (int r = 0; r < 16; ++r) p0[r] = __builtin_amdgcn_exp2f(p0[r] + sh);
#pragma unroll
  for (int r = 0; r < 16; ++r) p1[r] = __builtin_amdgcn_exp2f(p1[r] + sh);
  float s0 = 0.f, s1 = 0.f;
#pragma unroll
  for (int r = 0; r < 16; ++r) s0 = fmaf(p0[r], u[r], s0);
#pragma unroll
  for (int r = 0; r < 16; ++r) s1 = fmaf(p1[r], u[r], s1);
  float ps = fmaf(s1, w32, s0) * whi;
  { auto rr = __builtin_amdgcn_permlane32_swap(__float_as_uint(ps), __float_as_uint(ps), false, false);
    ps = __uint_as_float(rr[0]) + __uint_as_float(rr[1]); }
  l_reg += ps;
#define PK4(P, BASE, OUT) do { unsigned a0 = cvtpk(P[BASE + 0], P[BASE + 1]), a1 = cvtpk(P[BASE + 2], P[BASE + 3]);   \
    unsigned b0 = cvtpk(P[BASE + 4], P[BASE + 5]), b1 = cvtpk(P[BASE + 6], P[BASE + 7]);                              \
    auto r0 = __builtin_amdgcn_permlane32_swap(a0, b0, false, false); auto r1 = __builtin_amdgcn_permlane32_swap(a1, b1, false, false); \
    u32x4 w = {r0[0], r1[0], r0[1], r1[1]}; OUT = *reinterpret_cast<bf16x8*>(&w); } while (0)
  PK4(p0, 0, pa0); PK4(p0, 8, pa1); PK4(p1, 0, pa2); PK4(p1, 8, pa3);
#undef PK4
}
template <int D0> __device__ __forceinline__ void vload8(bf16x8 (&vf)[8], int vb) {
#define VF1(i, d0, ks) do { const s16x4 l_ = tr_read<v_rd_off(d0, ks, 0)>(vb), h_ = tr_read<v_rd_off(d0, ks, 1)>(vb); vf[i] = (bf16x8){l_[0], l_[1], l_[2], l_[3], h_[0], h_[1], h_[2], h_[3]}; } while (0)
  VF1(0, D0, 0); VF1(1, D0, 1); VF1(2, D0, 2); VF1(3, D0, 3); VF1(4, D0 + 1, 0); VF1(5, D0 + 1, 1); VF1(6, D0 + 1, 2); VF1(7, D0 + 1, 3);
#undef VF1
}
__device__ __forceinline__ void pv8(f32x16& oa, f32x16& ob, const bf16x8 (&vf)[8], bf16x8 pa0, bf16x8 pa1, bf16x8 pa2, bf16x8 pa3) {
  oa = __builtin_amdgcn_mfma_f32_32x32x16_bf16(pa0, vf[0], oa, 0, 0, 0); ob = __builtin_amdgcn_mfma_f32_32x32x16_bf16(pa0, vf[4], ob, 0, 0, 0);
  oa = __builtin_amdgcn_mfma_f32_32x32x16_bf16(pa1, vf[1], oa, 0, 0, 0); ob = __builtin_amdgcn_mfma_f32_32x32x16_bf16(pa1, vf[5], ob, 0, 0, 0);
  oa = __builtin_amdgcn_mfma_f32_32x32x16_bf16(pa2, vf[2], oa, 0, 0, 0); ob = __builtin_amdgcn_mfma_f32_32x32x16_bf16(pa2, vf[6], ob, 0, 0, 0);
  oa = __builtin_amdgcn_mfma_f32_32x32x16_bf16(pa3, vf[3], oa, 0, 0, 0); ob = __builtin_amdgcn_mfma_f32_32x32x16_bf16(pa3, vf[7], ob, 0, 0, 0);
}

__device__ __forceinline__ int attn_unit(const bf16* Qb, const bf16* __restrict__ Kh, const bf16* __restrict__ Vh, bf16* Ob, int i, float slope2, const float (&u)[16], float w4, float w32, float lam,
                                          const float* __restrict__ subln_g, const float* pmx, unsigned* qctr, char* lds, int probe = 0) {
  int tid = threadIdx.x; asm volatile("" : "+v"(tid));
  const int wid = __builtin_amdgcn_readfirstlane(tid >> 6), lane = tid & 63, r32 = lane & 31, hi = lane >> 5;
  const int c = wid & 1, rb = wid >> 1, grp = wid >> 2;
  const unsigned lds0 = (unsigned)(uintptr_t)lds;
  char* K_lds = lds + LDS_K;
  float* ws = (float*)(lds + LDS_WS) + wid * 64; float* li_l = ws; float* al_l = ws + 32;
  float m_reg = -1e30f, l_reg = 0; f32x16 o[4] = {}; bf16x8 qr[4];
  const bf16* Qw = Qb + (long)(rb * QBLK + r32) * LD + c * 64 + hi * 8;
#pragma unroll
  for (int d0 = 0; d0 < 4; ++d0) qr[d0] = *reinterpret_cast<const bf16x8*>(Qw + d0 * 16);
  float qn;
  unsigned* flg = (unsigned*)(lds + LDS_FLG);
  unsigned kvo, vvo;
  { const int p = wid;
    { const int row = 4 * p + (lane >> 4), ch = (lane & 15) ^ (row & 15); kvo = (unsigned)((row * LD + ch * 8) * 2); }
    { const int lp = lane & 31, kk = 8 * (p >> 1) + (lp >> 2), key = (kk & ~0xC) | ((kk & 4) << 1) | ((kk & 8) >> 1), col = 32 * (2 * (p & 1) + (lane >> 5)) + 8 * (lp & 3); vvo = (unsigned)((key * LD + col) * 2); } }
  const unsigned kdst = lds0 + LDS_K + wid * 1024, vdst = lds0 + LDS_V + wid * 1024;
  const int NT = 2 * i + 2;
#define DMA_K(n, slotoff) do { const char* sb_ = (const char*)Kh + (size_t)(NT - 1 - (n)) * (KVBLK * LD * 2); \
    glds16s(kvo, sb_, (unsigned)__builtin_amdgcn_readfirstlane(kdst + (slotoff))); glds16s(kvo, sb_ + 32 * LD * 2, (unsigned)__builtin_amdgcn_readfirstlane(kdst + (slotoff) + 8192)); } while (0)
#define DMA_V(n, slotoff) do { const char* sb_ = (const char*)Vh + (size_t)(NT - 1 - (n)) * (KVBLK * LD * 2); \
    glds16s(vvo, sb_, (unsigned)__builtin_amdgcn_readfirstlane(vdst + (slotoff))); glds16s(vvo, sb_ + 32 * LD * 2, (unsigned)__builtin_amdgcn_readfirstlane(vdst + (slotoff) + 8192)); } while (0)
#define WAITB(cnt) do { SBAR(); const int c_ = (cnt); if (c_ >= 8) { WAIT_BAR(8); } else if (c_ >= 6) { WAIT_BAR(6); } else if (c_ >= 4) { WAIT_BAR(4); } else if (c_ >= 2) { WAIT_BAR(2); } else { WAIT_BAR(0); } SBAR(); } while (0)
#define BSZ(j) (((j) + 4 < NT ? 2 : 0) + ((j) + 3 < NT ? 2 : 0))
  const int kq0 = r32 * 256 + (((c * 8 + hi) ^ (r32 & 15)) * 16);
  const int vb0 = (int)(lds0 + LDS_V) + v_rd_base(lane);
  const bool skiplast = rb < 2;
  const float qloc = (float)(rb * QBLK + r32 - 4 * hi);
  const float whi = hi ? w4 : 1.0f;
  const float slope64 = slope2 * 64.0f, slope2x2 = 2.0f * slope2;
  bf16x8 kf[8], vfa[8], vfb[8], pa0, pa1, pa2, pa3; f32x16 p0, p1;
#define KLOAD(slotoff) do { const char* ks_ = K_lds + (slotoff); _Pragma("unroll") for (int d0 = 0; d0 < 4; ++d0) { \
    kf[2 * d0] = *reinterpret_cast<const bf16x8*>(ks_ + (kq0 ^ (32 * d0))); kf[2 * d0 + 1] = *reinterpret_cast<const bf16x8*>(ks_ + (kq0 ^ (32 * d0)) + 8192); } } while (0)
  if (wid == 0) glds16s((unsigned)lane * 16u, pmx, (unsigned)__builtin_amdgcn_readfirstlane(lds0 + LDS_PMX));
  DMA_K(0, 0);
  { float s = 0.f;
#pragma unroll
    for (int d0 = 0; d0 < 4; ++d0)
#pragma unroll
      for (int e = 0; e < 8; ++e) { const float v = __uint_as_float(((unsigned)(unsigned short)qr[d0][e]) << 16); s = fmaf(v, v, s); }
    { auto rr = __builtin_amdgcn_permlane32_swap(__float_as_uint(s), __float_as_uint(s), false, false); s = __uint_as_float(rr[0]) + __uint_as_float(rr[1]); }
    s = fmaxf(s, swz_xor<1>(s)); s = fmaxf(s, swz_xor<2>(s)); s = fmaxf(s, swz_xor<4>(s)); s = fmaxf(s, swz_xor<8>(s)); s = fmaxf(s, swz_xor<16>(s));
    qn = __uint_as_float(__builtin_amdgcn_readfirstlane(__float_as_uint(sqrtf(s) * 1.001f))); }
  DMA_K(1, SLOT); DMA_V(0, 0);
  if (2 < NT) { DMA_K(2, 2 * SLOT); } DMA_V(1, SLOT);
  if (3 < NT) { DMA_K(3, 3 * SLOT); } if (2 < NT) { DMA_V(2, 2 * SLOT); }
  SBAR(); if (2 < NT) { WAIT_BAR(12); } else { WAIT_BAR(6); } SBAR();
  KLOAD(0);
  if (wid < 2) {
    float* pm_ = (float*)(lds + LDS_PMX) + wid * 128;
    float a = pm_[lane], b2 = pm_[64 + lane];
#define DPP_MAX(v, ctrl, rmask) v = fmaxf(v, __int_as_float(__builtin_amdgcn_update_dpp(__float_as_int(v), __float_as_int(v), ctrl, rmask, 0xf, false)))
    DPP_MAX(a, 0x111, 0xf); DPP_MAX(a, 0x112, 0xf); DPP_MAX(a, 0x114, 0xf); DPP_MAX(a, 0x118, 0xf); DPP_MAX(a, 0x142, 0xa); DPP_MAX(a, 0x143, 0xc);
    DPP_MAX(b2, 0x111, 0xf); DPP_MAX(b2, 0x112, 0xf); DPP_MAX(b2, 0x114, 0xf); DPP_MAX(b2, 0x118, 0xf); DPP_MAX(b2, 0x142, 0xa); DPP_MAX(b2, 0x143, 0xc);
#undef DPP_MAX
    b2 = fmaxf(b2, __int_as_float(__builtin_amdgcn_readlane(__float_as_int(a), 63)));
    pm_[lane] = sqrtf(a) * 1.001f; pm_[64 + lane] = sqrtf(b2) * 1.001f;
  }
  if (grp == 1) WAITB(BSZ(-2) + BSZ(-1));
  int v5 = 0;
  float mmin = -1e30f;
  for (int n = 0; n < NT; ++n) {
    const int v5p = (v5 == 0) ? 4 : v5 - 1, v5n2 = (v5 >= 3) ? v5 - 3 : v5 + 2;
    int vbp = vb0 + v5p * SLOT; asm volatile("" : "+v"(vbp));
    p0 = f32x16{}; p1 = f32x16{};
#define QKM(i) do { if ((i) & 1) p1 = __builtin_amdgcn_mfma_f32_32x32x16_bf16(kf[i], qr[(i) >> 1], p1, 0, 0, 0); else p0 = __builtin_amdgcn_mfma_f32_32x32x16_bf16(kf[i], qr[(i) >> 1], p0, 0, 0, 0); } while (0)
#define VFR(vf, i, D0) do { const s16x4 l_ = tr_read<v_rd_off((D0) + ((i) >> 2), (i) & 3, 0)>(vbp), h_ = tr_read<v_rd_off((D0) + ((i) >> 2), (i) & 3, 1)>(vbp); vf[i] = (bf16x8){l_[0], l_[1], l_[2], l_[3], h_[0], h_[1], h_[2], h_[3]}; } while (0)
#define PVM(oo, pa, vf, i) oo = __builtin_amdgcn_mfma_f32_32x32x16_bf16(pa, vf[i], oo, 0, 0, 0)
    if (n > 0) {
      QKM(0); SBAR(); VFR(vfa, 0, 0); SBAR(); QKM(1); SBAR(); VFR(vfa, 4, 0); SBAR(); QKM(2); SBAR(); VFR(vfa, 1, 0); SBAR(); QKM(3); SBAR(); VFR(vfa, 5, 0); SBAR();
      QKM(4); SBAR(); VFR(vfa, 2, 0); SBAR(); QKM(5); SBAR(); VFR(vfa, 6, 0); SBAR(); QKM(6); SBAR(); VFR(vfa, 3, 0); SBAR(); QKM(7); SBAR(); VFR(vfa, 7, 0); SBAR();
      if (n + 3 < NT) DMA_K(n + 3, ((n + 3) & 3) * SLOT);
      SBAR();
      PVM(o[0], pa0, vfa, 0); SBAR(); VFR(vfb, 0, 2); SBAR(); PVM(o[1], pa0, vfa, 4); SBAR(); VFR(vfb, 4, 2); SBAR(); PVM(o[0], pa1, vfa, 1); SBAR(); VFR(vfb, 1, 2); SBAR(); PVM(o[1], pa1, vfa, 5); SBAR(); VFR(vfb, 5, 2); SBAR();
      PVM(o[0], pa2, vfa, 2); SBAR(); VFR(vfb, 2, 2); SBAR(); PVM(o[1], pa2, vfa, 6); SBAR(); VFR(vfb, 6, 2); SBAR(); PVM(o[0], pa3, vfa, 3); SBAR(); VFR(vfb, 3, 2); SBAR(); PVM(o[1], pa3, vfa, 7); SBAR(); VFR(vfb, 7, 2); SBAR();
      if (n + 2 < NT) DMA_V(n + 2, v5n2 * SLOT);
      SBAR();
      pv8(o[2], o[3], vfb, pa0, pa1, pa2, pa3);
    } else {
#pragma unroll
      for (int d0 = 0; d0 < 4; ++d0) { p0 = __builtin_amdgcn_mfma_f32_32x32x16_bf16(kf[2 * d0], qr[d0], p0, 0, 0, 0); p1 = __builtin_amdgcn_mfma_f32_32x32x16_bf16(kf[2 * d0 + 1], qr[d0], p1, 0, 0, 0); }
    }
#undef QKM
#undef VFR
#undef PVM
    WAITB(BSZ(n - 2) + BSZ(n - 1));
    __builtin_amdgcn_s_setprio(1);
    u32x4 f0 = {0u, 0u, 0u, 0u}, f1 = {0u, 0u, 0u, 0u};
    if (n > 0) { f0 = *(const u32x4*)(flg + ((n - 1) & 1) * 8); f1 = *(const u32x4*)(flg + ((n - 1) & 1) * 8 + 4); }
    const int tn = NT - 1 - n;
    const float pmv = ((const float*)(lds + LDS_PMX))[c * 128 + (tn > 0 ? tn - 1 : 0)];
    KLOAD(((n + 1) & 3) * SLOT); SBAR();
    if (!(skiplast && n == 0))
      softmax_tile(p0, p1, m_reg, mmin, l_reg, o, slope64 * (float)(NT - 1 - n), (n == 0) || (skiplast && n == 1), (n == 0) ? qloc - 64.0f : qloc, slope2x2, u, whi, w32, al_l, r32, hi, pa0, pa1, pa2, pa3);
    else { pa0 = bf16x8{}; pa1 = bf16x8{}; pa2 = bf16x8{}; pa3 = bf16x8{}; }
    { const float argb = (tn > 0) ? fmaf(qn, pmv, slope64 * (float)(tn - 1) - mmin) : 0.f;
      if (lane == 0) flg[(n & 1) * 8 + wid] = (argb + slope64 < EXIT_ARG) ? 1u : 0u; }
    const bool stop = __builtin_amdgcn_readfirstlane(f0.x & f0.y & f0.z & f0.w & f1.x & f1.y & f1.z & f1.w) != 0u;
    __builtin_amdgcn_s_setprio(0);
    WAITB(BSZ(n - 1));
    v5 = (v5 == 4) ? 0 : v5 + 1;
    if (stop) break;
  }
  __builtin_amdgcn_s_setprio(0);
  float gsc[4];
#pragma unroll
  for (int d0 = 0; d0 < 4; ++d0) gsc[d0] = subln_g[d0 * 32 + r32] * 0.8f;
  { int vbl = vb0 + ((v5 == 0) ? 4 : v5 - 1) * SLOT; asm volatile("" : "+v"(vbl));
    vload8<0>(vfa, vbl); vload8<2>(vfb, vbl); SBAR();
    pv8(o[0], o[1], vfa, pa0, pa1, pa2, pa3);
    SBAR(); asm volatile("s_waitcnt lgkmcnt(0)" ::: "memory"); SBAR();
    pv8(o[2], o[3], vfb, pa0, pa1, pa2, pa3); }
  if (grp == 0) WAITB(0);
  if (probe == 2) {
    WAITB(0);
    if (wid == 1 && lane == 0) *(unsigned*)(lds + LDS_NXT) = __hip_atomic_fetch_add(qctr, 1u, __ATOMIC_RELAXED, __HIP_MEMORY_SCOPE_AGENT);
    if (wid == 0 && lane == 0) Ob[0] = (bf16)__float_as_uint(o[0][0] + o[1][1] + o[2][2] + o[3][3] + l_reg);
    WAITB(0);
    return (int)__builtin_amdgcn_readfirstlane(*(const unsigned*)(lds + LDS_NXT));
  }
  if (hi == 0) li_l[r32] = l_reg; asm volatile("s_waitcnt lgkmcnt(0)" ::: "memory");
  const float sgn = c ? lam : 1.0f;
#pragma unroll
  for (int r = 0; r < 16; ++r) { const float rl = __builtin_amdgcn_rcpf(li_l[crow(r, hi)]) * sgn;
#pragma unroll
    for (int d0 = 0; d0 < 4; ++d0) o[d0][r] *= rl; }
  WAITB(0);
  float* ex = (float*)lds + (size_t)rb * (4 * 16 * 64);
#define EPI_SEND(RS) do { _Pragma("unroll") for (int d0 = 0; d0 < 4; ++d0) _Pragma("unroll") for (int r8 = 0; r8 < 8; ++r8) ex[((c * 4 + d0) * 8 + r8) * 64 + lane] = o[d0][(RS) + r8]; } while (0)
  if (c == 0) { EPI_SEND(8); } else { EPI_SEND(0); }
#undef EPI_SEND
  WAITB(0);
  if (wid == 1 && lane == 0) *(unsigned*)(lds + LDS_NXT) = __hip_atomic_fetch_add(qctr, 1u, __ATOMIC_RELAXED, __HIP_MEMORY_SCOPE_AGENT);
  float ss[8]; float vo[4][8];
#define EPI_COMBINE(RK) do { _Pragma("unroll") for (int r8 = 0; r8 < 8; ++r8) { float s_ = 0.f; _Pragma("unroll") for (int d0 = 0; d0 < 4; ++d0) { \
      const float oth_ = ex[(((1 - c) * 4 + d0) * 8 + r8) * 64 + lane]; const float v_ = (c == 0) ? o[d0][(RK) + r8] - oth_ : oth_ - o[d0][(RK) + r8]; vo[d0][r8] = v_; s_ = fmaf(v_, v_, s_); } ss[r8] = s_; } } while (0)
  if (c == 0) { EPI_COMBINE(0); } else { EPI_COMBINE(8); }
#undef EPI_COMBINE
#define RSTEP(M) do { float t_[8]; _Pragma("unroll") for (int r = 0; r < 8; ++r) t_[r] = swz_xor<M>(ss[r]); _Pragma("unroll") for (int r = 0; r < 8; ++r) ss[r] += t_[r]; SBAR(); } while (0)
  RSTEP(1); RSTEP(2); RSTEP(4); RSTEP(8); RSTEP(16);
#undef RSTEP
  bf16* stg = (bf16*)(lds + LDS_V) + wid * (16 * 136);
#pragma unroll
  for (int r8 = 0; r8 < 8; ++r8) { const float rs = __builtin_amdgcn_rsqf(ss[r8] * (1.0f / 128.0f) + 1e-5f); const int orow = (r8 & 3) + 8 * (r8 >> 2) + 4 * hi;
#pragma unroll
    for (int d0 = 0; d0 < 4; ++d0) { const float v = vo[d0][r8] * rs * gsc[d0]; stg[orow * 136 + d0 * 32 + r32] = (bf16)(cvtpk(v, v) & 0xffffu); } }
  asm volatile("s_waitcnt lgkmcnt(0)" ::: "memory");
  { bf16* Ow = Ob + (long)(rb * QBLK + c * 16) * LD;
    int lane2 = lane; asm volatile("" : "+v"(lane2));
    const int srow = lane2 >> 4, sch = lane2 & 15; const bf16* sp = stg + srow * 136 + sch * 8; bf16* gp = Ow + (long)srow * LD + sch * 8;
#pragma unroll
    for (int q = 0; q < 4; ++q) { const u32x4 v = *(const u32x4*)(sp + q * 4 * 136); *(u32x4*)(gp + (long)q * 4 * LD) = v; } }
  SBAR(); asm volatile("s_waitcnt lgkmcnt(0)\n\ts_barrier" ::: "memory"); SBAR();
  return (int)__builtin_amdgcn_readfirstlane(*(const unsigned*)(lds + LDS_NXT));
#undef DMA_K
#undef DMA_V
#undef WAITB
#undef BSZ
#undef KLOAD
}
#undef SBAR
#undef WAIT_BAR
}

#define GAS __attribute__((address_space(1)))
#define LAS __attribute__((address_space(3)))
typedef unsigned short bf16;
typedef unsigned v4u __attribute__((ext_vector_type(4)));
typedef float f32x4 __attribute__((ext_vector_type(4)));
typedef short bf16x8 __attribute__((ext_vector_type(8)));
typedef GAS unsigned gu32;
typedef GAS unsigned long long gu64;
#define RLX_AGENT __ATOMIC_RELAXED, __HIP_MEMORY_SCOPE_AGENT
#define LDS_WAIT() asm volatile("s_waitcnt lgkmcnt(0)" ::: "memory")
#define VM_WAIT() asm volatile("s_waitcnt vmcnt(0)" ::: "memory")
__device__ __forceinline__ unsigned long long rt() { return __builtin_amdgcn_s_memrealtime(); }
__device__ __forceinline__ unsigned f2bf(float f) { unsigned u = __builtin_bit_cast(unsigned, f); return (u + 0x7fffu + ((u >> 16) & 1u)) >> 16; }
__device__ __forceinline__ unsigned pk2(float lo, float hi) { unsigned r; asm("v_cvt_pk_bf16_f32 %0, %1, %2" : "=v"(r) : "v"(lo), "v"(hi)); return r; }

#define XB_TMO      128
#define XB_XCNT(j)  (256  + 64 * (j))
#define XB_XSUB(j)  (1280 + 64 * (j))
#define XB_XGEN(j)  (2304 + 64 * (j))
#define XB_TOP      3328
#define XB_TOPGEN   3392
#define XCD_BAR_WORDS 3456
#define XB_SPIN_CAP (1u << 18)

__device__ __forceinline__ unsigned xb_ld(unsigned* p)              { return __hip_atomic_load(p, __ATOMIC_RELAXED, __HIP_MEMORY_SCOPE_AGENT); }
__device__ __forceinline__ unsigned xb_add(unsigned* p, unsigned v) { return __hip_atomic_fetch_add(p, v, __ATOMIC_RELAXED, __HIP_MEMORY_SCOPE_AGENT); }
__device__ __forceinline__ unsigned xb_xcc_id() { return (unsigned)__builtin_amdgcn_s_getreg((3 << 11) | 20) & 0xFu; }
#define XB_SPIN(cond, bar) do { unsigned _sp = 0; while (cond) { __builtin_amdgcn_s_sleep(1); \
    if ((++_sp & 255u) == 0u) { if (xb_ld(&(bar)[XB_TMO])) break; if (_sp > XB_SPIN_CAP) { atomicAdd(&(bar)[XB_TMO], 1u); break; } } } } while (0)

struct XcdBarrier {
    unsigned* bar; unsigned x;
    volatile LAS unsigned* st;
};

__device__ __forceinline__ XcdBarrier xcd_barrier_post(unsigned* bar, volatile LAS unsigned* st) {
    XcdBarrier b; b.bar = bar; b.x = xb_xcc_id(); b.st = st;
    if (threadIdx.x == 0) (void)xb_add(&bar[XB_XCNT(b.x)], 1u);
    return b;
}
__device__ __forceinline__ void xcd_barrier_complete(unsigned* bar, unsigned x, unsigned& nloc, unsigned& nx) {
    const unsigned G = gridDim.x * gridDim.y * gridDim.z;
    unsigned sum, cnt, mine, sp = 0u;
    for (;;) {
        sum = 0u; cnt = 0u; mine = 0u;
#pragma unroll
        for (unsigned j = 0; j < 16; ++j) { const unsigned c = xb_ld(&bar[XB_XCNT(j)]); sum += c; cnt += (c > 0u) ? 1u : 0u; mine = (j == x) ? c : mine; }
        if (sum == G) break;
        __builtin_amdgcn_s_sleep(1);
        if ((++sp & 255u) == 0u) { if (xb_ld(&bar[XB_TMO])) break; if (sp > XB_SPIN_CAP) { atomicAdd(&bar[XB_TMO], 1u); break; } }
    }
    nloc = mine > 0u ? mine : 1u; nx = cnt > 0u ? cnt : 1u;
}

__device__ __forceinline__ void xcd_barrier(const XcdBarrier& b) {
    asm volatile("s_waitcnt vmcnt(0)" ::: "memory");
    __syncthreads();
    if (threadIdx.x == 0) {
        unsigned* bar = b.bar;
        __builtin_amdgcn_s_waitcnt(0);
        unsigned nloc = b.st[0], nx = b.st[1];
        if (nloc == 0u) { xcd_barrier_complete(bar, b.x, nloc, nx); b.st[0] = nloc; b.st[1] = nx; }
        const unsigned old = xb_add(&bar[XB_XSUB(b.x)], 1u);
        const unsigned gen = old / nloc;
        if (old + 1u == (gen + 1u) * nloc) {
            __builtin_amdgcn_fence(__ATOMIC_RELEASE, "agent");
            asm volatile("s_waitcnt vmcnt(0)" ::: "memory");
            const unsigned og = xb_add(&bar[XB_TOP], 1u);
            const unsigned tg = og / nx;
            if (og + 1u == (tg + 1u) * nx) xb_add(&bar[XB_TOPGEN], 1u);
            else XB_SPIN(xb_ld(&bar[XB_TOPGEN]) == tg, bar);
            __builtin_amdgcn_fence(__ATOMIC_ACQUIRE, "agent");
            xb_add(&bar[XB_XGEN(b.x)], 1u);
            asm volatile("s_waitcnt vmcnt(0)" ::: "memory");
        } else {
            XB_SPIN(xb_ld(&bar[XB_XGEN(b.x)]) == gen, bar);
            __builtin_amdgcn_fence(__ATOMIC_ACQUIRE, "agent");
            asm volatile("s_waitcnt vmcnt(0)" ::: "memory");
        }
    }
    __syncthreads();
}

typedef unsigned v2u __attribute__((ext_vector_type(2)));

constexpr int NWAVES = 8, NTHREADS = NWAVES * 64;
constexpr int BATCH = 8, SEQ = 8192, D = 1024, T = BATCH * SEQ;
constexpr int INW = 6144, GW = 512, NHEAD = 8;
constexpr int NEXP = 32, EHID = 512, NASSIGN = T * 2;
constexpr int MAXTILES = (NASSIGN + NEXP * 255) / 256 + 1;
constexpr int MOE_CAP = NASSIGN;
constexpr float LN_EPS = 1e-5f;
constexpr float ALPHA = 1.189207115002721f;
constexpr float C2 = 0.125f * 1.4426950408889634f;
constexpr int NPHASE = 12;
constexpr unsigned STAGGER_P1_TICKS = 900;
#ifndef MK_ONE_LAUNCH
#define MK_ONE_LAUNCH 1
#endif
#ifndef MK_PROBE_PHASE
#define MK_PROBE_PHASE -1
#endif

constexpr size_t MiB = 1u << 20;
constexpr size_t WS_CTL = 0, CTL_ZERO_BYTES = 64 * 1024;
constexpr size_t WS_ROUTE_E = 1 * MiB;
constexpr size_t WS_ROUTE_W = WS_ROUTE_E + (size_t)NASSIGN * 4;
constexpr size_t WS_SLOT_TOK = WS_ROUTE_W + (size_t)NASSIGN * 4;
constexpr size_t WS_SLOT_W = WS_SLOT_TOK + (size_t)MAXTILES * 256 * 4;
constexpr size_t WS_TILE_E = WS_SLOT_W + (size_t)MAXTILES * 256 * 4;
constexpr size_t WS_TILE_ROWS = WS_TILE_E + 4096;
constexpr size_t WS_KN2 = WS_TILE_ROWS + 4096;
constexpr size_t WS_PMX = WS_KN2 + 8 * 8 * 2 * 128 * 4;
constexpr size_t WS_MISC_END = WS_PMX + 8 * 8 * 2 * 128 * 4;
static_assert(WS_MISC_END <= 4 * MiB, "misc tables");
constexpr size_t WS_WIN = 4 * MiB;
constexpr size_t WS_WA = 16 * MiB;
constexpr size_t WS_WB = 17 * MiB;
constexpr size_t WS_WO = 19 * MiB;
constexpr size_t WS_SGW = 21 * MiB;
constexpr size_t WS_WGU = 22 * MiB;
constexpr size_t WS_WD = 86 * MiB;
constexpr size_t WS_XB = 128 * MiB;
constexpr size_t WS_Q = 256 * MiB;
constexpr size_t WS_K = 384 * MiB, WS_VAL = 512 * MiB, WS_GA = 640 * MiB, WS_GB = 768 * MiB;
constexpr size_t WS_LIST_TOK = 384 * MiB, WS_LIST_W = 416 * MiB;
static_assert((size_t)NEXP * MOE_CAP * 4 + 1024 <= 32 * MiB, "dispatch lists");
constexpr size_t WS_PART = 256 * MiB;
constexpr size_t WS_STATS = 272 * MiB;
constexpr size_t WS_XS = 256 * MiB;
constexpr size_t WS_HB = 528 * MiB;
constexpr size_t WS_FFN = 664 * MiB;
constexpr size_t WS_END = 920 * MiB;
static_assert(WS_XS + (size_t)MAXTILES * 256 * 1024 * 2 <= WS_HB && WS_HB + (size_t)MAXTILES * 256 * 512 * 2 <= WS_FFN && WS_FFN + (size_t)NASSIGN * 1024 * 2 <= WS_END, "moe buffers");
constexpr size_t OUT_UV = 0, OUT_SG = 128 * MiB;
constexpr int CW_BAR = 1024;
constexpr int CW_CNT = 12288;
constexpr int CW_CUR = 12288 + 64;
constexpr int CW_AQ = 12288 + 128;
static_assert((CW_BAR + 3 * 3456) <= CW_CNT && (CW_AQ + 3 * 512) * 4 <= (int)CTL_ZERO_BYTES, "ctl map");

constexpr int RING_OFF = 0, RING_BYTES = 155648;
constexpr int LDSCTL_OFF = RING_BYTES, MISC_OFF = LDSCTL_OFF + 320;
constexpr int MOE_LDS_OFF = 131072;
static_assert(MOE_LDS_OFF + pg8::MOE_LDS_BYTES <= RING_BYTES && MOE_LDS_OFF + INW * 4 <= RING_BYTES, "MoE LDS tables / P1 bias copy");
constexpr int LDS_BYTES = 163840;
static_assert(MISC_OFF + 128 <= LDS_BYTES, "LDS map");

__device__ __forceinline__ float wave_sum(float v) {
#pragma unroll
    for (int o = 1; o < 64; o <<= 1) v += __shfl_xor(v, o);
    return v;
}

__device__ __forceinline__ void p0_transpose_item(const float* W, int K, int N, bf16* WT, int row_off, LAS float* scr, int item, int lane) {
    const int nblk = N / 32, kb = item / nblk, nb = item % nblk, k0 = 64 * kb, n0 = 32 * nb;
    float tv[32];
#pragma unroll
    for (int i = 0; i < 32; ++i) tv[i] = W[(size_t)(k0 + 2 * i + (lane >> 5)) * N + n0 + (lane & 31)];
#pragma unroll
    for (int i = 0; i < 32; ++i) scr[(2 * i + (lane >> 5)) * 33 + (lane & 31)] = tv[i];
    LDS_WAIT(); asm volatile("" ::: "memory");
    const int c = lane & 7;
#pragma unroll
    for (int j = 0; j < 4; ++j) { const int n = (lane >> 3) + 8 * j; const LAS float* s = scr + (8 * c) * 33 + n;
        v4u o; o.x = pk2(s[0 * 33], s[1 * 33]); o.y = pk2(s[2 * 33], s[3 * 33]); o.z = pk2(s[4 * 33], s[5 * 33]); o.w = pk2(s[6 * 33], s[7 * 33]);
        *(GAS v4u*)(WT + (size_t)(row_off + n0 + n) * K + k0 + 8 * c) = o; }
    LDS_WAIT(); asm volatile("" ::: "memory");
}
struct P0Args { const float *x, *w_in, *w_a, *w_b, *w_out, *sg_w, *w_gate, *w_up, *w_down; bf16 *win_t, *wa_t, *wb_t, *wo_t, *sgw, *wgu_t, *wd_t, *xb; };
__device__ __forceinline__ void p0_prologue(const P0Args& a, LAS unsigned char* lds, int gw, int NGW, int wave, int lane) {
    LAS float* scr = (LAS float*)(lds + RING_OFF + wave * 16384);
    constexpr int I_IN = (D / 64) * (INW / 32), I_A = (GW / 64) * (D / 32), I_B = (D / 64) * (D / 32), I_O = I_B;
    constexpr int I_G1 = (D / 64) * (EHID / 32), I_G = NEXP * I_G1, I_D1 = (EHID / 64) * (D / 32), I_DN = NEXP * I_D1;
    constexpr int NITEMS = I_IN + I_A + I_B + I_O + 2 * I_G + I_DN;
    for (int it = gw; it < NITEMS; it += NGW) {
        int r = it;
        if (r < I_IN) { p0_transpose_item(a.w_in, D, INW, a.win_t, 0, scr, r, lane); continue; } r -= I_IN;
        if (r < I_A) { p0_transpose_item(a.w_a, GW, D, a.wa_t, 0, scr, r, lane); continue; } r -= I_A;
        if (r < I_B) { p0_transpose_item(a.w_b, D, D, a.wb_t, 0, scr, r, lane); continue; } r -= I_B;
        if (r < I_O) { p0_transpose_item(a.w_out, D, D, a.wo_t, 0, scr, r, lane); continue; } r -= I_O;
        if (r < 2 * I_G) {
            const int which = r >= I_G; if (which) r -= I_G;
            const int e = r / I_G1, item = r % I_G1, nb = item % (EHID / 32), n0 = nb * 32, ct = n0 >> 7;
            const int row_off = e * 1024 + ct * 128 + which * 128;
            p0_transpose_item((which ? a.w_up : a.w_gate) + (size_t)e * D * EHID, D, EHID, a.wgu_t, row_off, scr, item, lane); continue; }
        r -= 2 * I_G;
        { const int e = r / I_D1, item = r % I_D1; p0_transpose_item(a.w_down + (size_t)e * EHID * D, EHID, D, a.wd_t, e * 1024, scr, item, lane); }
    }
    for (int idx = gw * 64 + lane; idx < 8 * 128 * 128; idx += NGW * 64) { const int s = idx & 127, t = (idx >> 7) & 127; const float w = a.sg_w[idx]; a.sgw[idx] = (bf16)f2bf(((t >> 6) >= (s >> 6)) ? w : 0.f); }
    const size_t n8 = (size_t)T * D / 8;
    for (size_t idx = (size_t)gw * 64 + lane; idx < n8; idx += (size_t)NGW * 64) { const f32x4 v0 = *(const GAS f32x4*)(a.x + idx * 8), v1 = *(const GAS f32x4*)(a.x + idx * 8 + 4);
        v4u o; o.x = pk2(v0.x, v0.y); o.y = pk2(v0.z, v0.w); o.z = pk2(v1.x, v1.y); o.w = pk2(v1.z, v1.w); *(GAS v4u*)(a.xb + idx * 8) = o; }
}

__device__ __forceinline__ void p2_knorm(const bf16* KB, float* kn2, int gw, int NGW, int lane) {
    for (int it = gw; it < BATCH * NHEAD * 2 * 128; it += NGW) {
        const int t = it & 127, c = (it >> 7) & 1, h = (it >> 8) & 7, b = it >> 11;
        const GAS v4u* kp = (const GAS v4u*)(KB + ((size_t)b * SEQ + (size_t)t * 64 + lane) * D + h * 128 + c * 64);
        float s = 0.f;
#pragma unroll
        for (int q = 0; q < 8; ++q) { const v4u w = kp[q];
#pragma unroll
            for (int e = 0; e < 4; ++e) { const float x = __uint_as_float(w[e] << 16), y = __uint_as_float(w[e] & 0xffff0000u); s = fmaf(x, x, s); s = fmaf(y, y, s); } }
#pragma unroll
        for (int o = 1; o < 64; o <<= 1) s = fmaxf(s, __shfl_xor(s, o));
        if (lane == 0) kn2[it] = s;
    }
}

__device__ __forceinline__ void p3_pmx(const float* kn2, float* pmx, int gw, int lane) {
    if (gw < BATCH * NHEAD * 2) {
        float a = kn2[gw * 128 + lane], b2 = kn2[gw * 128 + 64 + lane];
#pragma unroll
        for (int off = 1; off < 64; off <<= 1) { const float ta = __shfl_up(a, off), tb = __shfl_up(b2, off); if (lane >= off) { a = fmaxf(a, ta); b2 = fmaxf(b2, tb); } }
        const float tot = __shfl(a, 63); b2 = fmaxf(b2, tot);
        pmx[gw * 128 + lane] = sqrtf(a) * 1.001f; pmx[gw * 128 + 64 + lane] = sqrtf(b2) * 1.001f;
    }
}

constexpr int P2_PITCH = 136;
__device__ __forceinline__ void p2_gmlp(const bf16* UV, bf16* SG, const bf16* SGW, const float* ln_g, const float* ln_b, const float* sg_b, LAS unsigned char* lds, int G) {
    typedef float f32x2v __attribute__((ext_vector_type(2)));
    LAS bf16* vnT = (LAS bf16*)lds;
    LAS f32x2v* red = (LAS f32x2v*)(lds + 256 * P2_PITCH * 2);
    const int tid = threadIdx.x, lane = tid & 63, wave = __builtin_amdgcn_readfirstlane(tid >> 6), fr = lane & 15, fq = lane >> 4;
    for (int unit = blockIdx.x; unit < 1024; unit += G) {
        const int blk = unit >> 1, half = unit & 1, row0 = blk * 128;
        const int s = tid & 127, cg = __builtin_amdgcn_readfirstlane(tid >> 7);
        const bf16* vrow = UV + (size_t)(row0 + s) * 1024 + 512;
        float s1 = 0.f, s2 = 0.f;
#pragma unroll
        for (int q = 0; q < 16; ++q) { const v4u w = *(const GAS v4u*)(vrow + cg * 128 + q * 8);
#pragma unroll
            for (int e = 0; e < 4; ++e) { const float a = __uint_as_float(w[e] << 16), b = __uint_as_float(w[e] & 0xffff0000u); s1 += a + b; s2 += a * a + b * b; } }
        red[cg * 128 + s] = (f32x2v){s1, s2};
        __syncthreads();
        float t1 = 0.f, t2 = 0.f;
#pragma unroll
        for (int k = 0; k < 4; ++k) { const f32x2v p = red[k * 128 + s]; t1 += p.x; t2 += p.y; }
        const float mean = t1 * (1.f / 512.f), var = fmaxf(t2 * (1.f / 512.f) - mean * mean, 0.f), rstd = 1.0f / sqrtf(var + LN_EPS);
        const int g = half * 4 + cg;
#pragma unroll
        for (int q = 0; q < 8; ++q) { const v4u w = *(const GAS v4u*)(vrow + g * 64 + q * 8);
#pragma unroll
            for (int e = 0; e < 4; ++e) { const int c0 = q * 8 + 2 * e;
                const float a = (__uint_as_float(w[e] << 16) - mean) * rstd * ln_g[g * 64 + c0] + ln_b[g * 64 + c0];
                const float b = (__uint_as_float(w[e] & 0xffff0000u) - mean) * rstd * ln_g[g * 64 + c0 + 1] + ln_b[g * 64 + c0 + 1];
                vnT[(cg * 64 + c0) * P2_PITCH + s] = (bf16)f2bf(a); vnT[(cg * 64 + c0 + 1) * P2_PITCH + s] = (bf16)f2bf(b); } }
        __syncthreads();
        const int gl = wave >> 1, th = wave & 1, gg = half * 4 + gl;
        f32x4 acc[4][4];
#pragma unroll
        for (int a = 0; a < 4; ++a)
#pragma unroll
            for (int b = 0; b < 4; ++b) acc[a][b] = (f32x4){0.f, 0.f, 0.f, 0.f};
        const int nks = th ? 4 : 2;
        for (int ks = 0; ks < nks; ++ks) {
            bf16x8 wf[4], vf[4];
#pragma unroll
            for (int tt = 0; tt < 4; ++tt) wf[tt] = *(const GAS bf16x8*)(SGW + ((size_t)(gg * 128 + th * 64 + tt * 16 + fr) * 128 + ks * 32 + fq * 8));
#pragma unroll
            for (int ct = 0; ct < 4; ++ct) vf[ct] = *(const LAS bf16x8*)(vnT + (gl * 64 + 32 * (ct >> 1) + 8 * (fr >> 2) + 4 * (ct & 1) + (fr & 3)) * P2_PITCH + ks * 32 + fq * 8);
#pragma unroll
            for (int tt = 0; tt < 4; ++tt)
#pragma unroll
                for (int ct = 0; ct < 4; ++ct) acc[tt][ct] = __builtin_amdgcn_mfma_f32_16x16x32_bf16(vf[ct], wf[tt], acc[tt][ct], 0, 0, 0);
        }
#pragma unroll
        for (int tt = 0; tt < 4; ++tt) { const int t = th * 64 + tt * 16 + fr; const float bs = sg_b[gg * 128 + t];
#pragma unroll
            for (int cp = 0; cp < 2; ++cp) { const int c0 = gg * 64 + 32 * cp + 8 * fq;
                const v4u uw = *(const GAS v4u*)(UV + (size_t)(row0 + t) * 1024 + c0);
                const f32x4 a = acc[tt][2 * cp], b = acc[tt][2 * cp + 1];
                v4u o;
                o.x = pk2(__uint_as_float(uw.x << 16) * (a[0] + bs), __uint_as_float(uw.x & 0xffff0000u) * (a[1] + bs));
                o.y = pk2(__uint_as_float(uw.y << 16) * (a[2] + bs), __uint_as_float(uw.y & 0xffff0000u) * (a[3] + bs));
                o.z = pk2(__uint_as_float(uw.z << 16) * (b[0] + bs), __uint_as_float(uw.z & 0xffff0000u) * (b[1] + bs));
                o.w = pk2(__uint_as_float(uw.w << 16) * (b[2] + bs), __uint_as_float(uw.w & 0xffff0000u) * (b[3] + bs));
                *(GAS v4u*)(SG + (size_t)(row0 + t) * 512 + c0) = o; } }
        __syncthreads();
    }
}

typedef float f32x2v __attribute__((ext_vector_type(2)));
constexpr int P7_WPITCH = 52;
__device__ __forceinline__ void p7_ln_route(const float* H, const float* part, float* stats, bf16* H1B, const float* ln_g, const float* ln_b, const float* w_group, const float* b_group, const float* w_expert, const float* b_expert,
                                            int* list_tok, float* list_w, unsigned* cnt, LAS unsigned char* lds, int G, bool dry = false) {
    constexpr int WLB = 256 * P7_WPITCH * 4;
    LAS float* WL0 = (LAS float*)lds;
    LAS float* LG = (LAS float*)(lds + 2 * WLB);
    LAS unsigned* hist = (LAS unsigned*)(lds + 2 * WLB + 8 * 16 * 48 * 4);
    LAS unsigned* ebase = hist + 32;
    LAS float* LNG = (LAS float*)(lds + 2 * WLB + 8 * 16 * 48 * 4 + 256);
    LAS float* LBI = LNG + 2 * D;
    static_assert(2 * WLB + 8 * 16 * 48 * 4 + 256 + 2 * D * 4 + 256 <= RING_BYTES, "P7 LDS map");
    const int tid = threadIdx.x, lane = tid & 63, wave = __builtin_amdgcn_readfirstlane(tid >> 6), li = lane & 15, kq = lane >> 4;
    if (tid < 32) hist[tid] = 0u;
    for (int i = tid; i < 2 * 256 * 3; i += NTHREADS) *(LAS f32x4*)(WL0 + (i / 3) * P7_WPITCH + 36 + 4 * (i % 3)) = (f32x4){0.f, 0.f, 0.f, 0.f};
    for (int i = tid; i < D / 4; i += NTHREADS) { ((LAS f32x4*)LNG)[i] = ((const GAS f32x4*)ln_g)[i]; ((LAS f32x4*)(LNG + D))[i] = ((const GAS f32x4*)ln_b)[i]; }
    if (tid < 4) LBI[tid] = b_group[tid]; else if (tid < 36) LBI[tid] = b_expert[tid - 4];
#define P7_WLOAD(we, wg, ch_) do { _Pragma("unroll") for (int q = 0; q < 4; ++q) we[q] = *((const GAS f32x4*)(w_expert + (size_t)(ch_) * 256 * 32) + tid + q * NTHREADS); \
        wg = (f32x4){0.f, 0.f, 0.f, 0.f}; if (tid < 256) wg = *((const GAS f32x4*)(w_group + (size_t)(ch_) * 256 * 4) + tid); } while (0)
#define P7_WSTORE(we, wg, buf) do { LAS float* W_ = WL0 + (buf) * (WLB / 4); _Pragma("unroll") for (int q = 0; q < 4; ++q) { const int f = (tid + q * NTHREADS) * 4, kl = f >> 5, n = f & 31; *(LAS f32x4*)(W_ + kl * P7_WPITCH + 4 + n) = we[q]; } \
        if (tid < 256) *(LAS f32x4*)(W_ + tid * P7_WPITCH) = wg; } while (0)
#define P7_VLOAD(vv, hrow_, ch_) do { _Pragma("unroll") for (int g = 0; g < 8; ++g) { vv[2 * g] = *(const GAS f32x4*)((hrow_) + (ch_) * 256 + 32 * g); vv[2 * g + 1] = *(const GAS f32x4*)((hrow_) + (ch_) * 256 + 32 * g + 4); } } while (0)
    f32x4 vc[16], we[4], wg;
    const int rd0 = blockIdx.x;
    if (rd0 < T / 128) { P7_WLOAD(we, wg, 0); P7_VLOAD(vc, H + (size_t)(rd0 * 128 + wave * 16 + li) * D + 8 * kq, 0); P7_WSTORE(we, wg, 0); }
    __syncthreads();
    for (int rd = blockIdx.x; rd < T / 128; rd += G) {
        const int R0 = rd * 128 + wave * 16;
        const float* hrow = H + (size_t)(R0 + li) * D + 8 * kq;
        const int rdn = (rd + G < T / 128) ? rd + G : rd;
        const float* hrown = H + (size_t)(rdn * 128 + wave * 16 + li) * D + 8 * kq;
        float s1 = 0.f, s2 = 0.f;
        { const f32x4 pa = *(const GAS f32x4*)(part + (size_t)(R0 + li) * 32 + kq * 8), pb = *(const GAS f32x4*)(part + (size_t)(R0 + li) * 32 + kq * 8 + 4);
          s1 = (pa.x + pa.z) + (pb.x + pb.z); s2 = (pa.y + pa.w) + (pb.y + pb.w); }
        s1 += __shfl_xor(s1, 16); s1 += __shfl_xor(s1, 32); s2 += __shfl_xor(s2, 16); s2 += __shfl_xor(s2, 32);
        const float mean = s1 * (1.f / D), var = fmaxf(s2 * (1.f / D) - mean * mean, 0.f), rstd = 1.0f / sqrtf(var + LN_EPS);
        if (kq == 0) *(GAS f32x2v*)(stats + (size_t)(R0 + li) * 2) = (f32x2v){mean, rstd};
        f32x4 acc[3];
#pragma unroll
        for (int n = 0; n < 3; ++n) acc[n] = (f32x4){0.f, 0.f, 0.f, 0.f};
#pragma unroll 1
        for (int ch = 0; ch < 4; ++ch) {
            f32x4 vn[16];
            P7_WLOAD(we, wg, (ch + 1) & 3); P7_VLOAD(vn, (ch == 3) ? hrown : hrow, (ch + 1) & 3);
            __builtin_amdgcn_sched_barrier(0);
            const LAS float* W = WL0 + (ch & 1) * (WLB / 4);
#pragma unroll
            for (int g = 0; g < 8; ++g) { const int cl = 32 * g + 8 * kq, col = ch * 256 + cl;
                float wv[24];
#pragma unroll
                for (int e8 = 0; e8 < 8; ++e8)
#pragma unroll
                    for (int n = 0; n < 3; ++n) wv[e8 * 3 + n] = W[(cl + e8) * P7_WPITCH + li + 16 * n];
                __builtin_amdgcn_sched_barrier(0);
                float h[8];
#pragma unroll
                for (int q = 0; q < 2; ++q) { const f32x4 v = vc[2 * g + q]; const f32x4 gv = *(const LAS f32x4*)(LNG + col + 4 * q), bv = *(const LAS f32x4*)(LNG + D + col + 4 * q);
                    h[4 * q] = (v.x - mean) * rstd * gv.x + bv.x; h[4 * q + 1] = (v.y - mean) * rstd * gv.y + bv.y; h[4 * q + 2] = (v.z - mean) * rstd * gv.z + bv.z; h[4 * q + 3] = (v.w - mean) * rstd * gv.w + bv.w; }
                v4u o; o.x = pk2(h[0], h[1]); o.y = pk2(h[2], h[3]); o.z = pk2(h[4], h[5]); o.w = pk2(h[6], h[7]); *(GAS v4u*)(H1B + (size_t)(R0 + li) * D + col) = o;
#pragma unroll
                for (int e8 = 0; e8 < 8; ++e8)
#pragma unroll
                    for (int n = 0; n < 3; ++n) acc[n] = __builtin_amdgcn_mfma_f32_16x16x4f32(h[e8], wv[e8 * 3 + n], acc[n], 0, 0, 0); }
            __builtin_amdgcn_sched_barrier(0);
            P7_WSTORE(we, wg, (ch + 1) & 1);
#pragma unroll
            for (int q = 0; q < 16; ++q) vc[q] = vn[q];
            __syncthreads();
        }
        LAS float* lg = LG + wave * 16 * 48;
#pragma unroll
        for (int n = 0; n < 3; ++n)
#pragma unroll
            for (int r = 0; r < 4; ++r) lg[(4 * kq + r) * 48 + 16 * n + li] = acc[n][r];
        LDS_WAIT(); asm volatile("" ::: "memory");
        int e0 = 0, e1 = 0; unsigned r0 = 0u, r1 = 0u; float wt0 = 0.f, wt1 = 0.f;
        if (lane < 16) {
            const LAS float* l = lg + lane * 48;
            float gl[4]; int gs = 0; float gm;
#pragma unroll
            for (int q = 0; q < 4; ++q) gl[q] = l[q] + LBI[q];
            gm = gl[0];
#pragma unroll
            for (int q = 1; q < 4; ++q) if (gl[q] > gm) { gm = gl[q]; gs = q; }
            float den = 0.f;
#pragma unroll
            for (int q = 0; q < 4; ++q) den += __expf(gl[q] - gm);
            const float gwt = 1.0f / den;
            float ev[8];
#pragma unroll
            for (int q = 0; q < 8; ++q) ev[q] = l[4 + gs * 8 + q] + LBI[4 + gs * 8 + q];
            int i0 = 0; float v0 = ev[0];
#pragma unroll
            for (int q = 1; q < 8; ++q) if (ev[q] > v0) { v0 = ev[q]; i0 = q; }
            int i1 = -1; float v1 = -3.0e38f;
#pragma unroll
            for (int q = 0; q < 8; ++q) if (q != i0 && ev[q] > v1) { v1 = ev[q]; i1 = q; }
            const float ex = __expf(v1 - v0), p0 = 1.0f / (1.0f + ex), p1 = ex * p0;
            e0 = gs * 8 + i0; e1 = gs * 8 + i1; wt0 = p0 * gwt; wt1 = p1 * gwt;
            r0 = __hip_atomic_fetch_add(&hist[e0], 1u, __ATOMIC_RELAXED, __HIP_MEMORY_SCOPE_WORKGROUP); r1 = __hip_atomic_fetch_add(&hist[e1], 1u, __ATOMIC_RELAXED, __HIP_MEMORY_SCOPE_WORKGROUP);
        }
        __syncthreads();
        if (tid < 32) { const unsigned n = hist[tid]; hist[tid] = 0u; ebase[tid] = (n && !dry) ? __hip_atomic_fetch_add(cnt + tid, n, RLX_AGENT) : 0u; }
        __syncthreads();
        if (lane < 16 && !dry) { const int tok = R0 + lane;
            const size_t s0 = (size_t)e0 * MOE_CAP + ebase[e0] + r0, s1 = (size_t)e1 * MOE_CAP + ebase[e1] + r1;
            list_tok[s0] = tok * 2; list_w[s0] = wt0; list_tok[s1] = tok * 2 + 1; list_w[s1] = wt1; }
    }
}

#undef P7_WLOAD
#undef P7_WSTORE
#undef P7_VLOAD
__device__ __forceinline__ void p11_final(float* H, const bf16* H1, const bf16* FFN, const float* ln_g, const float* ln_b, int gw, int NGW, int lane) {
    f32x4 G4[4], B4[4];
#pragma unroll
    for (int j = 0; j < 4; ++j) { G4[j] = *((const GAS f32x4*)ln_g + lane + 64 * j); B4[j] = *((const GAS f32x4*)ln_b + lane + 64 * j); }
    v2u nh[4], na[4], nb[4];
    if (gw < T) {
        const GAS v2u* hp = (const GAS v2u*)(H1 + (size_t)gw * D) + lane; const GAS v2u* f0 = (const GAS v2u*)(FFN + (size_t)(2 * gw) * D) + lane; const GAS v2u* f1 = (const GAS v2u*)(FFN + (size_t)(2 * gw + 1) * D) + lane;
#pragma unroll
        for (int j = 0; j < 4; ++j) { nh[j] = hp[64 * j]; na[j] = f0[64 * j]; nb[j] = f1[64 * j]; }
    }
    for (int m = gw; m < T; m += NGW) {
        GAS f32x4* hr = (GAS f32x4*)(H + (size_t)m * D) + lane;
        v2u ch[4], ca[4], cb[4];
#pragma unroll
        for (int j = 0; j < 4; ++j) { ch[j] = nh[j]; ca[j] = na[j]; cb[j] = nb[j]; }
        { const int mn = (m + NGW < T) ? m + NGW : m;
          const GAS v2u* hp = (const GAS v2u*)(H1 + (size_t)mn * D) + lane; const GAS v2u* f0 = (const GAS v2u*)(FFN + (size_t)(2 * mn) * D) + lane; const GAS v2u* f1 = (const GAS v2u*)(FFN + (size_t)(2 * mn + 1) * D) + lane;
#pragma unroll
          for (int j = 0; j < 4; ++j) { nh[j] = hp[64 * j]; na[j] = f0[64 * j]; nb[j] = f1[64 * j]; } }
        f32x4 v[4]; float s = 0.f;
#pragma unroll
        for (int j = 0; j < 4; ++j) { const v2u hb = ch[j]; const v2u a = ca[j], b = cb[j];
            v[j].x = __uint_as_float(hb.x << 16) * ALPHA + (__uint_as_float(a.x << 16) + __uint_as_float(b.x << 16)); v[j].y = __uint_as_float(hb.x & 0xffff0000u) * ALPHA + (__uint_as_float(a.x & 0xffff0000u) + __uint_as_float(b.x & 0xffff0000u));
            v[j].z = __uint_as_float(hb.y << 16) * ALPHA + (__uint_as_float(a.y << 16) + __uint_as_float(b.y << 16)); v[j].w = __uint_as_float(hb.y & 0xffff0000u) * ALPHA + (__uint_as_float(a.y & 0xffff0000u) + __uint_as_float(b.y & 0xffff0000u));
            s += (v[j].x + v[j].y) + (v[j].z + v[j].w); }
        const float mean = wave_sum(s) * (1.f / D); float s2 = 0.f;
#pragma unroll
        for (int j = 0; j < 4; ++j) { v[j] = v[j] - mean; s2 += (v[j].x * v[j].x + v[j].y * v[j].y) + (v[j].z * v[j].z + v[j].w * v[j].w); }
        const float rstd = 1.f / sqrtf(wave_sum(s2) * (1.f / D) + LN_EPS);
#pragma unroll
        for (int j = 0; j < 4; ++j) { const f32x4 g = G4[j], b = B4[j];
            f32x4 o; o.x = v[j].x * rstd * g.x + b.x; o.y = v[j].y * rstd * g.y + b.y; o.z = v[j].z * rstd * g.z + b.z; o.w = v[j].w * rstd * g.w + b.w; hr[64 * j] = o; }
    }
}
#ifndef PROBE_SHORT_UNITS
#define PROBE_SHORT_UNITS 0
#endif

enum { I_X = 0, I_WIN, I_BIN, I_SGLNG, I_SGLNB, I_SGW, I_SGB, I_WA, I_LQ1, I_LK1, I_LQ2, I_LK2, I_SUBLN, I_WB, I_WOUT, I_LN1G, I_LN1B, I_WGRP, I_BGRP, I_WEXP, I_BEXP, I_WGATE, I_WUP, I_WDOWN, I_LN2G, I_LN2B, N_IN };
struct Args { const float* in[N_IN]; float* out; unsigned char* ws; int ph_lo, ph_hi, dummy, li; };
static_assert(sizeof(Args) == (N_IN + 2) * 8 + 16, "no padding bytes in Args");

__device__ __forceinline__ const float* karg_ptr(int k) {
    const __attribute__((address_space(4))) unsigned long long* p = (const __attribute__((address_space(4))) unsigned long long*)__builtin_amdgcn_kernarg_segment_ptr();
    asm volatile("" : "+s"(p));
    return (const float*)p[k];
}
#define KARG(k) karg_ptr(k)
__device__ __forceinline__ int fresh_lane() { int t = threadIdx.x; asm volatile("" : "+v"(t)); return t & 63; }
__global__ void __launch_bounds__(NTHREADS, 2) mk_fwd(Args args) {
    extern __shared__ __attribute__((aligned(16))) unsigned char lds[];
    LAS unsigned char* L = (LAS unsigned char*)lds;
    volatile LAS unsigned* MISC = (volatile LAS unsigned*)(L + MISC_OFF);
    const int tid = threadIdx.x, wave = __builtin_amdgcn_readfirstlane(tid >> 6);
#define lane fresh_lane()
    const int G = gridDim.x; const int bx = blockIdx.x; const int vcu = (G % 8 == 0) ? (bx % 8) * (G / 8) + bx / 8 : bx;
    unsigned char* ws = args.ws;
    gu32* ctl = (gu32*)(ws + WS_CTL);
    for (int u = tid; u < (LDS_BYTES - LDSCTL_OFF) / 4; u += NTHREADS) ((LAS unsigned*)(L + LDSCTL_OFF))[u] = 0u;
    __syncthreads();
    XcdBarrier bar; bar.bar = (unsigned*)(ctl + CW_BAR) + args.li * XCD_BAR_WORDS; bar.x = 0; bar.st = nullptr;
#if MK_ONE_LAUNCH
    bar = xcd_barrier_post((unsigned*)(ctl + CW_BAR) + args.li * XCD_BAR_WORDS, MISC + 8);
#define GRID_BAR() xcd_barrier(bar)
#else
#define GRID_BAR() do {} while (0)
#endif
    const int lo = args.ph_lo, hi = args.ph_hi;
#ifndef MK_PHASE_MASK
#define MK_PHASE_MASK 0xFFF
#endif
#define IN(k) (((MK_PHASE_MASK >> (k)) & 1) && lo <= (k) && (k) < hi)
#define BOTH(k) (IN(k) && IN((k) + 1))
#define CHAIN_SYNC() do { asm volatile("s_waitcnt vmcnt(0)" ::: "memory"); __syncthreads(); \
        if (tid == 0) { __builtin_amdgcn_fence(__ATOMIC_ACQUIRE, "agent"); asm volatile("s_waitcnt vmcnt(0)" ::: "memory"); } __syncthreads(); } while (0)
#define SEAM(k, chained) do { if (BOTH(k)) { if (chained) CHAIN_SYNC(); else GRID_BAR(); } } while (0)
    const bool dummy = args.dummy != 0;
    const int gw = vcu * NWAVES + wave, NGW = G * NWAVES;
    bf16* win_t = (bf16*)(ws + WS_WIN); bf16* wa_t = (bf16*)(ws + WS_WA); bf16* wb_t = (bf16*)(ws + WS_WB); bf16* wo_t = (bf16*)(ws + WS_WO);
    bf16* sgw = (bf16*)(ws + WS_SGW); bf16* wgu_t = (bf16*)(ws + WS_WGU); bf16* wd_t = (bf16*)(ws + WS_WD);
    bf16* XB = (bf16*)(ws + WS_XB); bf16* QB = (bf16*)(ws + WS_Q); bf16* KB = (bf16*)(ws + WS_K); bf16* VB = (bf16*)(ws + WS_VAL); bf16* GA = (bf16*)(ws + WS_GA); bf16* GB = (bf16*)(ws + WS_GB);
    bf16* XS = (bf16*)(ws + WS_XS); bf16* HB = (bf16*)(ws + WS_HB); bf16* FFN = (bf16*)(ws + WS_FFN);
    bf16* UV = (bf16*)((unsigned char*)args.out + OUT_UV); bf16* SG = (bf16*)((unsigned char*)args.out + OUT_SG);
    int* list_tok = (int*)(ws + WS_LIST_TOK); float* list_w = (float*)(ws + WS_LIST_W);
    float* kn2 = (float*)(ws + WS_KN2); float* pmx = (float*)(ws + WS_PMX);

    if (IN(0)) {
        P0Args a{KARG(I_X), KARG(I_WIN), KARG(I_WA), KARG(I_WB), KARG(I_WOUT), KARG(I_SGW), KARG(I_WGATE), KARG(I_WUP), KARG(I_WDOWN), win_t, wa_t, wb_t, wo_t, sgw, wgu_t, wd_t, XB};
        p0_prologue(a, L, gw, NGW, wave, lane);
        if (BOTH(0)) GRID_BAR();
    }
    if (IN(1)) {
        pg8::Gemm g{XB, win_t, T, INW, D}; pg8::StaticOrder S; S.init(T, INW, G, bx);
        LAS float* lbias = (LAS float*)(L + RING_OFF + MOE_LDS_OFF);
        { const float* bin = KARG(I_BIN); for (int i = tid; i < INW / 4; i += NTHREADS) ((LAS f32x4*)lbias)[i] = ((const f32x4*)bin)[i]; }
        __syncthreads();
        pg8::EpiInProj E{UV, QB, (size_t)(WS_K - WS_Q) / 2, lbias, C2};
        pg8::gemm_phase<pg8::EpiInProj, pg8::StaticOrder, true, true>(L + RING_OFF, g, S, E);
        if (BOTH(1)) GRID_BAR();
    }
    if (IN(2)) {
        p2_knorm(KB, kn2, gw, NGW, lane);
        p2_gmlp(UV, SG, sgw, KARG(I_SGLNG), KARG(I_SGLNB), KARG(I_SGB), L, G);
        if (BOTH(2)) GRID_BAR();
    }
    if (IN(3)) {
        pg8::Gemm g{SG, wa_t, T, D, GW}; pg8::StaticOrder S; S.init(T, D, G, bx);
        pg8::EpiGateMix<0> E{GA, nullptr, dummy ? XB : GA};
        pg8::gemm_phase<pg8::EpiGateMix<0>, pg8::StaticOrder, true, true>(L + RING_OFF, g, S, E);
    }
    if (IN(4)) {
        float lam;
        { const float a = KARG(I_LQ1)[lane] * KARG(I_LK1)[lane], b = KARG(I_LQ2)[lane] * KARG(I_LK2)[lane];
          lam = __expf(wave_sum(a)) - __expf(wave_sum(b)) + 0.2f; lam = __uint_as_float(__builtin_amdgcn_readfirstlane(__float_as_uint(lam))); }
        unsigned* aq = (unsigned*)(ctl + CW_AQ) + args.li * 512;
        int q = (int)(((long)vcu * 8) / G) & 7, tries = 0;
        if (tid == 0) *(LAS unsigned*)(L + RING_OFF + att::LDS_NXT) = __hip_atomic_fetch_add(aq + 64 * q, 1u, RLX_AGENT);
        __syncthreads();
        int item = (int)__builtin_amdgcn_readfirstlane(*(LAS unsigned*)(L + RING_OFF + att::LDS_NXT));
        __syncthreads();
        for (;;) {
            while (item >= 512 && tries < 7) { ++tries; q = (q + 1) & 7;
                if (tid == 0) *(LAS unsigned*)(L + RING_OFF + att::LDS_NXT) = __hip_atomic_fetch_add(aq + 64 * q, 1u, RLX_AGENT);
                __syncthreads();
                item = (int)__builtin_amdgcn_readfirstlane(*(LAS unsigned*)(L + RING_OFF + att::LDS_NXT));
                __syncthreads(); }
            if (item >= 512) break;
            const int rnd = item >> 6, i = 63 - (item & 63), h = 7 - rnd, b = (q + rnd) & 7;
#define UNI_F(x) __uint_as_float(__builtin_amdgcn_readfirstlane(__float_as_uint(x)))
            const float slope2 = UNI_F(exp2f(-(float)(h + 1)) * 1.4426950408889634f);
            float u[16];
#pragma unroll
            for (int r = 0; r < 16; ++r) u[r] = __uint_as_float(__builtin_amdgcn_readfirstlane(__float_as_uint(exp2f(slope2 * (float)((r & 3) + 8 * (r >> 2))))));
            const float w4 = UNI_F(exp2f(slope2 * 4.0f)), w32 = UNI_F(exp2f(slope2 * 32.0f));
            const bf16* Kh = KB + (size_t)b * SEQ * D + h * 128; const bf16* Vh = VB + (size_t)b * SEQ * D + h * 128;
            bf16* Qb = QB + ((size_t)b * SEQ + (size_t)i * 128) * D + h * 128;
            bf16* Ob = dummy ? XB + ((size_t)b * SEQ + (size_t)i * 128) * D + h * 128 : Qb;
            item = att::attn_unit(Qb, Kh, Vh, Ob, PROBE_SHORT_UNITS && dummy ? 0 : i, slope2, u, w4, w32, lam, KARG(I_SUBLN), kn2 + (size_t)(b * 8 + h) * 256, aq + 64 * q, (char*)lds + RING_OFF, PROBE_SHORT_UNITS && dummy ? PROBE_SHORT_UNITS : 0);
        }
        if (BOTH(4)) GRID_BAR();
    }
    if (IN(5)) {
        pg8::Gemm g{QB, wb_t, T, D, D}; pg8::StaticOrder S; S.init(T, D, G, bx);
        pg8::EpiGateMix<1> E{GA, GB, dummy ? XB : GA};
        pg8::gemm_phase<pg8::EpiGateMix<1>, pg8::StaticOrder, true, true>(L + RING_OFF, g, S, E);
        SEAM(5, false);
    }
    if (IN(6)) {
        pg8::Gemm g{GA, wo_t, T, D, D}; pg8::StaticOrder S; S.init(T, D, G, bx);
        pg8::EpiResid E{KARG(I_X), args.out, ALPHA, (pg8::f32x2*)(ws + WS_PART)};
        pg8::gemm_phase<pg8::EpiResid, pg8::StaticOrder, true, true>(L + RING_OFF, g, S, E);
        SEAM(6, false);
    }
    if (IN(7)) {
        p7_ln_route(args.out, (const float*)(ws + WS_PART), (float*)(ws + WS_STATS), XB, KARG(I_LN1G), KARG(I_LN1B), KARG(I_WGRP), KARG(I_BGRP), KARG(I_WEXP), KARG(I_BEXP), list_tok, list_w, (unsigned*)(ctl + CW_CNT), L, G, dummy);
        if (BOTH(7)) GRID_BAR();
    }
    if (IN(9)) {
        LAS int* ml = (LAS int*)(L + RING_OFF + MOE_LDS_OFF);
        const int ntiles = pg8::MoeOrder<true>::prime((const unsigned*)(ctl + CW_CNT), list_tok, list_w, MOE_CAP, bx, ml + pg8::MOE_LDS_TE / 4, ml + pg8::MOE_LDS_TR / 4, ml + pg8::MOE_LDS_TB / 4, ml + pg8::MOE_LDS_SL / 4, (LAS int*)(MISC + 12), tid);
        pg8::Gemm g{XB, wgu_t, 0, 0, D}; pg8::MoeOrder<true> S{list_tok, list_w, ntiles, G, bx, ml + pg8::MOE_LDS_TE / 4, ml + pg8::MOE_LDS_TR / 4, ml + pg8::MOE_LDS_TB / 4, ml + pg8::MOE_LDS_SL / 4};
        pg8::EpiGateUp E{HB};
        pg8::gemm_phase<pg8::EpiGateUp, pg8::MoeOrder<true>, true, true>(L + RING_OFF, g, S, E);
        if (BOTH(9)) GRID_BAR();
    }
    if (IN(10)) {
        LAS int* ml = (LAS int*)(L + RING_OFF + MOE_LDS_OFF);
        const int ntiles = pg8::MoeOrder<false>::prime((const unsigned*)(ctl + CW_CNT), list_tok, list_w, MOE_CAP, bx, ml + pg8::MOE_LDS_TE / 4, ml + pg8::MOE_LDS_TR / 4, ml + pg8::MOE_LDS_TB / 4, ml + pg8::MOE_LDS_SL / 4, (LAS int*)(MISC + 12), tid);
        pg8::Gemm g{HB, wd_t, 0, 0, EHID}; pg8::MoeOrder<false> S{list_tok, list_w, ntiles, G, bx, ml + pg8::MOE_LDS_TE / 4, ml + pg8::MOE_LDS_TR / 4, ml + pg8::MOE_LDS_TB / 4, ml + pg8::MOE_LDS_SL / 4};
        pg8::EpiDown E{FFN, ml + pg8::MOE_LDS_TR / 4, ml + pg8::MOE_LDS_SL / 4};
        pg8::gemm_phase<pg8::EpiDown, pg8::MoeOrder<false>, true, true>(L + RING_OFF, g, S, E);
        if (BOTH(10)) GRID_BAR();
    }
    if (IN(11)) {
        p11_final(args.out, XB, FFN, KARG(I_LN2G), KARG(I_LN2B), gw, NGW, lane);
    }
#undef IN
#undef BOTH
#undef lane
}

extern "C" void kernel_launch(void* const* d_in, const int* in_sizes, int n_in, void* d_out, int out_size, void* d_ws, size_t ws_size, hipStream_t stream) {
    static int grid = 0;
    if (grid == 0) {
        if (n_in != N_IN || in_sizes[0] != T * D || out_size != T * D || ws_size < WS_END) {
            fprintf(stderr, "kernel_launch: shape mismatch: n_in %d in0 %d out %d ws %zu (need %zu)\n", n_in, n_in > 0 ? in_sizes[0] : -1, out_size, ws_size, (size_t)WS_END); grid = -1; return; }
        int dev = 0, cus = 0, per_cu = 0;
        if (hipGetDevice(&dev) != hipSuccess || hipDeviceGetAttribute(&cus, hipDeviceAttributeMultiprocessorCount, dev) != hipSuccess) { grid = -1; return; }
        if (hipFuncSetAttribute((const void*)mk_fwd, hipFuncAttributeMaxDynamicSharedMemorySize, LDS_BYTES) != hipSuccess) { fprintf(stderr, "kernel_launch: hipFuncSetAttribute failed\n"); grid = -1; return; }
        if (hipOccupancyMaxActiveBlocksPerMultiprocessor(&per_cu, (const void*)mk_fwd, NTHREADS, LDS_BYTES) != hipSuccess || per_cu < 1)
            fprintf(stderr, "kernel_launch: note: occupancy query reports %d workgroups per CU\n", per_cu);
        (void)hipGetLastError();
        grid = cus;
    }
    if (grid < 0) return;
    if (hipMemsetAsync((char*)d_ws + WS_CTL, 0, CTL_ZERO_BYTES, stream) != hipSuccess) { fprintf(stderr, "kernel_launch: memset failed\n"); return; }
    Args a{};
    for (int i = 0; i < N_IN; ++i) a.in[i] = (const float*)d_in[i];
    a.out = (float*)d_out; a.ws = (unsigned char*)d_ws;
#if MK_ONE_LAUNCH && MK_PROBE_PHASE >= 0
    a.ph_lo = 0; a.ph_hi = MK_PROBE_PHASE; a.li = 0; if (MK_PROBE_PHASE > 0) hipLaunchKernelGGL(mk_fwd, dim3(grid), dim3(NTHREADS), LDS_BYTES, stream, a);
    a.ph_lo = MK_PROBE_PHASE; a.ph_hi = MK_PROBE_PHASE + 1; a.li = 1; a.dummy = 1; hipLaunchKernelGGL(mk_fwd, dim3(grid), dim3(NTHREADS), LDS_BYTES, stream, a);
    a.ph_lo = MK_PROBE_PHASE; a.ph_hi = NPHASE; a.li = 2; a.dummy = 0; hipLaunchKernelGGL(mk_fwd, dim3(grid), dim3(NTHREADS), LDS_BYTES, stream, a);
#elif MK_ONE_LAUNCH
    a.ph_lo = 0; a.ph_hi = NPHASE;
    hipLaunchKernelGGL(mk_fwd, dim3(grid), dim3(NTHREADS), LDS_BYTES, stream, a);
#else
    for (int p = 0; p < NPHASE; ++p) { a.ph_lo = p; a.ph_hi = p + 1; hipLaunchKernelGGL(mk_fwd, dim3(grid), dim3(NTHREADS), LDS_BYTES, stream, a); }
#endif
    const hipError_t le = hipPeekAtLastError();
    if (le != hipSuccess) fprintf(stderr, "kernel_launch: launch failed: %s\n", hipGetErrorName(le));
}
```

```cpp
#include <hip/hip_runtime.h>
#include <cstdio>
#include <cstdint>
namespace pg8 {
#define PG8_LAS __attribute__((address_space(3)))
typedef unsigned short bf16_t;
typedef short bf16x8 __attribute__((ext_vector_type(8)));
typedef float f32x4 __attribute__((ext_vector_type(4)));
typedef unsigned u32x4 __attribute__((ext_vector_type(4)));
constexpr int BM = 256, BK = 64, HALF = 128, HTB = HALF * BK * 2  , STAGE_BYTES = 8 * HTB, NXCD = 8, WGM = 8;

__host__ __device__ __forceinline__ int lds_byte(int r, int c) { const int st = (r >> 4) * 2 + (c >> 5), rr = r & 15, cc = c & 31, ob = rr * 64 + cc * 2; return st * 1024 + (ob ^ (((ob >> 9) & 1) << 5)); }
__host__ __device__ __forceinline__ void stage_rc(int b, int& R, int& C) { const int st = b / 1024, sb = b % 1024, swz = sb ^ (((sb >> 9) & 1) << 5); R = (st >> 1) * 16 + swz / 64; C = (st & 1) * 32 + (swz % 64) / 2; }
__host__ __device__ __forceinline__ int perm32(int rho) { const int n = rho >> 4, i = rho & 15; return 8 * (i >> 2) + 4 * n + (i & 3); }

struct Unit { int pm, pn, sl; };
struct Gemm { const bf16_t* A; const bf16_t* Bt; int M, N, K; };

struct StaticOrder {
    int nM, nN, nwg, G, c;
    __host__ __device__ void init(int M, int N, int G_, int c_) { nM = M / BM; nN = N / BM; nwg = nM * nN; G = G_; c = c_; }
    __host__ __device__ bool next(int i, Unit& u) const {
        const long L = (long)i * G + c; if (L >= nwg) return false;
        int wgid = (int)L; { const int q = nwg / NXCD, r = nwg % NXCD, xcd = wgid % NXCD, off = wgid / NXCD; wgid = (xcd < r ? xcd * (q + 1) : r * (q + 1) + (xcd - r) * q) + off; }
        const int nig = WGM * nN, gid = wgid / nig, fm = gid * WGM, gsz = (nM - fm) < WGM ? (nM - fm) : WGM;
        u.pm = fm + ((wgid % nig) % gsz); u.pn = (wgid % nig) / gsz; return true;
    }
    __device__ __forceinline__ void a_ready(const Unit&) const {}
    __device__ __forceinline__ void done(const Unit&) const {}
    __device__ __forceinline__ void stage(const Unit&, int, int) const {}
    static constexpr bool GATHER = false;
    __device__ __forceinline__ unsigned arow(const Unit&, int) const { return 0u; }
};

struct RowOwnerOrder {
    int nM, nN, G, c;
    __host__ __device__ void init(int M, int N, int G_, int c_) { nM = M / BM; nN = N / BM; G = G_; c = c_; }
    __host__ __device__ bool next(int i, Unit& u) const { const int pm = c + (i / nN) * G; if (pm >= nM) return false; u.pm = pm; u.pn = i % nN; return true; }
    __device__ __forceinline__ void a_ready(const Unit&) const {}
    __device__ __forceinline__ void done(const Unit&) const {}
    __device__ __forceinline__ void stage(const Unit&, int, int) const {}
    static constexpr bool GATHER = false;
    __device__ __forceinline__ unsigned arow(const Unit&, int) const { return 0u; }
};
__device__ __forceinline__ unsigned cvt_pk_bf16(float lo, float hi) { unsigned r; asm volatile("v_cvt_pk_bf16_f32 %0, %1, %2" : "=v"(r) : "v"(lo), "v"(hi)); return r; }
typedef float f32x2 __attribute__((ext_vector_type(2)));
__device__ __forceinline__ f32x2 gelu_pk(f32x2 v) {
    const f32x2 av = __builtin_elementwise_abs(v), d = av * 0.2316418882f + 1.0f;
    f32x2 t; t.x = __builtin_amdgcn_rcpf(d.x); t.y = __builtin_amdgcn_rcpf(d.y);
    f32x2 q = t * 0.5307027145f + (-0.7265760135f); q = q * t + 0.7107068705f; q = q * t + (-0.142248368f); q = q * t + 0.127414796f; q = q * t;
    const f32x2 s = (v * v) * (-0.72134752044f);
    f32x2 e; e.x = __builtin_amdgcn_exp2f(s.x); e.y = __builtin_amdgcn_exp2f(s.y);
    const f32x2 m = v * (q * e), r = v - m;
    f32x2 o; o.x = v.x < 0.f ? m.x : r.x; o.y = v.y < 0.f ? m.y : r.y; return o;
}
typedef unsigned u32x2 __attribute__((ext_vector_type(2)));
__device__ __forceinline__ float bf_lo(unsigned w) { return __uint_as_float(w << 16); }
__device__ __forceinline__ float bf_hi(unsigned w) { return __uint_as_float(w & 0xffff0000u); }
__device__ __forceinline__ float sigmoid_f(float x) { return __builtin_amdgcn_rcpf(1.0f + __builtin_amdgcn_exp2f(-1.4426950408889634f * x)); }

struct EpiInProj {
    static constexpr bool PERM = true, AFTER_DRAIN = false; static constexpr int VMEM_MIN = 16;
    bf16_t* uv; bf16_t* g1; size_t gstride; const PG8_LAS float* bias; float qscale;
    __device__ __forceinline__ void operator()(const f32x4 (&acc)[2][2][4][2], const Unit& u, int wr, int wc, int fr, int fq) const {
        asm volatile("" : "+v"(fr), "+v"(fq));
        const int t = u.pn >> 2;
        bf16_t* base = (t == 0) ? uv : g1 + (size_t)(t - 1) * gstride;
        const int row0 = u.pm * BM + wr * 64 + fr;
        const int col0 = (u.pn & 3) * BM + wc * 32 + 8 * fq, bcol0 = u.pn * BM + wc * 32 + 8 * fq;
        const float sc = (t == 1) ? qscale : 1.0f;
#pragma unroll
        for (int bj = 0; bj < 2; ++bj) {
            const f32x4 bv0 = *(const PG8_LAS f32x4*)(bias + bcol0 + bj * HALF), bv1 = *(const PG8_LAS f32x4*)(bias + bcol0 + bj * HALF + 4);
#pragma unroll
        for (int ai = 0; ai < 2; ++ai)
#pragma unroll
            for (int m = 0; m < 4; ++m) { bf16_t* rowp = base + (size_t)(row0 + ai * HALF + m * 16) * 1024 + col0;
                { f32x4 v0 = acc[ai][bj][m][0] + bv0, v1 = acc[ai][bj][m][1] + bv1;
                    if (t == 0) { const f32x2 a = gelu_pk((f32x2){v0[0], v0[1]}), b = gelu_pk((f32x2){v0[2], v0[3]}); v0 = (f32x4){a.x, a.y, b.x, b.y}; __builtin_amdgcn_sched_barrier(0);
                        const f32x2 c = gelu_pk((f32x2){v1[0], v1[1]}), d = gelu_pk((f32x2){v1[2], v1[3]}); v1 = (f32x4){c.x, c.y, d.x, d.y}; }
                    else if (t >= 4) {
#pragma unroll
                        for (int e = 0; e < 4; ++e) { v0[e] = sigmoid_f(v0[e]); v1[e] = sigmoid_f(v1[e]); } }
                    else if (t == 3) {
                        const int h = (u.pn & 3) * 2 + bj; const float w = __builtin_amdgcn_exp2f(__builtin_amdgcn_exp2f(-(float)(h + 1)) * 1.4426950408889634f * (float)(16 * m + fr));
                        v0 = v0 * w; v1 = v1 * w; }
                    else { v0 = v0 * sc; v1 = v1 * sc; }
                    u32x4 w; w.x = cvt_pk_bf16(v0[0], v0[1]); w.y = cvt_pk_bf16(v0[2], v0[3]); w.z = cvt_pk_bf16(v1[0], v1[1]); w.w = cvt_pk_bf16(v1[2], v1[3]);
                    *(u32x4*)(rowp + bj * HALF) = w; } }
        }
    }
};

template <int MODE  > struct EpiGateMix {
    static constexpr bool PERM = true, AFTER_DRAIN = false; static constexpr int VMEM_MIN = MODE ? 40 : 24;
    const bf16_t* io; const bf16_t* g2; bf16_t* outp;
    __device__ __forceinline__ void operator()(const f32x4 (&acc)[2][2][4][2], const Unit& u, int wr, int wc, int fr, int fq) const {
        asm volatile("" : "+v"(fr), "+v"(fq));
        const int row0 = u.pm * BM + wr * 64 + fr, col0 = u.pn * BM + wc * 32 + 8 * fq;
#pragma unroll
        for (int ai = 0; ai < 2; ++ai) {
            u32x4 xi[4][2], xg[4][2];
#pragma unroll
            for (int m = 0; m < 4; ++m)
#pragma unroll
                for (int bj = 0; bj < 2; ++bj) { const size_t off = (size_t)(row0 + ai * HALF + m * 16) * 1024 + col0 + bj * HALF;
                    xi[m][bj] = *(const u32x4*)(io + off); if (MODE == 1) xg[m][bj] = *(const u32x4*)(g2 + off); }
            __builtin_amdgcn_sched_barrier(0);
#pragma unroll
            for (int m = 0; m < 4; ++m)
#pragma unroll
                for (int bj = 0; bj < 2; ++bj) { const size_t off = (size_t)(row0 + ai * HALF + m * 16) * 1024 + col0 + bj * HALF;
                    const f32x4 a0 = acc[ai][bj][m][0], a1 = acc[ai][bj][m][1]; const u32x4 x = xi[m][bj];
                    float r[8];
                    if (MODE == 0) {
                        r[0] = bf_lo(x.x) * a0[0]; r[1] = bf_hi(x.x) * a0[1]; r[2] = bf_lo(x.y) * a0[2]; r[3] = bf_hi(x.y) * a0[3];
                        r[4] = bf_lo(x.z) * a1[0]; r[5] = bf_hi(x.z) * a1[1]; r[6] = bf_lo(x.w) * a1[2]; r[7] = bf_hi(x.w) * a1[3];
                    } else {
                        const u32x4 g = xg[m][bj];
                        r[0] = bf_lo(x.x) + bf_lo(g.x) * a0[0]; r[1] = bf_hi(x.x) + bf_hi(g.x) * a0[1]; r[2] = bf_lo(x.y) + bf_lo(g.y) * a0[2]; r[3] = bf_hi(x.y) + bf_hi(g.y) * a0[3];
                        r[4] = bf_lo(x.z) + bf_lo(g.z) * a1[0]; r[5] = bf_hi(x.z) + bf_hi(g.z) * a1[1]; r[6] = bf_lo(x.w) + bf_lo(g.w) * a1[2]; r[7] = bf_hi(x.w) + bf_hi(g.w) * a1[3];
                    }
                    u32x4 w; w.x = cvt_pk_bf16(r[0], r[1]); w.y = cvt_pk_bf16(r[2], r[3]); w.z = cvt_pk_bf16(r[4], r[5]); w.w = cvt_pk_bf16(r[6], r[7]);
                    *(u32x4*)(outp + off) = w; }
            __builtin_amdgcn_sched_barrier(0);
        }
    }
};

struct EpiResid {
    static constexpr bool PERM = false, AFTER_DRAIN = false; static constexpr int VMEM_MIN = 32;
    const float* x; float* out; float alpha; f32x2* part;
    __device__ __forceinline__ void operator()(const f32x4 (&acc)[2][2][4][2], const Unit& u, int wr, int wc, int fr, int fq) const {
        asm volatile("" : "+v"(fr), "+v"(fq));
        const int row0 = u.pm * BM + wr * 64 + fr, col0 = u.pn * BM + wc * 32 + 4 * fq;
#define ER_LOAD(xv, blk) do { _Pragma("unroll") for (int mm = 0; mm < 2; ++mm) _Pragma("unroll") for (int bj = 0; bj < 2; ++bj) _Pragma("unroll") for (int n = 0; n < 2; ++n) \
            xv[mm][bj][n] = *(const f32x4*)(x + (size_t)(row0 + ((blk) >> 1) * HALF + (2 * ((blk) & 1) + mm) * 16) * 1024 + col0 + bj * HALF + n * 16); } while (0)
#define ER_DO(xv, blk) do { constexpr int ai = (blk) >> 1, mp = (blk) & 1; _Pragma("unroll") for (int mm = 0; mm < 2; ++mm) { const int m = 2 * mp + mm; const int row = row0 + ai * HALF + m * 16; const size_t off = (size_t)row * 1024 + col0; float s1 = 0.f, s2 = 0.f; \
            _Pragma("unroll") for (int bj = 0; bj < 2; ++bj) _Pragma("unroll") for (int n = 0; n < 2; ++n) { const f32x4 r = xv[mm][bj][n] * alpha + acc[ai][bj][m][n]; \
                *(f32x4*)(out + off + bj * HALF + n * 16) = r; s1 += (r[0] + r[1]) + (r[2] + r[3]); s2 += (r[0] * r[0] + r[1] * r[1]) + (r[2] * r[2] + r[3] * r[3]); } \
            s1 += __shfl_xor(s1, 16); s1 += __shfl_xor(s1, 32); s2 += __shfl_xor(s2, 16); s2 += __shfl_xor(s2, 32); \
            if (fq == 0) part[(size_t)row * 16 + (u.pn & 3) * 4 + wc] = (f32x2){s1, s2}; } } while (0)
        f32x4 xa[2][2][2], xb[2][2][2];
        ER_LOAD(xa, 0); ER_LOAD(xb, 1); __builtin_amdgcn_sched_barrier(0);
        ER_DO(xa, 0); __builtin_amdgcn_sched_barrier(0); ER_LOAD(xa, 2); __builtin_amdgcn_sched_barrier(0);
        ER_DO(xb, 1); __builtin_amdgcn_sched_barrier(0); ER_LOAD(xb, 3); __builtin_amdgcn_sched_barrier(0);
        ER_DO(xa, 2); __builtin_amdgcn_sched_barrier(0);
        ER_DO(xb, 3);
#undef ER_LOAD
#undef ER_DO
    }
};

struct EpiGateUp {
    static constexpr bool PERM = true, AFTER_DRAIN = false; static constexpr int VMEM_MIN = 8;
    bf16_t* hb;
    __device__ __forceinline__ void operator()(const f32x4 (&acc)[2][2][4][2], const Unit& u, int wr, int wc, int fr, int fq) const {
        asm volatile("" : "+v"(fr), "+v"(fq));
        const int row0 = u.pm * BM + wr * 64 + fr, col0 = (u.pn & 3) * HALF + wc * 32 + 8 * fq;
#pragma unroll
        for (int ai = 0; ai < 2; ++ai)
#pragma unroll
            for (int m = 0; m < 4; ++m) { bf16_t* p = hb + (size_t)(row0 + ai * HALF + m * 16) * 512 + col0;
                float r[8];
#pragma unroll
                for (int n = 0; n < 2; ++n)
#pragma unroll
                    for (int e = 0; e < 4; ++e) { const float g = acc[ai][0][m][n][e], up = acc[ai][1][m][n][e]; r[n * 4 + e] = g * sigmoid_f(g) * up; }
                u32x4 w; w.x = cvt_pk_bf16(r[0], r[1]); w.y = cvt_pk_bf16(r[2], r[3]); w.z = cvt_pk_bf16(r[4], r[5]); w.w = cvt_pk_bf16(r[6], r[7]);
                *(u32x4*)p = w; }
    }
};

constexpr int MOE_LDS_TE = 0, MOE_LDS_TR = 2304, MOE_LDS_TB = 4608, MOE_LDS_SL = 6912, MOE_LDS_BYTES = 6912 + 3 * 2048;
struct EpiDown {
    static constexpr bool PERM = true, AFTER_DRAIN = false; static constexpr int VMEM_MIN = 0;
    bf16_t* ffn; const PG8_LAS int* ltr; const PG8_LAS int* lsl;
    __device__ __forceinline__ void operator()(const f32x4 (&acc)[2][2][4][2], const Unit& u, int wr, int wc, int fr, int fq) const {
        asm volatile("" : "+v"(fr), "+v"(fq));
        const int nvalid = ltr[u.pm];
        const int col0 = (u.pn & 3) * BM + wc * 32 + 8 * fq;
        const PG8_LAS int* sl = lsl + u.sl * 512;
        int aa[2][4]; float ww[2][4];
#pragma unroll
        for (int ai = 0; ai < 2; ++ai)
#pragma unroll
            for (int m = 0; m < 4; ++m) { const int rl = ai * HALF + wr * 64 + m * 16 + fr; aa[ai][m] = sl[rl]; ww[ai][m] = __int_as_float(sl[256 + rl]); }
#pragma unroll
        for (int ai = 0; ai < 2; ++ai)
#pragma unroll
            for (int m = 0; m < 4; ++m) { const int rl = ai * HALF + wr * 64 + m * 16 + fr;
                if (rl < nvalid) { const float wt = ww[ai][m];
                    bf16_t* p = ffn + (size_t)aa[ai][m] * 1024 + col0;
#pragma unroll
                    for (int bj = 0; bj < 2; ++bj) { const f32x4 v0 = acc[ai][bj][m][0] * wt, v1 = acc[ai][bj][m][1] * wt;
                        u32x4 w; w.x = cvt_pk_bf16(v0[0], v0[1]); w.y = cvt_pk_bf16(v0[2], v0[3]); w.z = cvt_pk_bf16(v1[0], v1[1]); w.w = cvt_pk_bf16(v1[2], v1[3]);
                        *(u32x4*)(p + bj * HALF) = w; } } }
    }
};

template <bool GATHER_> struct MoeOrder {
    static constexpr bool GATHER = GATHER_;
    const int* list_tok; const float* list_w; int ntiles, G, c;
    PG8_LAS int* lte; PG8_LAS int* ltr; PG8_LAS int* ltb; PG8_LAS int* lsl;
    static __device__ __forceinline__ int prime(const unsigned* cnt, const int* list_tok_, const float* list_w_, int cap, int c_, PG8_LAS int* lte_, PG8_LAS int* ltr_, PG8_LAS int* ltb_, PG8_LAS int* lsl_, PG8_LAS int* lnt, int tid) {
        if (tid < 64) { const int ln = tid;
            const int cn = (ln < 32) ? (int)__hip_atomic_load(cnt + (ln & 31), __ATOMIC_RELAXED, __HIP_MEMORY_SCOPE_AGENT) : 0; const int nt = (cn + 255) >> 8;
            int incl = nt;
#pragma unroll
            for (int off = 1; off < 32; off <<= 1) { const int t = __shfl_up(incl, off); if (ln >= off) incl += t; }
            const int excl = incl - nt;
            if (ln < 32) for (int t = 0; t < nt; ++t) { lte_[excl + t] = ln; const int rem = cn - t * 256; ltr_[excl + t] = rem < 256 ? rem : 256; ltb_[excl + t] = ln * cap + t * 256; }
            if (ln == 31) *lnt = incl; }
        __syncthreads();
        const int ntl = *lnt;
        if (c_ < ntl * 4 && tid < 256) { const int base = ltb_[c_ >> 2]; lsl_[tid] = list_tok_[base + tid]; lsl_[256 + tid] = __float_as_int(list_w_[base + tid]); }
        __syncthreads();
        return ntl;
    }
    __device__ bool next(int i, Unit& u) const {
        const long L = (long)i * G + c; if (L >= (long)ntiles * 4) return false;
        const int rt = (int)(L >> 2), ct = (int)(L & 3);
        u.pm = rt; u.pn = __builtin_amdgcn_readfirstlane(lte[rt]) * 4 + ct; u.sl = i % 3; return true;
    }
    __device__ __forceinline__ void stage(const Unit& n, int wid, int lane) const {
        if (wid == 0) { const int base = __builtin_amdgcn_readfirstlane(ltb[n.pm]);
            __builtin_amdgcn_global_load_lds((const unsigned*)(list_tok + base + lane * 4), (PG8_LAS unsigned*)(lsl + n.sl * 512), 16, 0, 0);
            if (!GATHER) __builtin_amdgcn_global_load_lds((const unsigned*)(list_w + base + lane * 4), (PG8_LAS unsigned*)(lsl + n.sl * 512 + 256), 16, 0, 0);
        }
    }
    __device__ __forceinline__ unsigned arow(const Unit& u, int rl) const { return rl < ltr[u.pm] ? (unsigned)(lsl[u.sl * 512 + rl] >> 1) : 0u; }
    __device__ __forceinline__ void a_ready(const Unit&) const {}
    __device__ __forceinline__ void done(const Unit&) const {}
};

template <class Epi, class Sched, bool ALIGN_EPI = false, bool SP2 = false>
__device__ __forceinline__ void gemm_phase(PG8_LAS unsigned char* lds, const Gemm g, const Sched& S, const Epi& E) {
    int tid = threadIdx.x; asm volatile("" : "+v"(tid));
    const int wid = __builtin_amdgcn_readfirstlane(tid >> 6), lane = tid & 63, wr = wid >> 2, wc = wid & 3, fr = lane & 15, fq = lane >> 4;
    const int K = g.K, nt = K / BK;
    unsigned voffA[2], voffB[2]; int gR[2], gC[2];
    static_assert(!Sched::GATHER || SP2, "gathered A rows: SP2 loop only");
    unsigned gvo[2][2] = {{0u, 0u}, {0u, 0u}}, ngvo[2][2] = {{0u, 0u}, {0u, 0u}}, pvo[2][2] = {{0u, 0u}, {0u, 0u}};
#pragma unroll
    for (int i = 0; i < 2; ++i) { int R, C; stage_rc(tid * 16 + i * 8192, R, C); const int Rb = Epi::PERM ? ((R & ~31) + perm32(R & 31)) : R;
        voffA[i] = (unsigned)(R * K + C) * 2u; voffB[i] = (unsigned)(Rb * K + C) * 2u; gR[i] = R; gC[i] = C; }
    const size_t kstep = (size_t)(BK * 2);
    const size_t hstep = (size_t)HALF * K * 2;
    const size_t tstep = 2 * hstep;
    const unsigned ldsw = (unsigned)wid * 1024u;
    const int aoff = lds_byte(wr * 64 + fr, fq * 8), boff = lds_byte(wc * 32 + fr, fq * 8);
#define PG8_SA(b, h) (((b) * 2 + (h)) * HTB)
#define PG8_SB(b, h) ((4 + (b) * 2 + (h)) * HTB)
#define PG8_STAGE(bufoff, gbase, voff) do { _Pragma("unroll") for (int _i = 0; _i < 2; ++_i) \
        __builtin_amdgcn_global_load_lds((const unsigned*)((const char*)(gbase) + (voff)[_i]), (PG8_LAS unsigned*)(lds + (bufoff) + ldsw + _i * 8192), 16, 0, 0); } while (0)
#define PG8_STAGEA(bufoff, kptr, half, VO) do { if constexpr (Sched::GATHER) { PG8_STAGE(bufoff, kptr, (VO)[half]); } else { PG8_STAGE(bufoff, (kptr) + (half) * hstep, voffA); } } while (0)
#define PG8_GOFF(dst, un) do { _Pragma("unroll") for (int h_ = 0; h_ < 2; ++h_) _Pragma("unroll") for (int i_ = 0; i_ < 2; ++i_) dst[h_][i_] = (unsigned)(((size_t)S.arow(un, h_ * HALF + gR[i_]) * K + gC[i_]) * 2u); } while (0)
#define PG8_LDA(dst, b, h) do { _Pragma("unroll") for (int m = 0; m < 4; ++m) _Pragma("unroll") for (int k = 0; k < 2; ++k) dst[m][k] = *(const PG8_LAS bf16x8*)(lds + PG8_SA(b, h) + aoff + m * 2048 + k * 1024); } while (0)
#define PG8_LDB(dst, b, h) do { _Pragma("unroll") for (int n = 0; n < 2; ++n) _Pragma("unroll") for (int k = 0; k < 2; ++k) dst[n][k] = *(const PG8_LAS bf16x8*)(lds + PG8_SB(b, h) + boff + n * 2048 + k * 1024); } while (0)
#define PG8_MMA(ai, bj, At, Bt) do { __builtin_amdgcn_s_setprio(1); _Pragma("unroll") for (int m = 0; m < 4; ++m) _Pragma("unroll") for (int n = 0; n < 2; ++n) _Pragma("unroll") for (int k = 0; k < 2; ++k) \
        acc[ai][bj][m][n] = __builtin_amdgcn_mfma_f32_16x16x32_bf16(Bt[n][k], At[m][k], acc[ai][bj][m][n], 0, 0, 0); __builtin_amdgcn_s_setprio(0); } while (0)
#define PG8_WAIT_V(n) asm volatile("s_waitcnt vmcnt(" #n ")" ::: "memory")
#define PG8_WAIT_L(n) asm volatile("s_waitcnt lgkmcnt(" #n ")" ::: "memory")
#define PG8_BAR __builtin_amdgcn_s_barrier()
#define PG8_SCHED __builtin_amdgcn_sched_barrier(0)
    Unit cur, nxt; int ui = 0;
    if (!S.next(0, cur)) return;
    f32x4 acc[2][2][4][2];
#pragma unroll
    for (int a = 0; a < 2; ++a)
#pragma unroll
        for (int b = 0; b < 2; ++b)
#pragma unroll
            for (int m = 0; m < 4; ++m)
#pragma unroll
                for (int n = 0; n < 2; ++n) acc[a][b][m][n] = (f32x4){0.f, 0.f, 0.f, 0.f};
    bf16x8 At[4][2], B0[2][2], B1[2][2];
    const char* cA = Sched::GATHER ? (const char*)g.A : (const char*)g.A + (size_t)cur.pm * tstep; const char* cB = (const char*)g.Bt + (size_t)cur.pn * tstep;
    if constexpr (Sched::GATHER) PG8_GOFF(gvo, cur);
    S.a_ready(cur);
    if constexpr (SP2) {
        PG8_STAGE(PG8_SB(0, 0), cB, voffB); PG8_STAGE(PG8_SB(0, 1), cB + hstep, voffB); PG8_STAGEA(PG8_SA(0, 0), cA, 0, gvo); PG8_STAGEA(PG8_SA(0, 1), cA, 1, gvo);
        if (wr == 1) PG8_BAR;
        PG8_WAIT_V(2); PG8_BAR;
        PG8_STAGE(PG8_SB(1, 0), cB + kstep, voffB); PG8_STAGEA(PG8_SA(1, 0), cA + kstep, 0, gvo); PG8_STAGE(PG8_SB(1, 1), cB + hstep + kstep, voffB);
        PG8_WAIT_V(6); PG8_BAR;
    } else {
        PG8_STAGE(PG8_SB(0, 0), cB, voffB); PG8_STAGE(PG8_SA(0, 0), cA, voffA); PG8_STAGE(PG8_SB(0, 1), cB + hstep, voffB); PG8_STAGE(PG8_SA(0, 1), cA + hstep, voffA);
        if (wr == 1) PG8_BAR;
        PG8_WAIT_V(4); PG8_BAR;
        PG8_STAGE(PG8_SB(1, 0), cB + kstep, voffB); PG8_STAGE(PG8_SA(1, 0), cA + kstep, voffA); PG8_STAGE(PG8_SB(1, 1), cB + hstep + kstep, voffB);
        PG8_WAIT_V(6); PG8_BAR;
    }
    for (;;) {
        const bool has_next = S.next(ui + 1, nxt);
        const char* nA = (has_next && !Sched::GATHER) ? (const char*)g.A + (size_t)nxt.pm * tstep : cA; const char* nB = has_next ? (const char*)g.Bt + (size_t)nxt.pn * tstep : cB;
        if (has_next) S.stage(nxt, wid, lane);
        if constexpr (Sched::GATHER) { _Pragma("unroll") for (int h_ = 0; h_ < 2; ++h_) _Pragma("unroll") for (int i_ = 0; i_ < 2; ++i_) ngvo[h_][i_] = gvo[h_][i_]; }
        for (int t = 0; t < nt; t += 2) {
            const bool last = (t == nt - 2);
            const char* a1 = cA + (size_t)(t + 1) * kstep;
            const char* a2 = last ? nA : cA + (size_t)(t + 2) * kstep; const char* b2 = last ? nB : cB + (size_t)(t + 2) * kstep;
            const char* a3 = a2 + kstep; const char* b3 = b2 + kstep;
            if (last && has_next) { if constexpr (Sched::GATHER) { PG8_GOFF(ngvo, nxt); } S.a_ready(nxt); }
            if constexpr (Sched::GATHER) { _Pragma("unroll") for (int h_ = 0; h_ < 2; ++h_) _Pragma("unroll") for (int i_ = 0; i_ < 2; ++i_) pvo[h_][i_] = last ? ngvo[h_][i_] : gvo[h_][i_]; }
            if constexpr (SP2) {
            PG8_LDB(B0, 0, 0); PG8_LDB(B1, 0, 1); PG8_SCHED; PG8_LDA(At, 0, 0); PG8_STAGEA(PG8_SA(1, 1), a1, 1, gvo);
            PG8_WAIT_V(8); PG8_WAIT_L(0); PG8_BAR; PG8_MMA(0, 0, At, B0); PG8_MMA(0, 1, At, B1); PG8_BAR; PG8_SCHED;
            PG8_LDA(At, 0, 1); PG8_STAGE(PG8_SB(0, 0), b2, voffB); PG8_STAGE(PG8_SB(0, 1), b2 + hstep, voffB); PG8_STAGEA(PG8_SA(0, 0), a2, 0, pvo);
            PG8_WAIT_V(8); PG8_WAIT_L(0); PG8_BAR; PG8_MMA(1, 0, At, B0); PG8_MMA(1, 1, At, B1); PG8_BAR; PG8_SCHED;
            PG8_LDB(B0, 1, 0); PG8_LDB(B1, 1, 1); PG8_SCHED; PG8_LDA(At, 1, 0); PG8_STAGEA(PG8_SA(0, 1), a2, 1, pvo);
            PG8_WAIT_V(8); PG8_WAIT_L(0); PG8_BAR; PG8_MMA(0, 0, At, B0); PG8_MMA(0, 1, At, B1); PG8_BAR; PG8_SCHED;
            PG8_LDA(At, 1, 1); PG8_STAGE(PG8_SB(1, 0), b3, voffB); PG8_STAGE(PG8_SB(1, 1), b3 + hstep, voffB); PG8_STAGEA(PG8_SA(1, 0), a3, 0, pvo);
            PG8_WAIT_V(8); PG8_WAIT_L(0); PG8_BAR; PG8_MMA(1, 0, At, B0); PG8_MMA(1, 1, At, B1); PG8_BAR; PG8_SCHED;
            } else {
            PG8_LDB(B0, 0, 0); PG8_SCHED; PG8_LDA(At, 0, 0); PG8_STAGE(PG8_SA(1, 1), a1 + hstep, voffA);
            PG8_WAIT_L(8); PG8_BAR; PG8_WAIT_L(0); PG8_MMA(0, 0, At, B0); PG8_BAR; PG8_SCHED;
            PG8_LDB(B1, 0, 1); PG8_STAGE(PG8_SB(0, 0), b2, voffB);
            PG8_BAR; PG8_WAIT_L(0); PG8_MMA(0, 1, At, B1); PG8_BAR;
            PG8_LDA(At, 0, 1); PG8_STAGE(PG8_SA(0, 0), a2, voffA);
            PG8_BAR; PG8_WAIT_L(0); PG8_MMA(1, 0, At, B0); PG8_BAR; PG8_SCHED;
            PG8_STAGE(PG8_SB(0, 1), b2 + hstep, voffB);
            PG8_WAIT_V(6); PG8_BAR; PG8_MMA(1, 1, At, B1); PG8_BAR;
            PG8_LDB(B0, 1, 0); PG8_SCHED; PG8_LDA(At, 1, 0); PG8_STAGE(PG8_SA(0, 1), a2 + hstep, voffA);
            PG8_WAIT_L(8); PG8_BAR; PG8_WAIT_L(0); PG8_MMA(0, 0, At, B0); PG8_BAR; PG8_SCHED;
            PG8_LDB(B1, 1, 1); PG8_STAGE(PG8_SB(1, 0), b3, voffB);
            PG8_BAR; PG8_WAIT_L(0); PG8_MMA(0, 1, At, B1); PG8_BAR;
            PG8_LDA(At, 1, 1); PG8_STAGE(PG8_SA(1, 0), a3, voffA);
            PG8_BAR; PG8_WAIT_L(0); PG8_MMA(1, 0, At, B0); PG8_BAR; PG8_SCHED;
            PG8_STAGE(PG8_SB(1, 1), b3 + hstep, voffB);
            PG8_WAIT_V(6); PG8_BAR; PG8_MMA(1, 1, At, B1); PG8_BAR;
            }
        }
        if constexpr (ALIGN_EPI) { if (wr == 0) PG8_BAR; }
        if constexpr (!Epi::AFTER_DRAIN) { E(acc, cur, wr, wc, fr, fq); S.done(cur); }
        if (!has_next) break;
#pragma unroll
        for (int a = 0; a < 2; ++a)
#pragma unroll
            for (int b = 0; b < 2; ++b)
#pragma unroll
                for (int m = 0; m < 4; ++m)
#pragma unroll
                    for (int n = 0; n < 2; ++n) acc[a][b][m][n] = (f32x4){0.f, 0.f, 0.f, 0.f};
        cur = nxt; cA = nA; cB = nB; ++ui;
        if constexpr (Sched::GATHER) { _Pragma("unroll") for (int h_ = 0; h_ < 2; ++h_) _Pragma("unroll") for (int i_ = 0; i_ < 2; ++i_) gvo[h_][i_] = ngvo[h_][i_]; }
        if constexpr (ALIGN_EPI) { if (wr == 1) PG8_BAR; }
    }
    PG8_WAIT_V(0);
    if constexpr (!ALIGN_EPI) { if (wr == 0) PG8_BAR; }
    PG8_BAR;
    if constexpr (Epi::AFTER_DRAIN) { E.fused(acc, cur, wr, wc, fr, fq, lds, wid, lane); S.done(cur); }
#undef PG8_SA
#undef PG8_SB
#undef PG8_STAGE
#undef PG8_LDA
#undef PG8_STAGEA
#undef PG8_GOFF
#undef PG8_LDB
#undef PG8_MMA
#undef PG8_WAIT_V
#undef PG8_WAIT_L
#undef PG8_BAR
#undef PG8_SCHED
}
}
namespace att {
using bf16x8 = __attribute__((ext_vector_type(8))) short;
using s16x4  = __attribute__((ext_vector_type(4))) short;
using f32x16 = __attribute__((ext_vector_type(16))) float;
using u32x4  = __attribute__((ext_vector_type(4))) unsigned;
using f32x4_t = __attribute__((ext_vector_type(4))) float;
typedef unsigned short bf16;
constexpr int NW = 8, QBLK = 32, KVBLK = 64, LD = 1024, SEQ = 8192;
constexpr int SLOT = KVBLK * 128 * 2;
constexpr int KSL = 4, VSL = 5;
constexpr int LDS_K = 0, LDS_V = KSL * SLOT, LDS_WS = (KSL + VSL) * SLOT, LDS_FLG = LDS_WS + NW * 64 * 4, LDS_NXT = LDS_FLG + 64, LDS_PMX = LDS_NXT + 16, LDS_BYTES = LDS_PMX + 1024;
constexpr float THR2 = 11.5f;
constexpr float EXIT_ARG = -152.0f;
#define SBAR() __builtin_amdgcn_sched_barrier(0)
#define WAIT_BAR(N) asm volatile("s_waitcnt vmcnt(" #N ") lgkmcnt(0)\n\ts_barrier" ::: "memory")
template <int M> __device__ __forceinline__ float swz_xor(float v) {
  return __int_as_float(__builtin_amdgcn_ds_swizzle(__float_as_int(v), (M << 10) | 0x1f)); }
__device__ __forceinline__ int crow(int r, int hi) { return (r & 3) + 8 * (r >> 2) + 4 * hi; }
__device__ __forceinline__ unsigned cvtpk(float lo, float hi) { unsigned r; asm volatile("v_cvt_pk_bf16_f32 %0, %1, %2" : "=v"(r) : "v"(lo), "v"(hi)); return r; }
__device__ __forceinline__ void glds16s(unsigned voff, const void* sbase, unsigned lds_dst) { unsigned keep;
  asm volatile("s_mov_b32 %0, m0\n\ts_mov_b32 m0, %3\n\ts_nop 0\n\tglobal_load_lds_dwordx4 %1, %2\n\ts_mov_b32 m0, %0" : "=&s"(keep) : "v"(voff), "s"(sbase), "s"(lds_dst) : "memory"); }

__device__ __forceinline__ void partialSM(f32x16& p0, f32x16& p1, float& m_reg, float& alpha, float bt, bool diag, float qrel4, float slope2x2) {
  if (diag) {
#pragma unroll
    for (int r = 0; r < 16; ++r) { const float kk = (float)((r & 3) + 8 * (r >> 2));
      p0[r] -= slope2x2 * fmaxf(kk - qrel4, 0.f); p1[r] -= slope2x2 * fmaxf(kk + 32.0f - qrel4, 0.f); }
  }
  float pmax = p0[0];
#pragma unroll
  for (int r = 1; r < 16; ++r) pmax = fmaxf(pmax, p0[r]);
#pragma unroll
  for (int r = 0; r < 16; ++r) pmax = fmaxf(pmax, p1[r]);
  { auto rr = __builtin_amdgcn_permlane32_swap(__float_as_uint(pmax), __float_as_uint(pmax), false, false);
    pmax = fmaxf(__uint_as_float(rr[0]), __uint_as_float(rr[1])); }
  const float b = pmax + bt; float mn;
  if (__builtin_expect(__all(b - m_reg <= THR2), 1)) { mn = m_reg; alpha = 1.f; }
  else { mn = fmaxf(m_reg, b); alpha = __builtin_amdgcn_exp2f(m_reg - mn); m_reg = mn; }
  const float sh = bt - mn;
#pragma unroll
  for (int r = 0; r < 16; ++r) p0[r] = p0[r] + sh;
#pragma unroll
  for (int r = 0; r < 16; ++r) p1[r] = p1[r] + sh;
#pragma unroll
  for (int r = 0; r < 16; ++r) p0[r] = __builtin_amdgcn_exp2f(p0[r]);
}
__device__ __forceinline__ void finishSM(f32x16& p0, f32x16& p1, float alpha, float& l_reg, const float (&u)[16], float whi, float w32, bf16x8& pa0, bf16x8& pa1, bf16x8& pa2, bf16x8& pa3) {
#pragma unroll
  for (int r = 0; r < 16; ++r) p1[r] = __builtin_amdgcn_exp2f(p1[r]);
  float s0 = 0.f, s1 = 0.f;
#pragma unroll
  for (int r = 0; r < 16; ++r) s0 = fmaf(p0[r], u[r], s0);
#pragma unroll
  for (int r = 0; r < 16; ++r) s1 = fmaf(p1[r], u[r], s1);
  float ps = fmaf(s1, w32, s0) * whi;
  { auto rr = __builtin_amdgcn_permlane32_swap(__float_as_uint(ps), __float_as_uint(ps), false, false);
    ps = __uint_as_float(rr[0]) + __uint_as_float(rr[1]); }
  l_reg = l_reg * alpha + ps;
#define PK4(P, BASE, OUT) do { unsigned a0 = cvtpk(P[BASE + 0], P[BASE + 1]), a1 = cvtpk(P[BASE + 2], P[BASE + 3]);   \
    unsigned b0 = cvtpk(P[BASE + 4], P[BASE + 5]), b1 = cvtpk(P[BASE + 6], P[BASE + 7]);                              \
    auto r0 = __builtin_amdgcn_permlane32_swap(a0, b0, false, false); auto r1 = __builtin_amdgcn_permlane32_swap(a1, b1, false, false); \
    u32x4 w = {r0[0], r1[0], r0[1], r1[1]}; OUT = *reinterpret_cast<bf16x8*>(&w); } while (0)
  PK4(p0, 0, pa0); PK4(p0, 8, pa1); PK4(p1, 0, pa2); PK4(p1, 8, pa3);
#undef PK4
}
__device__ __forceinline__ void qkt(f32x16& p0, f32x16& p1, const char* Ks, const bf16x8* qr, int r32, const int (&kq)[4]) {
  p0 = f32x16{}; p1 = f32x16{};
#pragma unroll
  for (int d0 = 0; d0 < 4; ++d0) {
    const bf16x8 b0 = *reinterpret_cast<const bf16x8*>(Ks + r32 * 256 + kq[d0]);
    const bf16x8 b1 = *reinterpret_cast<const bf16x8*>(Ks + (32 + r32) * 256 + kq[d0]);
    p0 = __builtin_amdgcn_mfma_f32_32x32x16_bf16(b0, qr[d0], p0, 0, 0, 0);
    p1 = __builtin_amdgcn_mfma_f32_32x32x16_bf16(b1, qr[d0], p1, 0, 0, 0); }
}
__device__ __forceinline__ int v_rd_base(int lane) { return ((lane & 3) << 3) | (((lane >> 2) & 3) << 6) | (((lane >> 4) & 1) << 5) | (((lane >> 5) & 1) << 8); }
constexpr int v_rd_off(int d0, int ks, int half) { return d0 * 512 + ks * 4096 + half * 2048; }
typedef short v4i16_t __attribute__((ext_vector_type(4)));
template <int OFF> __device__ __forceinline__ s16x4 tr_read(int vb) {
  return __builtin_bit_cast(s16x4, __builtin_amdgcn_ds_read_tr16_b64_v4i16((__attribute__((address_space(3))) v4i16_t*)(uintptr_t)(unsigned)(vb + OFF)));
}
template <int D0> __device__ __forceinline__ void pv_one(f32x16& od, int vb, bf16x8 pa0, bf16x8 pa1, bf16x8 pa2, bf16x8 pa3) {
  const s16x4 l0 = tr_read<v_rd_off(D0, 0, 0)>(vb), h0 = tr_read<v_rd_off(D0, 0, 1)>(vb), l1 = tr_read<v_rd_off(D0, 1, 0)>(vb), h1 = tr_read<v_rd_off(D0, 1, 1)>(vb);
  const s16x4 l2 = tr_read<v_rd_off(D0, 2, 0)>(vb), h2 = tr_read<v_rd_off(D0, 2, 1)>(vb), l3 = tr_read<v_rd_off(D0, 3, 0)>(vb), h3 = tr_read<v_rd_off(D0, 3, 1)>(vb);
  asm volatile("s_waitcnt lgkmcnt(0)" ::: "memory"); SBAR();
#define PK(L, H) (bf16x8){L[0], L[1], L[2], L[3], H[0], H[1], H[2], H[3]}
  od = __builtin_amdgcn_mfma_f32_32x32x16_bf16(pa0, PK(l0, h0), od, 0, 0, 0);
  od = __builtin_amdgcn_mfma_f32_32x32x16_bf16(pa1, PK(l1, h1), od, 0, 0, 0);
  od = __builtin_amdgcn_mfma_f32_32x32x16_bf16(pa2, PK(l2, h2), od, 0, 0, 0);
  od = __builtin_amdgcn_mfma_f32_32x32x16_bf16(pa3, PK(l3, h3), od, 0, 0, 0);
#undef PK
}
__device__ __forceinline__ void pv_d0(f32x16* o, int vb, bf16x8 pa0, bf16x8 pa1, bf16x8 pa2, bf16x8 pa3) {
  pv_one<0>(o[0], vb, pa0, pa1, pa2, pa3); pv_one<1>(o[1], vb, pa0, pa1, pa2, pa3); pv_one<2>(o[2], vb, pa0, pa1, pa2, pa3); pv_one<3>(o[3], vb, pa0, pa1, pa2, pa3);
}

__device__ __forceinline__ void softmax_tile(f32x16& p0, f32x16& p1, float& m_reg, float& mmin, float& l_reg, f32x16* o, float bt, bool diag, float qrel4, float slope2x2, const float (&u)[16], float whi, float w32,
                                             float* al_l, int r32, int hi, bf16x8& pa0, bf16x8& pa1, bf16x8& pa2, bf16x8& pa3) {
  if (diag) {
#pragma unroll
    for (int r = 0; r < 16; ++r) { const float kk = (float)((r & 3) + 8 * (r >> 2));
      p0[r] -= slope2x2 * fmaxf(kk - qrel4, 0.f); p1[r] -= slope2x2 * fmaxf(kk + 32.0f - qrel4, 0.f); }
  }
  float pmax = p0[0];
#pragma unroll
  for (int r = 1; r < 16; ++r) pmax = fmaxf(pmax, p0[r]);
#pragma unroll
  for (int r = 0; r < 16; ++r) pmax = fmaxf(pmax, p1[r]);
  { auto rr = __builtin_amdgcn_permlane32_swap(__float_as_uint(pmax), __float_as_uint(pmax), false, false);
    pmax = fmaxf(__uint_as_float(rr[0]), __uint_as_float(rr[1])); }
  const float b = pmax + bt;
  if (__builtin_expect(!__all(b - m_reg <= THR2), 0)) {
    const float mn = fmaxf(m_reg, b), alpha = __builtin_amdgcn_exp2f(m_reg - mn); m_reg = mn; l_reg *= alpha;
    { float mm = m_reg;
      mm = fminf(mm, swz_xor<1>(mm)); mm = fminf(mm, swz_xor<2>(mm)); mm = fminf(mm, swz_xor<4>(mm)); mm = fminf(mm, swz_xor<8>(mm)); mm = fminf(mm, swz_xor<16>(mm));
      mmin = __uint_as_float(__builtin_amdgcn_readfirstlane(__float_as_uint(mm))); }
#pragma unroll
    for (int d = 0; d < 4; ++d)
#pragma unroll
      for (int r = 0; r < 16; ++r) o[d][r] *= alpha;
  }
  const float sh = bt - m_reg;
#pragma unroll
  for (int r = 0; r < 16; ++r) p0[r] = __builtin_amdgcn_exp2f(p0[r] + sh);
#pragma unroll
  for (int r = 0; r < 16; ++r) p1[r] = __builtin_amdgcn_exp2f(p1[r] + sh);
  float s0 = 0.f, s1 = 0.f;
#pragma unroll
  for (int r = 0; r < 16; ++r) s0 = fmaf(p0[r], u[r], s0);
#pragma unroll
  for (int r = 0; r < 16; ++r) s1 = fmaf(p1[r], u[r], s1);
  float ps = fmaf(s1, w32, s0) * whi;
  { auto rr = __builtin_amdgcn_permlane32_swap(__float_as_uint(ps), __float_as_uint(ps), false, false);
    ps = __uint_as_float(rr[0]) + __uint_as_float(rr[1]); }
  l_reg += ps;
#define PK4(P, BASE, OUT) do { unsigned a0 = cvtpk(P[BASE + 0], P[BASE + 1]), a1 = cvtpk(P[BASE + 2], P[BASE + 3]);   \
    unsigned b0 = cvtpk(P[BASE + 4], P[BASE + 5]), b1 = cvtpk(P[BASE + 6], P[BASE + 7]);                              \
    auto r0 = __builtin_amdgcn_permlane32_swap(a0, b0, false, false); auto r1 = __builtin_amdgcn_permlane32_swap(a1, b1, false, false); \
    u32x4 w = {r0[0], r1[0], r0[1], r1[1]}; OUT = *reinterpret_cast<bf16x8*>(&w); } while (0)
  PK4(p0, 0, pa0); PK4(p0, 8, pa1); PK4(p1, 0, pa2); PK4(p1, 8, pa3);
#undef PK4
}
template <int D0> __device__ __forceinline__ void vload8(bf16x8 (&vf)[8], int vb) {
#define VF1(i, d0, ks) do { const s16x4 l_ = tr_read<v_rd_off(d0, ks, 0)>(vb), h_ = tr_read<v_rd_off(d0, ks, 1)>(vb); vf[i] = (bf16x8){l_[0], l_[1], l_[2], l_[3], h_[0], h_[1], h_[2], h_[3]}; } while (0)
  VF1(0, D0, 0); VF1(1, D0, 1); VF1(2, D0, 2); VF1(3, D0, 3); VF1(4, D0 + 1, 0); VF1(5, D0 + 1, 1); VF1(6, D0 + 1, 2); VF1(7, D0 + 1, 3);
#undef VF1
}
__device__ __forceinline__ void pv8(f32x16& oa, f32x16& ob, const bf16x8 (&vf)[8], bf16x8 pa0, bf16x8 pa1, bf16x8 pa2, bf16x8 pa3) {
  oa = __builtin_amdgcn_mfma_f32_32x32x16_bf16(vf[0], pa0, oa, 0, 0, 0); ob = __builtin_amdgcn_mfma_f32_32x32x16_bf16(vf[4], pa0, ob, 0, 0, 0);
  oa = __builtin_amdgcn_mfma_f32_32x32x16_bf16(vf[1], pa1, oa, 0, 0, 0); ob = __builtin_amdgcn_mfma_f32_32x32x16_bf16(vf[5], pa1, ob, 0, 0, 0);
  oa = __builtin_amdgcn_mfma_f32_32x32x16_bf16(vf[2], pa2, oa, 0, 0, 0); ob = __builtin_amdgcn_mfma_f32_32x32x16_bf16(vf[6], pa2, ob, 0, 0, 0);
  oa = __builtin_amdgcn_mfma_f32_32x32x16_bf16(vf[3], pa3, oa, 0, 0, 0); ob = __builtin_amdgcn_mfma_f32_32x32x16_bf16(vf[7], pa3, ob, 0, 0, 0);
}

__device__ __forceinline__ int attn_unit(const bf16* Qb, const bf16* __restrict__ Kh, const bf16* __restrict__ Vh, bf16* Ob, int i, float slope2, const float (&u)[16], float w4, float w32, float lam,
                                          const float* __restrict__ subln_g, const float* pmx, unsigned* qctr, char* lds, int probe = 0) {
  int tid = threadIdx.x; asm volatile("" : "+v"(tid));
  const int wid = __builtin_amdgcn_readfirstlane(tid >> 6), lane = tid & 63, r32 = lane & 31, hi = lane >> 5;
  const int c = wid & 1, rb = wid >> 1, grp = wid >> 2;
  const unsigned lds0 = (unsigned)(uintptr_t)lds;
  char* K_lds = lds + LDS_K;
  float* ws = (float*)(lds + LDS_WS) + wid * 64; float* li_l = ws; float* al_l = ws + 32;
  float m_reg = -1e30f, l_reg = 0; f32x16 o[4] = {}; bf16x8 qr[4];
  const bf16* Qw = Qb + (long)(rb * QBLK + r32) * LD + c * 64 + hi * 8;
#pragma unroll
  for (int d0 = 0; d0 < 4; ++d0) qr[d0] = *reinterpret_cast<const bf16x8*>(Qw + d0 * 16);
  float qn;
  unsigned* flg = (unsigned*)(lds + LDS_FLG);
  unsigned kvo, vvo;
  { const int p = wid;
    { const int row = 4 * p + (lane >> 4), ch = (lane & 15) ^ (row & 15); kvo = (unsigned)((row * LD + ch * 8) * 2); }
    { const int lp = lane & 31, kk = 8 * (p >> 1) + (lp >> 2), key = (kk & ~0xC) | ((kk & 4) << 1) | ((kk & 8) >> 1), col = 32 * (2 * (p & 1) + (lane >> 5)) + 8 * (lp & 3); vvo = (unsigned)((key * LD + col) * 2); } }
  const unsigned kdst = lds0 + LDS_K + wid * 1024, vdst = lds0 + LDS_V + wid * 1024;
  const int NT = 2 * i + 2;
#define DMA_K(n, slotoff) do { const char* sb_ = (const char*)Kh + (size_t)(NT - 1 - (n)) * (KVBLK * LD * 2); \
    glds16s(kvo, sb_, (unsigned)__builtin_amdgcn_readfirstlane(kdst + (slotoff))); glds16s(kvo, sb_ + 32 * LD * 2, (unsigned)__builtin_amdgcn_readfirstlane(kdst + (slotoff) + 8192)); } while (0)
#define DMA_V(n, slotoff) do { const char* sb_ = (const char*)Vh + (size_t)(NT - 1 - (n)) * (KVBLK * LD * 2); \
    glds16s(vvo, sb_, (unsigned)__builtin_amdgcn_readfirstlane(vdst + (slotoff))); glds16s(vvo, sb_ + 32 * LD * 2, (unsigned)__builtin_amdgcn_readfirstlane(vdst + (slotoff) + 8192)); } while (0)
#define WAITB(cnt) do { SBAR(); const int c_ = (cnt); if (c_ >= 8) { WAIT_BAR(8); } else if (c_ >= 6) { WAIT_BAR(6); } else if (c_ >= 4) { WAIT_BAR(4); } else if (c_ >= 2) { WAIT_BAR(2); } else { WAIT_BAR(0); } SBAR(); } while (0)
#define BSZ(j) (((j) + 4 < NT ? 2 : 0) + ((j) + 3 < NT ? 2 : 0))
  const int kq0 = r32 * 256 + (((c * 8 + hi) ^ (r32 & 15)) * 16);
  const int vb0 = (int)(lds0 + LDS_V) + v_rd_base(lane);
  const bool skiplast = rb < 2;
  const float qloc = (float)(rb * QBLK + r32 - 4 * hi);
  const float whi = hi ? w4 : 1.0f;
  const float slope64 = slope2 * 64.0f, slope2x2 = 2.0f * slope2;
  bf16x8 kf[8], vfa[8], vfb[8], pa0, pa1, pa2, pa3; f32x16 p0, p1;
#define KLOAD(slotoff) do { const char* ks_ = K_lds + (slotoff); _Pragma("unroll") for (int d0 = 0; d0 < 4; ++d0) { \
    kf[2 * d0] = *reinterpret_cast<const bf16x8*>(ks_ + (kq0 ^ (32 * d0))); kf[2 * d0 + 1] = *reinterpret_cast<const bf16x8*>(ks_ + (kq0 ^ (32 * d0)) + 8192); } } while (0)
  if (wid == 0) glds16s((unsigned)lane * 16u, pmx, (unsigned)__builtin_amdgcn_readfirstlane(lds0 + LDS_PMX));
  DMA_K(0, 0);
  { float s = 0.f;
#pragma unroll
    for (int d0 = 0; d0 < 4; ++d0)
#pragma unroll
      for (int e = 0; e < 8; ++e) { const float v = __uint_as_float(((unsigned)(unsigned short)qr[d0][e]) << 16); s = fmaf(v, v, s); }
    { auto rr = __builtin_amdgcn_permlane32_swap(__float_as_uint(s), __float_as_uint(s), false, false); s = __uint_as_float(rr[0]) + __uint_as_float(rr[1]); }
    s = fmaxf(s, swz_xor<1>(s)); s = fmaxf(s, swz_xor<2>(s)); s = fmaxf(s, swz_xor<4>(s)); s = fmaxf(s, swz_xor<8>(s)); s = fmaxf(s, swz_xor<16>(s));
    qn = __uint_as_float(__builtin_amdgcn_readfirstlane(__float_as_uint(sqrtf(s) * 1.001f))); }
  DMA_K(1, SLOT); DMA_V(0, 0);
  if (2 < NT) { DMA_K(2, 2 * SLOT); } DMA_V(1, SLOT);
  if (3 < NT) { DMA_K(3, 3 * SLOT); } if (2 < NT) { DMA_V(2, 2 * SLOT); }
  SBAR(); if (2 < NT) { WAIT_BAR(12); } else { WAIT_BAR(6); } SBAR();
  KLOAD(0);
  if (wid < 2) {
    float* pm_ = (float*)(lds + LDS_PMX) + wid * 128;
    float a = pm_[lane], b2 = pm_[64 + lane];
#define DPP_MAX(v, ctrl, rmask) v = fmaxf(v, __int_as_float(__builtin_amdgcn_update_dpp(__float_as_int(v), __float_as_int(v), ctrl, rmask, 0xf, false)))
    DPP_MAX(a, 0x111, 0xf); DPP_MAX(a, 0x112, 0xf); DPP_MAX(a, 0x114, 0xf); DPP_MAX(a, 0x118, 0xf); DPP_MAX(a, 0x142, 0xa); DPP_MAX(a, 0x143, 0xc);
    DPP_MAX(b2, 0x111, 0xf); DPP_MAX(b2, 0x112, 0xf); DPP_MAX(b2, 0x114, 0xf); DPP_MAX(b2, 0x118, 0xf); DPP_MAX(b2, 0x142, 0xa); DPP_MAX(b2, 0x143, 0xc);
#undef DPP_MAX
    b2 = fmaxf(b2, __int_as_float(__builtin_amdgcn_readlane(__float_as_int(a), 63)));
    pm_[lane] = sqrtf(a) * 1.001f; pm_[64 + lane] = sqrtf(b2) * 1.001f;
  }
  if (grp == 1) WAITB(BSZ(-2) + BSZ(-1));
  int v5 = 0;
  float mmin = -1e30f;
  for (int n = 0; n < NT; ++n) {
    const int v5p = (v5 == 0) ? 4 : v5 - 1, v5n2 = (v5 >= 3) ? v5 - 3 : v5 + 2;
    int vbp = vb0 + v5p * SLOT; asm volatile("" : "+v"(vbp));
    p0 = f32x16{}; p1 = f32x16{};
#define QKM(i) do { if ((i) & 1) p1 = __builtin_amdgcn_mfma_f32_32x32x16_bf16(kf[i], qr[(i) >> 1], p1, 0, 0, 0); else p0 = __builtin_amdgcn_mfma_f32_32x32x16_bf16(kf[i], qr[(i) >> 1], p0, 0, 0, 0); } while (0)
#define VFR(vf, i, D0) do { const s16x4 l_ = tr_read<v_rd_off((D0) + ((i) >> 2), (i) & 3, 0)>(vbp), h_ = tr_read<v_rd_off((D0) + ((i) >> 2), (i) & 3, 1)>(vbp); vf[i] = (bf16x8){l_[0], l_[1], l_[2], l_[3], h_[0], h_[1], h_[2], h_[3]}; } while (0)
#define PVM(oo, pa, vf, i) oo = __builtin_amdgcn_mfma_f32_32x32x16_bf16(vf[i], pa, oo, 0, 0, 0)
    if (n > 0) {
      QKM(0); SBAR(); VFR(vfa, 0, 0); SBAR(); QKM(1); SBAR(); VFR(vfa, 4, 0); SBAR(); QKM(2); SBAR(); VFR(vfa, 1, 0); SBAR(); QKM(3); SBAR(); VFR(vfa, 5, 0); SBAR();
      QKM(4); SBAR(); VFR(vfa, 2, 0); SBAR(); QKM(5); SBAR(); VFR(vfa, 6, 0); SBAR(); QKM(6); SBAR(); VFR(vfa, 3, 0); SBAR(); QKM(7); SBAR(); VFR(vfa, 7, 0); SBAR();
      if (n + 3 < NT) DMA_K(n + 3, ((n + 3) & 3) * SLOT);
      SBAR();
      PVM(o[0], pa0, vfa, 0); SBAR(); VFR(vfb, 0, 2); SBAR(); PVM(o[1], pa0, vfa, 4); SBAR(); VFR(vfb, 4, 2); SBAR(); PVM(o[0], pa1, vfa, 1); SBAR(); VFR(vfb, 1, 2); SBAR(); PVM(o[1], pa1, vfa, 5); SBAR(); VFR(vfb, 5, 2); SBAR();
      PVM(o[0], pa2, vfa, 2); SBAR(); VFR(vfb, 2, 2); SBAR(); PVM(o[1], pa2, vfa, 6); SBAR(); VFR(vfb, 6, 2); SBAR(); PVM(o[0], pa3, vfa, 3); SBAR(); VFR(vfb, 3, 2); SBAR(); PVM(o[1], pa3, vfa, 7); SBAR(); VFR(vfb, 7, 2); SBAR();
      if (n + 2 < NT) DMA_V(n + 2, v5n2 * SLOT);
      SBAR();
      pv8(o[2], o[3], vfb, pa0, pa1, pa2, pa3);
    } else {
#pragma unroll
      for (int d0 = 0; d0 < 4; ++d0) { p0 = __builtin_amdgcn_mfma_f32_32x32x16_bf16(kf[2 * d0], qr[d0], p0, 0, 0, 0); p1 = __builtin_amdgcn_mfma_f32_32x32x16_bf16(kf[2 * d0 + 1], qr[d0], p1, 0, 0, 0); }
    }
#undef QKM
#undef VFR
#undef PVM
    WAITB(BSZ(n - 2) + BSZ(n - 1));
    __builtin_amdgcn_s_setprio(1);
    u32x4 f0 = {0u, 0u, 0u, 0u}, f1 = {0u, 0u, 0u, 0u};
    if (n > 0) { f0 = *(const u32x4*)(flg + ((n - 1) & 1) * 8); f1 = *(const u32x4*)(flg + ((n - 1) & 1) * 8 + 4); }
    const int tn = NT - 1 - n;
    const float pmv = ((const float*)(lds + LDS_PMX))[c * 128 + (tn > 0 ? tn - 1 : 0)];
    KLOAD(((n + 1) & 3) * SLOT); SBAR();
    if (!(skiplast && n == 0))
      softmax_tile(p0, p1, m_reg, mmin, l_reg, o, slope64 * (float)(NT - 1 - n), (n == 0) || (skiplast && n == 1), (n == 0) ? qloc - 64.0f : qloc, slope2x2, u, whi, w32, al_l, r32, hi, pa0, pa1, pa2, pa3);
    else { pa0 = bf16x8{}; pa1 = bf16x8{}; pa2 = bf16x8{}; pa3 = bf16x8{}; }
    { const float argb = (tn > 0) ? fmaf(qn, pmv, slope64 * (float)(tn - 1) - mmin) : 0.f;
      if (lane == 0) flg[(n & 1) * 8 + wid] = (argb + slope64 < EXIT_ARG) ? 1u : 0u; }
    const bool stop = __builtin_amdgcn_readfirstlane(f0.x & f0.y & f0.z & f0.w & f1.x & f1.y & f1.z & f1.w) != 0u;
    __builtin_amdgcn_s_setprio(0);
    WAITB(BSZ(n - 1));
    v5 = (v5 == 4) ? 0 : v5 + 1;
    if (stop) break;
  }
  __builtin_amdgcn_s_setprio(0);
  f32x4_t gs4[2][4];
#pragma unroll
  for (int dd = 0; dd < 2; ++dd)
#pragma unroll
    for (int g = 0; g < 4; ++g) gs4[dd][g] = *(const f32x4_t*)(subln_g + (2 * c + dd) * 32 + 8 * g + 4 * hi);
  { int vbl = vb0 + ((v5 == 0) ? 4 : v5 - 1) * SLOT; asm volatile("" : "+v"(vbl));
    vload8<0>(vfa, vbl); vload8<2>(vfb, vbl); SBAR();
    pv8(o[0], o[1], vfa, pa0, pa1, pa2, pa3);
    SBAR(); asm volatile("s_waitcnt lgkmcnt(0)" ::: "memory"); SBAR();
    pv8(o[2], o[3], vfb, pa0, pa1, pa2, pa3); }
  if (grp == 0) WAITB(0);
  if (probe == 2) {
    WAITB(0);
    if (wid == 1 && lane == 0) *(unsigned*)(lds + LDS_NXT) = __hip_atomic_fetch_add(qctr, 1u, __ATOMIC_RELAXED, __HIP_MEMORY_SCOPE_AGENT);
    if (wid == 0 && lane == 0) Ob[0] = (bf16)__float_as_uint(o[0][0] + o[1][1] + o[2][2] + o[3][3] + l_reg);
    WAITB(0);
    return (int)__builtin_amdgcn_readfirstlane(*(const unsigned*)(lds + LDS_NXT));
  }
  { const float rl = __builtin_amdgcn_rcpf(l_reg) * (c ? lam : 1.0f);
#pragma unroll
    for (int d0 = 0; d0 < 4; ++d0)
#pragma unroll
      for (int r = 0; r < 16; ++r) o[d0][r] *= rl; }
  WAITB(0);
  float* ex = (float*)lds + (size_t)rb * (4 * 16 * 64);
#define EPI_SEND(B0) do { _Pragma("unroll") for (int dd = 0; dd < 2; ++dd) _Pragma("unroll") for (int r = 0; r < 16; ++r) ex[((c * 2 + dd) * 16 + r) * 64 + lane] = o[(B0) + dd][r]; } while (0)
  if (c == 0) { EPI_SEND(2); } else { EPI_SEND(0); }
#undef EPI_SEND
  WAITB(0);
  if (wid == 1 && lane == 0) *(unsigned*)(lds + LDS_NXT) = __hip_atomic_fetch_add(qctr, 1u, __ATOMIC_RELAXED, __HIP_MEMORY_SCOPE_AGENT);
  float vo[2][16]; float ssq = 0.f;
#define EPI_COMBINE(B0) do { _Pragma("unroll") for (int dd = 0; dd < 2; ++dd) _Pragma("unroll") for (int r = 0; r < 16; ++r) { \
      const float oth_ = ex[(((1 - c) * 2 + dd) * 16 + r) * 64 + lane]; const float v_ = (c == 0) ? o[(B0) + dd][r] - oth_ : oth_ - o[(B0) + dd][r]; vo[dd][r] = v_; ssq = fmaf(v_, v_, ssq); } } while (0)
  if (c == 0) { EPI_COMBINE(0); } else { EPI_COMBINE(2); }
#undef EPI_COMBINE
  { auto rr = __builtin_amdgcn_permlane32_swap(__float_as_uint(ssq), __float_as_uint(ssq), false, false); ssq = __uint_as_float(rr[0]) + __uint_as_float(rr[1]); }
  if (hi == 0) ws[r32] = ssq;
  SBAR(); asm volatile("s_waitcnt lgkmcnt(0)\n\ts_barrier" ::: "memory"); SBAR();
  ssq += ((const float*)(lds + LDS_WS))[(wid ^ 1) * 64 + r32];
  const float rs = __builtin_amdgcn_rsqf(ssq * (1.0f / 128.0f) + 1e-5f) * 0.8f;
  { int lane2 = lane; asm volatile("" : "+v"(lane2));
    bf16* Ow = Ob + (long)(rb * QBLK + (lane2 & 31)) * LD + c * 64 + ((lane2 >> 5) ? 8 : 0);
#pragma unroll
    for (int dd = 0; dd < 2; ++dd)
#pragma unroll
      for (int g = 0; g < 4; g += 2) {
        const f32x4_t ga = gs4[dd][g], gb = gs4[dd][g + 1];
        const unsigned a0 = cvtpk(vo[dd][4 * g] * rs * ga[0], vo[dd][4 * g + 1] * rs * ga[1]), a1 = cvtpk(vo[dd][4 * g + 2] * rs * ga[2], vo[dd][4 * g + 3] * rs * ga[3]);
        const unsigned b0 = cvtpk(vo[dd][4 * g + 4] * rs * gb[0], vo[dd][4 * g + 5] * rs * gb[1]), b1 = cvtpk(vo[dd][4 * g + 6] * rs * gb[2], vo[dd][4 * g + 7] * rs * gb[3]);
        auto r0 = __builtin_amdgcn_permlane32_swap(a0, b0, false, false); auto r1 = __builtin_amdgcn_permlane32_swap(a1, b1, false, false);
        const u32x4 w = {r0[0], r1[0], r0[1], r1[1]};
        *(u32x4*)(Ow + dd * 32 + 8 * g) = w; } }
  SBAR(); asm volatile("s_waitcnt lgkmcnt(0)\n\ts_barrier" ::: "memory"); SBAR();
  return (int)__builtin_amdgcn_readfirstlane(*(const unsigned*)(lds + LDS_NXT));
#undef DMA_K
#undef DMA_V
#undef WAITB
#undef BSZ
#undef KLOAD
}
#undef SBAR
#undef WAIT_BAR
}

#define GAS __attribute__((address_space(1)))
#define LAS __attribute__((address_space(3)))
typedef unsigned short bf16;
typedef unsigned v4u __attribute__((ext_vector_type(4)));
typedef float f32x4 __attribute__((ext_vector_type(4)));
typedef short bf16x8 __attribute__((ext_vector_type(8)));
typedef GAS unsigned gu32;
typedef GAS unsigned long long gu64;
#define RLX_AGENT __ATOMIC_RELAXED, __HIP_MEMORY_SCOPE_AGENT
#define LDS_WAIT() asm volatile("s_waitcnt lgkmcnt(0)" ::: "memory")
#define VM_WAIT() asm volatile("s_waitcnt vmcnt(0)" ::: "memory")
__device__ __forceinline__ unsigned long long rt() { return __builtin_amdgcn_s_memrealtime(); }
__device__ __forceinline__ unsigned f2bf(float f) { unsigned u = __builtin_bit_cast(unsigned, f); return (u + 0x7fffu + ((u >> 16) & 1u)) >> 16; }
__device__ __forceinline__ unsigned pk2(float lo, float hi) { unsigned r; asm("v_cvt_pk_bf16_f32 %0, %1, %2" : "=v"(r) : "v"(lo), "v"(hi)); return r; }

#define XB_TMO      128
#define XB_XCNT(j)  (256  + 64 * (j))
#define XB_XSUB(j)  (1280 + 64 * (j))
#define XB_XGEN(j)  (2304 + 64 * (j))
#define XB_TOP      3328
#define XB_TOPGEN   3392
#define XCD_BAR_WORDS 3456
#define XB_SPIN_CAP (1u << 18)

__device__ __forceinline__ unsigned xb_ld(unsigned* p)              { return __hip_atomic_load(p, __ATOMIC_RELAXED, __HIP_MEMORY_SCOPE_AGENT); }
__device__ __forceinline__ unsigned xb_add(unsigned* p, unsigned v) { return __hip_atomic_fetch_add(p, v, __ATOMIC_RELAXED, __HIP_MEMORY_SCOPE_AGENT); }
__device__ __forceinline__ unsigned xb_xcc_id() { return (unsigned)__builtin_amdgcn_s_getreg((3 << 11) | 20) & 0xFu; }
#define XB_SPIN(cond, bar) do { unsigned _sp = 0; while (cond) { __builtin_amdgcn_s_sleep(1); \
    if ((++_sp & 255u) == 0u) { if (xb_ld(&(bar)[XB_TMO])) break; if (_sp > XB_SPIN_CAP) { atomicAdd(&(bar)[XB_TMO], 1u); break; } } } } while (0)

struct XcdBarrier {
    unsigned* bar; unsigned x;
    volatile LAS unsigned* st;
};

__device__ __forceinline__ XcdBarrier xcd_barrier_post(unsigned* bar, volatile LAS unsigned* st) {
    XcdBarrier b; b.bar = bar; b.x = xb_xcc_id(); b.st = st;
    if (threadIdx.x == 0) (void)xb_add(&bar[XB_XCNT(b.x)], 1u);
    return b;
}
__device__ __forceinline__ void xcd_barrier_complete(unsigned* bar, unsigned x, unsigned& nloc, unsigned& nx) {
    const unsigned G = gridDim.x * gridDim.y * gridDim.z;
    unsigned sum, cnt, mine, sp = 0u;
    for (;;) {
        sum = 0u; cnt = 0u; mine = 0u;
#pragma unroll
        for (unsigned j = 0; j < 16; ++j) { const unsigned c = xb_ld(&bar[XB_XCNT(j)]); sum += c; cnt += (c > 0u) ? 1u : 0u; mine = (j == x) ? c : mine; }
        if (sum == G) break;
        __builtin_amdgcn_s_sleep(1);
        if ((++sp & 255u) == 0u) { if (xb_ld(&bar[XB_TMO])) break; if (sp > XB_SPIN_CAP) { atomicAdd(&bar[XB_TMO], 1u); break; } }
    }
    nloc = mine > 0u ? mine : 1u; nx = cnt > 0u ? cnt : 1u;
}

__device__ __forceinline__ void xcd_barrier(const XcdBarrier& b) {
    asm volatile("s_waitcnt vmcnt(0)" ::: "memory");
    __syncthreads();
    if (threadIdx.x == 0) {
        unsigned* bar = b.bar;
        __builtin_amdgcn_s_waitcnt(0);
        unsigned nloc = b.st[0], nx = b.st[1];
        if (nloc == 0u) { xcd_barrier_complete(bar, b.x, nloc, nx); b.st[0] = nloc; b.st[1] = nx; }
        const unsigned old = xb_add(&bar[XB_XSUB(b.x)], 1u);
        const unsigned gen = old / nloc;
        if (old + 1u == (gen + 1u) * nloc) {
            __builtin_amdgcn_fence(__ATOMIC_RELEASE, "agent");
            asm volatile("s_waitcnt vmcnt(0)" ::: "memory");
            const unsigned og = xb_add(&bar[XB_TOP], 1u);
            const unsigned tg = og / nx;
            if (og + 1u == (tg + 1u) * nx) xb_add(&bar[XB_TOPGEN], 1u);
            else XB_SPIN(xb_ld(&bar[XB_TOPGEN]) == tg, bar);
            __builtin_amdgcn_fence(__ATOMIC_ACQUIRE, "agent");
            xb_add(&bar[XB_XGEN(b.x)], 1u);
            asm volatile("s_waitcnt vmcnt(0)" ::: "memory");
        } else {
            XB_SPIN(xb_ld(&bar[XB_XGEN(b.x)]) == gen, bar);
            __builtin_amdgcn_fence(__ATOMIC_ACQUIRE, "agent");
            asm volatile("s_waitcnt vmcnt(0)" ::: "memory");
        }
    }
    __syncthreads();
}

typedef unsigned v2u __attribute__((ext_vector_type(2)));

constexpr int NWAVES = 8, NTHREADS = NWAVES * 64;
constexpr int BATCH = 8, SEQ = 8192, D = 1024, T = BATCH * SEQ;
constexpr int INW = 6144, GW = 512, NHEAD = 8;
constexpr int NEXP = 32, EHID = 512, NASSIGN = T * 2;
constexpr int MAXTILES = (NASSIGN + NEXP * 255) / 256 + 1;
constexpr int MOE_CAP = NASSIGN;
constexpr float LN_EPS = 1e-5f;
constexpr float ALPHA = 1.189207115002721f;
constexpr float C2 = 0.125f * 1.4426950408889634f;
constexpr int NPHASE = 12;
constexpr unsigned STAGGER_P1_TICKS = 900;
#ifndef MK_ONE_LAUNCH
#define MK_ONE_LAUNCH 1
#endif
#ifndef MK_PROBE_PHASE
#define MK_PROBE_PHASE -1
#endif

constexpr size_t MiB = 1u << 20;
constexpr size_t WS_CTL = 0, CTL_ZERO_BYTES = 64 * 1024;
constexpr size_t WS_ROUTE_E = 1 * MiB;
constexpr size_t WS_ROUTE_W = WS_ROUTE_E + (size_t)NASSIGN * 4;
constexpr size_t WS_SLOT_TOK = WS_ROUTE_W + (size_t)NASSIGN * 4;
constexpr size_t WS_SLOT_W = WS_SLOT_TOK + (size_t)MAXTILES * 256 * 4;
constexpr size_t WS_TILE_E = WS_SLOT_W + (size_t)MAXTILES * 256 * 4;
constexpr size_t WS_TILE_ROWS = WS_TILE_E + 4096;
constexpr size_t WS_KN2 = WS_TILE_ROWS + 4096;
constexpr size_t WS_PMX = WS_KN2 + 8 * 8 * 2 * 128 * 4;
constexpr size_t WS_MISC_END = WS_PMX + 8 * 8 * 2 * 128 * 4;
static_assert(WS_MISC_END <= 4 * MiB, "misc tables");
constexpr size_t WS_WIN = 4 * MiB;
constexpr size_t WS_WA = 16 * MiB;
constexpr size_t WS_WB = 17 * MiB;
constexpr size_t WS_WO = 19 * MiB;
constexpr size_t WS_SGW = 21 * MiB;
constexpr size_t WS_WGU = 22 * MiB;
constexpr size_t WS_WD = 86 * MiB;
constexpr size_t WS_XB = 128 * MiB;
constexpr size_t WS_Q = 256 * MiB;
constexpr size_t WS_K = 384 * MiB, WS_VAL = 512 * MiB, WS_GA = 640 * MiB, WS_GB = 768 * MiB;
constexpr size_t WS_LIST_TOK = 384 * MiB, WS_LIST_W = 416 * MiB;
static_assert((size_t)NEXP * MOE_CAP * 4 + 1024 <= 32 * MiB, "dispatch lists");
constexpr size_t WS_PART = 256 * MiB;
constexpr size_t WS_STATS = 272 * MiB;
constexpr size_t WS_XS = 256 * MiB;
constexpr size_t WS_HB = 528 * MiB;
constexpr size_t WS_FFN = 664 * MiB;
constexpr size_t WS_END = 920 * MiB;
static_assert(WS_XS + (size_t)MAXTILES * 256 * 1024 * 2 <= WS_HB && WS_HB + (size_t)MAXTILES * 256 * 512 * 2 <= WS_FFN && WS_FFN + (size_t)NASSIGN * 1024 * 2 <= WS_END, "moe buffers");
constexpr size_t OUT_UV = 0, OUT_SG = 128 * MiB;
constexpr int CW_BAR = 1024;
constexpr int CW_CNT = 12288;
constexpr int CW_CUR = 12288 + 64;
constexpr int CW_AQ = 12288 + 128;
static_assert((CW_BAR + 3 * 3456) <= CW_CNT && (CW_AQ + 3 * 512) * 4 <= (int)CTL_ZERO_BYTES, "ctl map");

constexpr int RING_OFF = 0, RING_BYTES = 155648;
constexpr int LDSCTL_OFF = RING_BYTES, MISC_OFF = LDSCTL_OFF + 320;
constexpr int MOE_LDS_OFF = 131072;
static_assert(MOE_LDS_OFF + pg8::MOE_LDS_BYTES <= RING_BYTES && MOE_LDS_OFF + INW * 4 <= RING_BYTES, "MoE LDS tables / P1 bias copy");
constexpr int LDS_BYTES = 163840;
static_assert(MISC_OFF + 128 <= LDS_BYTES, "LDS map");

__device__ __forceinline__ float wave_sum(float v) {
#pragma unroll
    for (int o = 1; o < 64; o <<= 1) v += __shfl_xor(v, o);
    return v;
}

__device__ __forceinline__ void p0_transpose_item(const float* W, int K, int N, bf16* WT, int row_off, LAS float* scr, int item, int lane) {
    const int nblk = N / 32, kb = item / nblk, nb = item % nblk, k0 = 64 * kb, n0 = 32 * nb;
    float tv[32];
#pragma unroll
    for (int i = 0; i < 32; ++i) tv[i] = W[(size_t)(k0 + 2 * i + (lane >> 5)) * N + n0 + (lane & 31)];
#pragma unroll
    for (int i = 0; i < 32; ++i) scr[(2 * i + (lane >> 5)) * 33 + (lane & 31)] = tv[i];
    LDS_WAIT(); asm volatile("" ::: "memory");
    const int c = lane & 7;
#pragma unroll
    for (int j = 0; j < 4; ++j) { const int n = (lane >> 3) + 8 * j; const LAS float* s = scr + (8 * c) * 33 + n;
        v4u o; o.x = pk2(s[0 * 33], s[1 * 33]); o.y = pk2(s[2 * 33], s[3 * 33]); o.z = pk2(s[4 * 33], s[5 * 33]); o.w = pk2(s[6 * 33], s[7 * 33]);
        *(GAS v4u*)(WT + (size_t)(row_off + n0 + n) * K + k0 + 8 * c) = o; }
    LDS_WAIT(); asm volatile("" ::: "memory");
}
struct P0Args { const float *x, *w_in, *w_a, *w_b, *w_out, *sg_w, *w_gate, *w_up, *w_down; bf16 *win_t, *wa_t, *wb_t, *wo_t, *sgw, *wgu_t, *wd_t, *xb; };
__device__ __forceinline__ void p0_prologue(const P0Args& a, LAS unsigned char* lds, int gw, int NGW, int wave, int lane) {
    LAS float* scr = (LAS float*)(lds + RING_OFF + wave * 16384);
    constexpr int I_IN = (D / 64) * (INW / 32), I_A = (GW / 64) * (D / 32), I_B = (D / 64) * (D / 32), I_O = I_B;
    constexpr int I_G1 = (D / 64) * (EHID / 32), I_G = NEXP * I_G1, I_D1 = (EHID / 64) * (D / 32), I_DN = NEXP * I_D1;
    constexpr int NITEMS = I_IN + I_A + I_B + I_O + 2 * I_G + I_DN;
    for (int it = gw; it < NITEMS; it += NGW) {
        int r = it;
        if (r < I_IN) { p0_transpose_item(a.w_in, D, INW, a.win_t, 0, scr, r, lane); continue; } r -= I_IN;
        if (r < I_A) { p0_transpose_item(a.w_a, GW, D, a.wa_t, 0, scr, r, lane); continue; } r -= I_A;
        if (r < I_B) { p0_transpose_item(a.w_b, D, D, a.wb_t, 0, scr, r, lane); continue; } r -= I_B;
        if (r < I_O) { p0_transpose_item(a.w_out, D, D, a.wo_t, 0, scr, r, lane); continue; } r -= I_O;
        if (r < 2 * I_G) {
            const int which = r >= I_G; if (which) r -= I_G;
            const int e = r / I_G1, item = r % I_G1, nb = item % (EHID / 32), n0 = nb * 32, ct = n0 >> 7;
            const int row_off = e * 1024 + ct * 128 + which * 128;
            p0_transpose_item((which ? a.w_up : a.w_gate) + (size_t)e * D * EHID, D, EHID, a.wgu_t, row_off, scr, item, lane); continue; }
        r -= 2 * I_G;
        { const int e = r / I_D1, item = r % I_D1; p0_transpose_item(a.w_down + (size_t)e * EHID * D, EHID, D, a.wd_t, e * 1024, scr, item, lane); }
    }
    for (int idx = gw * 64 + lane; idx < 8 * 128 * 128; idx += NGW * 64) { const int s = idx & 127, t = (idx >> 7) & 127; const float w = a.sg_w[idx]; a.sgw[idx] = (bf16)f2bf(((t >> 6) >= (s >> 6)) ? w : 0.f); }
    const size_t n8 = (size_t)T * D / 8;
    for (size_t idx = (size_t)gw * 64 + lane; idx < n8; idx += (size_t)NGW * 64) { const f32x4 v0 = *(const GAS f32x4*)(a.x + idx * 8), v1 = *(const GAS f32x4*)(a.x + idx * 8 + 4);
        v4u o; o.x = pk2(v0.x, v0.y); o.y = pk2(v0.z, v0.w); o.z = pk2(v1.x, v1.y); o.w = pk2(v1.z, v1.w); *(GAS v4u*)(a.xb + idx * 8) = o; }
}

__device__ __forceinline__ void p2_knorm(const bf16* KB, float* kn2, int gw, int NGW, int lane) {
    for (int it = gw; it < BATCH * NHEAD * 2 * 128; it += NGW) {
        const int t = it & 127, c = (it >> 7) & 1, h = (it >> 8) & 7, b = it >> 11;
        const GAS v4u* kp = (const GAS v4u*)(KB + ((size_t)b * SEQ + (size_t)t * 64 + lane) * D + h * 128 + c * 64);
        float s = 0.f;
#pragma unroll
        for (int q = 0; q < 8; ++q) { const v4u w = kp[q];
#pragma unroll
            for (int e = 0; e < 4; ++e) { const float x = __uint_as_float(w[e] << 16), y = __uint_as_float(w[e] & 0xffff0000u); s = fmaf(x, x, s); s = fmaf(y, y, s); } }
#pragma unroll
        for (int o = 1; o < 64; o <<= 1) s = fmaxf(s, __shfl_xor(s, o));
        if (lane == 0) kn2[it] = s;
    }
}

__device__ __forceinline__ void p3_pmx(const float* kn2, float* pmx, int gw, int lane) {
    if (gw < BATCH * NHEAD * 2) {
        float a = kn2[gw * 128 + lane], b2 = kn2[gw * 128 + 64 + lane];
#pragma unroll
        for (int off = 1; off < 64; off <<= 1) { const float ta = __shfl_up(a, off), tb = __shfl_up(b2, off); if (lane >= off) { a = fmaxf(a, ta); b2 = fmaxf(b2, tb); } }
        const float tot = __shfl(a, 63); b2 = fmaxf(b2, tot);
        pmx[gw * 128 + lane] = sqrtf(a) * 1.001f; pmx[gw * 128 + 64 + lane] = sqrtf(b2) * 1.001f;
    }
}

constexpr int P2_PITCH = 136;
__device__ __forceinline__ void p2_gmlp(const bf16* UV, bf16* SG, const bf16* SGW, const float* ln_g, const float* ln_b, const float* sg_b, LAS unsigned char* lds, int G) {
    typedef float f32x2v __attribute__((ext_vector_type(2)));
    LAS bf16* vnT = (LAS bf16*)lds;
    LAS f32x2v* red = (LAS f32x2v*)(lds + 256 * P2_PITCH * 2);
    const int tid = threadIdx.x, lane = tid & 63, wave = __builtin_amdgcn_readfirstlane(tid >> 6), fr = lane & 15, fq = lane >> 4;
    for (int unit = blockIdx.x; unit < 1024; unit += G) {
        const int blk = unit >> 1, half = unit & 1, row0 = blk * 128;
        const int s = tid & 127, cg = __builtin_amdgcn_readfirstlane(tid >> 7);
        const bf16* vrow = UV + (size_t)(row0 + s) * 1024 + 512;
        float s1 = 0.f, s2 = 0.f;
#pragma unroll
        for (int q = 0; q < 16; ++q) { const v4u w = *(const GAS v4u*)(vrow + cg * 128 + q * 8);
#pragma unroll
            for (int e = 0; e < 4; ++e) { const float a = __uint_as_float(w[e] << 16), b = __uint_as_float(w[e] & 0xffff0000u); s1 += a + b; s2 += a * a + b * b; } }
        red[cg * 128 + s] = (f32x2v){s1, s2};
        __syncthreads();
        float t1 = 0.f, t2 = 0.f;
#pragma unroll
        for (int k = 0; k < 4; ++k) { const f32x2v p = red[k * 128 + s]; t1 += p.x; t2 += p.y; }
        const float mean = t1 * (1.f / 512.f), var = fmaxf(t2 * (1.f / 512.f) - mean * mean, 0.f), rstd = 1.0f / sqrtf(var + LN_EPS);
        const int g = half * 4 + cg;
#pragma unroll
        for (int q = 0; q < 8; ++q) { const v4u w = *(const GAS v4u*)(vrow + g * 64 + q * 8);
#pragma unroll
            for (int e = 0; e < 4; ++e) { const int c0 = q * 8 + 2 * e;
                const float a = (__uint_as_float(w[e] << 16) - mean) * rstd * ln_g[g * 64 + c0] + ln_b[g * 64 + c0];
                const float b = (__uint_as_float(w[e] & 0xffff0000u) - mean) * rstd * ln_g[g * 64 + c0 + 1] + ln_b[g * 64 + c0 + 1];
                vnT[(cg * 64 + c0) * P2_PITCH + s] = (bf16)f2bf(a); vnT[(cg * 64 + c0 + 1) * P2_PITCH + s] = (bf16)f2bf(b); } }
        __syncthreads();
        const int gl = wave >> 1, th = wave & 1, gg = half * 4 + gl;
        f32x4 acc[4][4];
#pragma unroll
        for (int a = 0; a < 4; ++a)
#pragma unroll
            for (int b = 0; b < 4; ++b) acc[a][b] = (f32x4){0.f, 0.f, 0.f, 0.f};
        const int nks = th ? 4 : 2;
        for (int ks = 0; ks < nks; ++ks) {
            bf16x8 wf[4], vf[4];
#pragma unroll
            for (int tt = 0; tt < 4; ++tt) wf[tt] = *(const GAS bf16x8*)(SGW + ((size_t)(gg * 128 + th * 64 + tt * 16 + fr) * 128 + ks * 32 + fq * 8));
#pragma unroll
            for (int ct = 0; ct < 4; ++ct) vf[ct] = *(const LAS bf16x8*)(vnT + (gl * 64 + 32 * (ct >> 1) + 8 * (fr >> 2) + 4 * (ct & 1) + (fr & 3)) * P2_PITCH + ks * 32 + fq * 8);
#pragma unroll
            for (int tt = 0; tt < 4; ++tt)
#pragma unroll
                for (int ct = 0; ct < 4; ++ct) acc[tt][ct] = __builtin_amdgcn_mfma_f32_16x16x32_bf16(vf[ct], wf[tt], acc[tt][ct], 0, 0, 0);
        }
#pragma unroll
        for (int tt = 0; tt < 4; ++tt) { const int t = th * 64 + tt * 16 + fr; const float bs = sg_b[gg * 128 + t];
#pragma unroll
            for (int cp = 0; cp < 2; ++cp) { const int c0 = gg * 64 + 32 * cp + 8 * fq;
                const v4u uw = *(const GAS v4u*)(UV + (size_t)(row0 + t) * 1024 + c0);
                const f32x4 a = acc[tt][2 * cp], b = acc[tt][2 * cp + 1];
                v4u o;
                o.x = pk2(__uint_as_float(uw.x << 16) * (a[0] + bs), __uint_as_float(uw.x & 0xffff0000u) * (a[1] + bs));
                o.y = pk2(__uint_as_float(uw.y << 16) * (a[2] + bs), __uint_as_float(uw.y & 0xffff0000u) * (a[3] + bs));
                o.z = pk2(__uint_as_float(uw.z << 16) * (b[0] + bs), __uint_as_float(uw.z & 0xffff0000u) * (b[1] + bs));
                o.w = pk2(__uint_as_float(uw.w << 16) * (b[2] + bs), __uint_as_float(uw.w & 0xffff0000u) * (b[3] + bs));
                *(GAS v4u*)(SG + (size_t)(row0 + t) * 512 + c0) = o; } }
        __syncthreads();
    }
}

typedef float f32x2v __attribute__((ext_vector_type(2)));
constexpr int P7_WPITCH = 52;
__device__ __forceinline__ void p7_ln_route(const float* H, const float* part, float* stats, bf16* H1B, const float* ln_g, const float* ln_b, const float* w_group, const float* b_group, const float* w_expert, const float* b_expert,
                                            int* list_tok, float* list_w, unsigned* cnt, LAS unsigned char* lds, int G, bool dry = false) {
    constexpr int WLB = 256 * P7_WPITCH * 4;
    LAS float* WL0 = (LAS float*)lds;
    LAS float* LG = (LAS float*)(lds + 2 * WLB);
    LAS unsigned* hist = (LAS unsigned*)(lds + 2 * WLB + 8 * 16 * 48 * 4);
    LAS unsigned* ebase = hist + 32;
    LAS float* LNG = (LAS float*)(lds + 2 * WLB + 8 * 16 * 48 * 4 + 256);
    LAS float* LBI = LNG + 2 * D;
    static_assert(2 * WLB + 8 * 16 * 48 * 4 + 256 + 2 * D * 4 + 256 <= RING_BYTES, "P7 LDS map");
    const int tid = threadIdx.x, lane = tid & 63, wave = __builtin_amdgcn_readfirstlane(tid >> 6), li = lane & 15, kq = lane >> 4;
    if (tid < 32) hist[tid] = 0u;
    for (int i = tid; i < 2 * 256 * 3; i += NTHREADS) *(LAS f32x4*)(WL0 + (i / 3) * P7_WPITCH + 36 + 4 * (i % 3)) = (f32x4){0.f, 0.f, 0.f, 0.f};
    for (int i = tid; i < D / 4; i += NTHREADS) { ((LAS f32x4*)LNG)[i] = ((const GAS f32x4*)ln_g)[i]; ((LAS f32x4*)(LNG + D))[i] = ((const GAS f32x4*)ln_b)[i]; }
    if (tid < 4) LBI[tid] = b_group[tid]; else if (tid < 36) LBI[tid] = b_expert[tid - 4];
#define P7_WLOAD(we, wg, ch_) do { _Pragma("unroll") for (int q = 0; q < 4; ++q) we[q] = *((const GAS f32x4*)(w_expert + (size_t)(ch_) * 256 * 32) + tid + q * NTHREADS); \
        wg = (f32x4){0.f, 0.f, 0.f, 0.f}; if (tid < 256) wg = *((const GAS f32x4*)(w_group + (size_t)(ch_) * 256 * 4) + tid); } while (0)
#define P7_WSTORE(we, wg, buf) do { LAS float* W_ = WL0 + (buf) * (WLB / 4); _Pragma("unroll") for (int q = 0; q < 4; ++q) { const int f = (tid + q * NTHREADS) * 4, kl = f >> 5, n = f & 31; *(LAS f32x4*)(W_ + kl * P7_WPITCH + 4 + n) = we[q]; } \
        if (tid < 256) *(LAS f32x4*)(W_ + tid * P7_WPITCH) = wg; } while (0)
#define P7_VLOAD(vv, hrow_, ch_) do { _Pragma("unroll") for (int g = 0; g < 8; ++g) { vv[2 * g] = *(const GAS f32x4*)((hrow_) + (ch_) * 256 + 32 * g); vv[2 * g + 1] = *(const GAS f32x4*)((hrow_) + (ch_) * 256 + 32 * g + 4); } } while (0)
    f32x4 vc[16], we[4], wg;
    const int rd0 = blockIdx.x;
    if (rd0 < T / 128) { P7_WLOAD(we, wg, 0); P7_VLOAD(vc, H + (size_t)(rd0 * 128 + wave * 16 + li) * D + 8 * kq, 0); P7_WSTORE(we, wg, 0); }
    __syncthreads();
    for (int rd = blockIdx.x; rd < T / 128; rd += G) {
        const int R0 = rd * 128 + wave * 16;
        const float* hrow = H + (size_t)(R0 + li) * D + 8 * kq;
        const int rdn = (rd + G < T / 128) ? rd + G : rd;
        const float* hrown = H + (size_t)(rdn * 128 + wave * 16 + li) * D + 8 * kq;
        float s1 = 0.f, s2 = 0.f;
        { const f32x4 pa = *(const GAS f32x4*)(part + (size_t)(R0 + li) * 32 + kq * 8), pb = *(const GAS f32x4*)(part + (size_t)(R0 + li) * 32 + kq * 8 + 4);
          s1 = (pa.x + pa.z) + (pb.x + pb.z); s2 = (pa.y + pa.w) + (pb.y + pb.w); }
        s1 += __shfl_xor(s1, 16); s1 += __shfl_xor(s1, 32); s2 += __shfl_xor(s2, 16); s2 += __shfl_xor(s2, 32);
        const float mean = s1 * (1.f / D), var = fmaxf(s2 * (1.f / D) - mean * mean, 0.f), rstd = 1.0f / sqrtf(var + LN_EPS);
        if (kq == 0) *(GAS f32x2v*)(stats + (size_t)(R0 + li) * 2) = (f32x2v){mean, rstd};
        f32x4 acc[3];
#pragma unroll
        for (int n = 0; n < 3; ++n) acc[n] = (f32x4){0.f, 0.f, 0.f, 0.f};
#pragma unroll 1
        for (int ch = 0; ch < 4; ++ch) {
            f32x4 vn[16];
            P7_WLOAD(we, wg, (ch + 1) & 3); P7_VLOAD(vn, (ch == 3) ? hrown : hrow, (ch + 1) & 3);
            __builtin_amdgcn_sched_barrier(0);
            const LAS float* W = WL0 + (ch & 1) * (WLB / 4);
#pragma unroll
            for (int g = 0; g < 8; ++g) { const int cl = 32 * g + 8 * kq, col = ch * 256 + cl;
                float wv[24];
#pragma unroll
                for (int e8 = 0; e8 < 8; ++e8)
#pragma unroll
                    for (int n = 0; n < 3; ++n) wv[e8 * 3 + n] = W[(cl + e8) * P7_WPITCH + li + 16 * n];
                __builtin_amdgcn_sched_barrier(0);
                float h[8];
#pragma unroll
                for (int q = 0; q < 2; ++q) { const f32x4 v = vc[2 * g + q]; const f32x4 gv = *(const LAS f32x4*)(LNG + col + 4 * q), bv = *(const LAS f32x4*)(LNG + D + col + 4 * q);
                    h[4 * q] = (v.x - mean) * rstd * gv.x + bv.x; h[4 * q + 1] = (v.y - mean) * rstd * gv.y + bv.y; h[4 * q + 2] = (v.z - mean) * rstd * gv.z + bv.z; h[4 * q + 3] = (v.w - mean) * rstd * gv.w + bv.w; }
                v4u o; o.x = pk2(h[0], h[1]); o.y = pk2(h[2], h[3]); o.z = pk2(h[4], h[5]); o.w = pk2(h[6], h[7]); *(GAS v4u*)(H1B + (size_t)(R0 + li) * D + col) = o;
#pragma unroll
                for (int e8 = 0; e8 < 8; ++e8)
#pragma unroll
                    for (int n = 0; n < 3; ++n) acc[n] = __builtin_amdgcn_mfma_f32_16x16x4f32(h[e8], wv[e8 * 3 + n], acc[n], 0, 0, 0); }
            __builtin_amdgcn_sched_barrier(0);
            P7_WSTORE(we, wg, (ch + 1) & 1);
#pragma unroll
            for (int q = 0; q < 16; ++q) vc[q] = vn[q];
            __syncthreads();
        }
        LAS float* lg = LG + wave * 16 * 48;
#pragma unroll
        for (int n = 0; n < 3; ++n)
#pragma unroll
            for (int r = 0; r < 4; ++r) lg[(4 * kq + r) * 48 + 16 * n + li] = acc[n][r];
        LDS_WAIT(); asm volatile("" ::: "memory");
        int e0 = 0, e1 = 0; unsigned r0 = 0u, r1 = 0u; float wt0 = 0.f, wt1 = 0.f;
        if (lane < 16) {
            const LAS float* l = lg + lane * 48;
            float gl[4]; int gs = 0; float gm;
#pragma unroll
            for (int q = 0; q < 4; ++q) gl[q] = l[q] + LBI[q];
            gm = gl[0];
#pragma unroll
            for (int q = 1; q < 4; ++q) if (gl[q] > gm) { gm = gl[q]; gs = q; }
            float den = 0.f;
#pragma unroll
            for (int q = 0; q < 4; ++q) den += __expf(gl[q] - gm);
            const float gwt = 1.0f / den;
            float ev[8];
#pragma unroll
            for (int q = 0; q < 8; ++q) ev[q] = l[4 + gs * 8 + q] + LBI[4 + gs * 8 + q];
            int i0 = 0; float v0 = ev[0];
#pragma unroll
            for (int q = 1; q < 8; ++q) if (ev[q] > v0) { v0 = ev[q]; i0 = q; }
            int i1 = -1; float v1 = -3.0e38f;
#pragma unroll
            for (int q = 0; q < 8; ++q) if (q != i0 && ev[q] > v1) { v1 = ev[q]; i1 = q; }
            const float ex = __expf(v1 - v0), p0 = 1.0f / (1.0f + ex), p1 = ex * p0;
            e0 = gs * 8 + i0; e1 = gs * 8 + i1; wt0 = p0 * gwt; wt1 = p1 * gwt;
            r0 = __hip_atomic_fetch_add(&hist[e0], 1u, __ATOMIC_RELAXED, __HIP_MEMORY_SCOPE_WORKGROUP); r1 = __hip_atomic_fetch_add(&hist[e1], 1u, __ATOMIC_RELAXED, __HIP_MEMORY_SCOPE_WORKGROUP);
        }
        __syncthreads();
        if (tid < 32) { const unsigned n = hist[tid]; hist[tid] = 0u; ebase[tid] = (n && !dry) ? __hip_atomic_fetch_add(cnt + tid, n, RLX_AGENT) : 0u; }
        __syncthreads();
        if (lane < 16 && !dry) { const int tok = R0 + lane;
            const size_t s0 = (size_t)e0 * MOE_CAP + ebase[e0] + r0, s1 = (size_t)e1 * MOE_CAP + ebase[e1] + r1;
            list_tok[s0] = tok * 2; list_w[s0] = wt0; list_tok[s1] = tok * 2 + 1; list_w[s1] = wt1; }
    }
}

#undef P7_WLOAD
#undef P7_WSTORE
#undef P7_VLOAD
__device__ __forceinline__ void p11_final(float* H, const bf16* H1, const bf16* FFN, const float* ln_g, const float* ln_b, int gw, int NGW, int lane) {
    f32x4 G4[4], B4[4];
#pragma unroll
    for (int j = 0; j < 4; ++j) { G4[j] = *((const GAS f32x4*)ln_g + lane + 64 * j); B4[j] = *((const GAS f32x4*)ln_b + lane + 64 * j); }
    v2u nh[4], na[4], nb[4];
    if (gw < T) {
        const GAS v2u* hp = (const GAS v2u*)(H1 + (size_t)gw * D) + lane; const GAS v2u* f0 = (const GAS v2u*)(FFN + (size_t)(2 * gw) * D) + lane; const GAS v2u* f1 = (const GAS v2u*)(FFN + (size_t)(2 * gw + 1) * D) + lane;
#pragma unroll
        for (int j = 0; j < 4; ++j) { nh[j] = hp[64 * j]; na[j] = f0[64 * j]; nb[j] = f1[64 * j]; }
    }
    for (int m = gw; m < T; m += NGW) {
        GAS f32x4* hr = (GAS f32x4*)(H + (size_t)m * D) + lane;
        v2u ch[4], ca[4], cb[4];
#pragma unroll
        for (int j = 0; j < 4; ++j) { ch[j] = nh[j]; ca[j] = na[j]; cb[j] = nb[j]; }
        { const int mn = (m + NGW < T) ? m + NGW : m;
          const GAS v2u* hp = (const GAS v2u*)(H1 + (size_t)mn * D) + lane; const GAS v2u* f0 = (const GAS v2u*)(FFN + (size_t)(2 * mn) * D) + lane; const GAS v2u* f1 = (const GAS v2u*)(FFN + (size_t)(2 * mn + 1) * D) + lane;
#pragma unroll
          for (int j = 0; j < 4; ++j) { nh[j] = hp[64 * j]; na[j] = f0[64 * j]; nb[j] = f1[64 * j]; } }
        f32x4 v[4]; float s = 0.f;
#pragma unroll
        for (int j = 0; j < 4; ++j) { const v2u hb = ch[j]; const v2u a = ca[j], b = cb[j];
            v[j].x = __uint_as_float(hb.x << 16) * ALPHA + (__uint_as_float(a.x << 16) + __uint_as_float(b.x << 16)); v[j].y = __uint_as_float(hb.x & 0xffff0000u) * ALPHA + (__uint_as_float(a.x & 0xffff0000u) + __uint_as_float(b.x & 0xffff0000u));
            v[j].z = __uint_as_float(hb.y << 16) * ALPHA + (__uint_as_float(a.y << 16) + __uint_as_float(b.y << 16)); v[j].w = __uint_as_float(hb.y & 0xffff0000u) * ALPHA + (__uint_as_float(a.y & 0xffff0000u) + __uint_as_float(b.y & 0xffff0000u));
            s += (v[j].x + v[j].y) + (v[j].z + v[j].w); }
        const float mean = wave_sum(s) * (1.f / D); float s2 = 0.f;
#pragma unroll
        for (int j = 0; j < 4; ++j) { v[j] = v[j] - mean; s2 += (v[j].x * v[j].x + v[j].y * v[j].y) + (v[j].z * v[j].z + v[j].w * v[j].w); }
        const float rstd = 1.f / sqrtf(wave_sum(s2) * (1.f / D) + LN_EPS);
#pragma unroll
        for (int j = 0; j < 4; ++j) { const f32x4 g = G4[j], b = B4[j];
            f32x4 o; o.x = v[j].x * rstd * g.x + b.x; o.y = v[j].y * rstd * g.y + b.y; o.z = v[j].z * rstd * g.z + b.z; o.w = v[j].w * rstd * g.w + b.w; hr[64 * j] = o; }
    }
}
#ifndef PROBE_SHORT_UNITS
#define PROBE_SHORT_UNITS 0
#endif

enum { I_X = 0, I_WIN, I_BIN, I_SGLNG, I_SGLNB, I_SGW, I_SGB, I_WA, I_LQ1, I_LK1, I_LQ2, I_LK2, I_SUBLN, I_WB, I_WOUT, I_LN1G, I_LN1B, I_WGRP, I_BGRP, I_WEXP, I_BEXP, I_WGATE, I_WUP, I_WDOWN, I_LN2G, I_LN2B, N_IN };
struct Args { const float* in[N_IN]; float* out; unsigned char* ws; int ph_lo, ph_hi, dummy, li; };
static_assert(sizeof(Args) == (N_IN + 2) * 8 + 16, "no padding bytes in Args");

__device__ __forceinline__ const float* karg_ptr(int k) {
    const __attribute__((address_space(4))) unsigned long long* p = (const __attribute__((address_space(4))) unsigned long long*)__builtin_amdgcn_kernarg_segment_ptr();
    asm volatile("" : "+s"(p));
    return (const float*)p[k];
}
#define KARG(k) karg_ptr(k)
__device__ __forceinline__ int fresh_lane() { int t = threadIdx.x; asm volatile("" : "+v"(t)); return t & 63; }
__global__ void __launch_bounds__(NTHREADS, 2) mk_fwd(Args args) {
    extern __shared__ __attribute__((aligned(16))) unsigned char lds[];
    LAS unsigned char* L = (LAS unsigned char*)lds;
    volatile LAS unsigned* MISC = (volatile LAS unsigned*)(L + MISC_OFF);
    const int tid = threadIdx.x, wave = __builtin_amdgcn_readfirstlane(tid >> 6);
#define lane fresh_lane()
    const int G = gridDim.x; const int bx = blockIdx.x; const int vcu = (G % 8 == 0) ? (bx % 8) * (G / 8) + bx / 8 : bx;
    unsigned char* ws = args.ws;
    gu32* ctl = (gu32*)(ws + WS_CTL);
    for (int u = tid; u < (LDS_BYTES - LDSCTL_OFF) / 4; u += NTHREADS) ((LAS unsigned*)(L + LDSCTL_OFF))[u] = 0u;
    __syncthreads();
    XcdBarrier bar; bar.bar = (unsigned*)(ctl + CW_BAR) + args.li * XCD_BAR_WORDS; bar.x = 0; bar.st = nullptr;
#if MK_ONE_LAUNCH
    bar = xcd_barrier_post((unsigned*)(ctl + CW_BAR) + args.li * XCD_BAR_WORDS, MISC + 8);
#define GRID_BAR() xcd_barrier(bar)
#else
#define GRID_BAR() do {} while (0)
#endif
    const int lo = args.ph_lo, hi = args.ph_hi;
#ifndef MK_PHASE_MASK
#define MK_PHASE_MASK 0xFFF
#endif
#define IN(k) (((MK_PHASE_MASK >> (k)) & 1) && lo <= (k) && (k) < hi)
#define BOTH(k) (IN(k) && IN((k) + 1))
#define CHAIN_SYNC() do { asm volatile("s_waitcnt vmcnt(0)" ::: "memory"); __syncthreads(); \
        if (tid == 0) { __builtin_amdgcn_fence(__ATOMIC_ACQUIRE, "agent"); asm volatile("s_waitcnt vmcnt(0)" ::: "memory"); } __syncthreads(); } while (0)
#define SEAM(k, chained) do { if (BOTH(k)) { if (chained) CHAIN_SYNC(); else GRID_BAR(); } } while (0)
    const bool dummy = args.dummy != 0;
    const int gw = vcu * NWAVES + wave, NGW = G * NWAVES;
    bf16* win_t = (bf16*)(ws + WS_WIN); bf16* wa_t = (bf16*)(ws + WS_WA); bf16* wb_t = (bf16*)(ws + WS_WB); bf16* wo_t = (bf16*)(ws + WS_WO);
    bf16* sgw = (bf16*)(ws + WS_SGW); bf16* wgu_t = (bf16*)(ws + WS_WGU); bf16* wd_t = (bf16*)(ws + WS_WD);
    bf16* XB = (bf16*)(ws + WS_XB); bf16* QB = (bf16*)(ws + WS_Q); bf16* KB = (bf16*)(ws + WS_K); bf16* VB = (bf16*)(ws + WS_VAL); bf16* GA = (bf16*)(ws + WS_GA); bf16* GB = (bf16*)(ws + WS_GB);
    bf16* XS = (bf16*)(ws + WS_XS); bf16* HB = (bf16*)(ws + WS_HB); bf16* FFN = (bf16*)(ws + WS_FFN);
    bf16* UV = (bf16*)((unsigned char*)args.out + OUT_UV); bf16* SG = (bf16*)((unsigned char*)args.out + OUT_SG);
    int* list_tok = (int*)(ws + WS_LIST_TOK); float* list_w = (float*)(ws + WS_LIST_W);
    float* kn2 = (float*)(ws + WS_KN2); float* pmx = (float*)(ws + WS_PMX);

    if (IN(0)) {
        P0Args a{KARG(I_X), KARG(I_WIN), KARG(I_WA), KARG(I_WB), KARG(I_WOUT), KARG(I_SGW), KARG(I_WGATE), KARG(I_WUP), KARG(I_WDOWN), win_t, wa_t, wb_t, wo_t, sgw, wgu_t, wd_t, XB};
        p0_prologue(a, L, gw, NGW, wave, lane);
        if (BOTH(0)) GRID_BAR();
    }
    if (IN(1)) {
        pg8::Gemm g{XB, win_t, T, INW, D}; pg8::StaticOrder S; S.init(T, INW, G, bx);
        LAS float* lbias = (LAS float*)(L + RING_OFF + MOE_LDS_OFF);
        { const float* bin = KARG(I_BIN); for (int i = tid; i < INW / 4; i += NTHREADS) ((LAS f32x4*)lbias)[i] = ((const f32x4*)bin)[i]; }
        __syncthreads();
        pg8::EpiInProj E{UV, QB, (size_t)(WS_K - WS_Q) / 2, lbias, C2};
        pg8::gemm_phase<pg8::EpiInProj, pg8::StaticOrder, true, true>(L + RING_OFF, g, S, E);
        if (BOTH(1)) GRID_BAR();
    }
    if (IN(2)) {
        p2_knorm(KB, kn2, gw, NGW, lane);
        p2_gmlp(UV, SG, sgw, KARG(I_SGLNG), KARG(I_SGLNB), KARG(I_SGB), L, G);
        if (BOTH(2)) GRID_BAR();
    }
    if (IN(3)) {
        pg8::Gemm g{SG, wa_t, T, D, GW}; pg8::StaticOrder S; S.init(T, D, G, bx);
        pg8::EpiGateMix<0> E{GA, nullptr, dummy ? XB : GA};
        pg8::gemm_phase<pg8::EpiGateMix<0>, pg8::StaticOrder, true, true>(L + RING_OFF, g, S, E);
    }
    if (IN(4)) {
        float lam;
        { const float a = KARG(I_LQ1)[lane] * KARG(I_LK1)[lane], b = KARG(I_LQ2)[lane] * KARG(I_LK2)[lane];
          lam = __expf(wave_sum(a)) - __expf(wave_sum(b)) + 0.2f; lam = __uint_as_float(__builtin_amdgcn_readfirstlane(__float_as_uint(lam))); }
        unsigned* aq = (unsigned*)(ctl + CW_AQ) + args.li * 512;
        int q = (int)(((long)vcu * 8) / G) & 7, tries = 0;
        if (tid == 0) *(LAS unsigned*)(L + RING_OFF + att::LDS_NXT) = __hip_atomic_fetch_add(aq + 64 * q, 1u, RLX_AGENT);
        __syncthreads();
        int item = (int)__builtin_amdgcn_readfirstlane(*(LAS unsigned*)(L + RING_OFF + att::LDS_NXT));
        __syncthreads();
        for (;;) {
            while (item >= 512 && tries < 7) { ++tries; q = (q + 1) & 7;
                if (tid == 0) *(LAS unsigned*)(L + RING_OFF + att::LDS_NXT) = __hip_atomic_fetch_add(aq + 64 * q, 1u, RLX_AGENT);
                __syncthreads();
                item = (int)__builtin_amdgcn_readfirstlane(*(LAS unsigned*)(L + RING_OFF + att::LDS_NXT));
                __syncthreads(); }
            if (item >= 512) break;
            const int rnd = item >> 6, i = 63 - (item & 63), h = 7 - rnd, b = (q + rnd) & 7;
#define UNI_F(x) __uint_as_float(__builtin_amdgcn_readfirstlane(__float_as_uint(x)))
            const float slope2 = UNI_F(exp2f(-(float)(h + 1)) * 1.4426950408889634f);
            float u[16];
#pragma unroll
            for (int r = 0; r < 16; ++r) u[r] = __uint_as_float(__builtin_amdgcn_readfirstlane(__float_as_uint(exp2f(slope2 * (float)((r & 3) + 8 * (r >> 2))))));
            const float w4 = UNI_F(exp2f(slope2 * 4.0f)), w32 = UNI_F(exp2f(slope2 * 32.0f));
            const bf16* Kh = KB + (size_t)b * SEQ * D + h * 128; const bf16* Vh = VB + (size_t)b * SEQ * D + h * 128;
            bf16* Qb = QB + ((size_t)b * SEQ + (size_t)i * 128) * D + h * 128;
            bf16* Ob = dummy ? XB + ((size_t)b * SEQ + (size_t)i * 128) * D + h * 128 : Qb;
            item = att::attn_unit(Qb, Kh, Vh, Ob, PROBE_SHORT_UNITS && dummy ? 0 : i, slope2, u, w4, w32, lam, KARG(I_SUBLN), kn2 + (size_t)(b * 8 + h) * 256, aq + 64 * q, (char*)lds + RING_OFF, PROBE_SHORT_UNITS && dummy ? PROBE_SHORT_UNITS : 0);
        }
        if (BOTH(4)) GRID_BAR();
    }
    if (IN(5)) {
        pg8::Gemm g{QB, wb_t, T, D, D}; pg8::StaticOrder S; S.init(T, D, G, bx);
        pg8::EpiGateMix<1> E{GA, GB, dummy ? XB : GA};
        pg8::gemm_phase<pg8::EpiGateMix<1>, pg8::StaticOrder, true, true>(L + RING_OFF, g, S, E);
        SEAM(5, false);
    }
    if (IN(6)) {
        pg8::Gemm g{GA, wo_t, T, D, D}; pg8::StaticOrder S; S.init(T, D, G, bx);
        pg8::EpiResid E{KARG(I_X), args.out, ALPHA, (pg8::f32x2*)(ws + WS_PART)};
        pg8::gemm_phase<pg8::EpiResid, pg8::StaticOrder, true, true>(L + RING_OFF, g, S, E);
        SEAM(6, false);
    }
    if (IN(7)) {
        p7_ln_route(args.out, (const float*)(ws + WS_PART), (float*)(ws + WS_STATS), XB, KARG(I_LN1G), KARG(I_LN1B), KARG(I_WGRP), KARG(I_BGRP), KARG(I_WEXP), KARG(I_BEXP), list_tok, list_w, (unsigned*)(ctl + CW_CNT), L, G, dummy);
        if (BOTH(7)) GRID_BAR();
    }
    if (IN(9)) {
        LAS int* ml = (LAS int*)(L + RING_OFF + MOE_LDS_OFF);
        const int ntiles = pg8::MoeOrder<true>::prime((const unsigned*)(ctl + CW_CNT), list_tok, list_w, MOE_CAP, bx, ml + pg8::MOE_LDS_TE / 4, ml + pg8::MOE_LDS_TR / 4, ml + pg8::MOE_LDS_TB / 4, ml + pg8::MOE_LDS_SL / 4, (LAS int*)(MISC + 12), tid);
        pg8::Gemm g{XB, wgu_t, 0, 0, D}; pg8::MoeOrder<true> S{list_tok, list_w, ntiles, G, bx, ml + pg8::MOE_LDS_TE / 4, ml + pg8::MOE_LDS_TR / 4, ml + pg8::MOE_LDS_TB / 4, ml + pg8::MOE_LDS_SL / 4};
        pg8::EpiGateUp E{HB};
        pg8::gemm_phase<pg8::EpiGateUp, pg8::MoeOrder<true>, true, true>(L + RING_OFF, g, S, E);
        if (BOTH(9)) GRID_BAR();
    }
    if (IN(10)) {
        LAS int* ml = (LAS int*)(L + RING_OFF + MOE_LDS_OFF);
        const int ntiles = pg8::MoeOrder<false>::prime((const unsigned*)(ctl + CW_CNT), list_tok, list_w, MOE_CAP, bx, ml + pg8::MOE_LDS_TE / 4, ml + pg8::MOE_LDS_TR / 4, ml + pg8::MOE_LDS_TB / 4, ml + pg8::MOE_LDS_SL / 4, (LAS int*)(MISC + 12), tid);
        pg8::Gemm g{HB, wd_t, 0, 0, EHID}; pg8::MoeOrder<false> S{list_tok, list_w, ntiles, G, bx, ml + pg8::MOE_LDS_TE / 4, ml + pg8::MOE_LDS_TR / 4, ml + pg8::MOE_LDS_TB / 4, ml + pg8::MOE_LDS_SL / 4};
        pg8::EpiDown E{FFN, ml + pg8::MOE_LDS_TR / 4, ml + pg8::MOE_LDS_SL / 4};
        pg8::gemm_phase<pg8::EpiDown, pg8::MoeOrder<false>, true, true>(L + RING_OFF, g, S, E);
        if (BOTH(10)) GRID_BAR();
    }
    if (IN(11)) {
        p11_final(args.out, XB, FFN, KARG(I_LN2G), KARG(I_LN2B), gw, NGW, lane);
    }
#undef IN
#undef BOTH
#undef lane
}

extern "C" void kernel_launch(void* const* d_in, const int* in_sizes, int n_in, void* d_out, int out_size, void* d_ws, size_t ws_size, hipStream_t stream) {
    static int grid = 0;
    if (grid == 0) {
        if (n_in != N_IN || in_sizes[0] != T * D || out_size != T * D || ws_size < WS_END) {
            fprintf(stderr, "kernel_launch: shape mismatch: n_in %d in0 %d out %d ws %zu (need %zu)\n", n_in, n_in > 0 ? in_sizes[0] : -1, out_size, ws_size, (size_t)WS_END); grid = -1; return; }
        int dev = 0, cus = 0, per_cu = 0;
        if (hipGetDevice(&dev) != hipSuccess || hipDeviceGetAttribute(&cus, hipDeviceAttributeMultiprocessorCount, dev) != hipSuccess) { grid = -1; return; }
        if (hipFuncSetAttribute((const void*)mk_fwd, hipFuncAttributeMaxDynamicSharedMemorySize, LDS_BYTES) != hipSuccess) { fprintf(stderr, "kernel_launch: hipFuncSetAttribute failed\n"); grid = -1; return; }
        if (hipOccupancyMaxActiveBlocksPerMultiprocessor(&per_cu, (const void*)mk_fwd, NTHREADS, LDS_BYTES) != hipSuccess || per_cu < 1)
            fprintf(stderr, "kernel_launch: note: occupancy query reports %d workgroups per CU\n", per_cu);
        (void)hipGetLastError();
        grid = cus;
    }
    if (grid < 0) return;
    if (hipMemsetAsync((char*)d_ws + WS_CTL, 0, CTL_ZERO_BYTES, stream) != hipSuccess) { fprintf(stderr, "kernel_launch: memset failed\n"); return; }
    Args a{};
    for (int i = 0; i < N_IN; ++i) a.in[i] = (const float*)d_in[i];
    a.out = (float*)d_out; a.ws = (unsigned char*)d_ws;
#if MK_ONE_LAUNCH && MK_PROBE_PHASE >= 0
    a.ph_lo = 0; a.ph_hi = MK_PROBE_PHASE; a.li = 0; if (MK_PROBE_PHASE > 0) hipLaunchKernelGGL(mk_fwd, dim3(grid), dim3(NTHREADS), LDS_BYTES, stream, a);
    a.ph_lo = MK_PROBE_PHASE; a.ph_hi = MK_PROBE_PHASE + 1; a.li = 1; a.dummy = 1; hipLaunchKernelGGL(mk_fwd, dim3(grid), dim3(NTHREADS), LDS_BYTES, stream, a);
    a.ph_lo = MK_PROBE_PHASE; a.ph_hi = NPHASE; a.li = 2; a.dummy = 0; hipLaunchKernelGGL(mk_fwd, dim3(grid), dim3(NTHREADS), LDS_BYTES, stream, a);
#elif MK_ONE_LAUNCH
    a.ph_lo = 0; a.ph_hi = NPHASE;
    hipLaunchKernelGGL(mk_fwd, dim3(grid), dim3(NTHREADS), LDS_BYTES, stream, a);
#else
    for (int p = 0; p < NPHASE; ++p) { a.ph_lo = p; a.ph_hi = p + 1; hipLaunchKernelGGL(mk_fwd, dim3(grid), dim3(NTHREADS), LDS_BYTES, stream, a); }
#endif
    const hipError_t le = hipPeekAtLastError();
    if (le != hipSuccess) fprintf(stderr, "kernel_launch: launch failed: %s\n", hipGetErrorName(le));
}
```

```cpp
#include <hip/hip_runtime.h>
#include <cstdio>
#include <cstdint>
namespace pg8 {
#define PG8_LAS __attribute__((address_space(3)))
typedef unsigned short bf16_t;
typedef short bf16x8 __attribute__((ext_vector_type(8)));
typedef float f32x4 __attribute__((ext_vector_type(4)));
typedef unsigned u32x4 __attribute__((ext_vector_type(4)));
constexpr int BM = 256, BK = 64, HALF = 128, HTB = HALF * BK * 2  , STAGE_BYTES = 8 * HTB, NXCD = 8, WGM = 8;

__host__ __device__ __forceinline__ int lds_byte(int r, int c) { const int st = (r >> 4) * 2 + (c >> 5), rr = r & 15, cc = c & 31, ob = rr * 64 + cc * 2; return st * 1024 + (ob ^ (((ob >> 9) & 1) << 5)); }
__host__ __device__ __forceinline__ void stage_rc(int b, int& R, int& C) { const int st = b / 1024, sb = b % 1024, swz = sb ^ (((sb >> 9) & 1) << 5); R = (st >> 1) * 16 + swz / 64; C = (st & 1) * 32 + (swz % 64) / 2; }
__host__ __device__ __forceinline__ int perm32(int rho) { const int n = rho >> 4, i = rho & 15; return 8 * (i >> 2) + 4 * n + (i & 3); }

struct Unit { int pm, pn, sl; };
struct Gemm { const bf16_t* A; const bf16_t* Bt; int M, N, K; };

struct StaticOrder {
    int nM, nN, nwg, G, c;
    __host__ __device__ void init(int M, int N, int G_, int c_) { nM = M / BM; nN = N / BM; nwg = nM * nN; G = G_; c = c_; }
    __host__ __device__ bool next(int i, Unit& u) const {
        const long L = (long)i * G + c; if (L >= nwg) return false;
        int wgid = (int)L; { const int q = nwg / NXCD, r = nwg % NXCD, xcd = wgid % NXCD, off = wgid / NXCD; wgid = (xcd < r ? xcd * (q + 1) : r * (q + 1) + (xcd - r) * q) + off; }
        const int nig = WGM * nN, gid = wgid / nig, fm = gid * WGM, gsz = (nM - fm) < WGM ? (nM - fm) : WGM;
        u.pm = fm + ((wgid % nig) % gsz); u.pn = (wgid % nig) / gsz; return true;
    }
    __device__ __forceinline__ void a_ready(const Unit&) const {}
    __device__ __forceinline__ void done(const Unit&) const {}
    __device__ __forceinline__ void stage(const Unit&, int, int) const {}
    static constexpr bool GATHER = false;
    __device__ __forceinline__ unsigned arow(const Unit&, int) const { return 0u; }
};

struct RowOwnerOrder {
    int nM, nN, G, c;
    __host__ __device__ void init(int M, int N, int G_, int c_) { nM = M / BM; nN = N / BM; G = G_; c = c_; }
    __host__ __device__ bool next(int i, Unit& u) const { const int pm = c + (i / nN) * G; if (pm >= nM) return false; u.pm = pm; u.pn = i % nN; return true; }
    __device__ __forceinline__ void a_ready(const Unit&) const {}
    __device__ __forceinline__ void done(const Unit&) const {}
    __device__ __forceinline__ void stage(const Unit&, int, int) const {}
    static constexpr bool GATHER = false;
    __device__ __forceinline__ unsigned arow(const Unit&, int) const { return 0u; }
};
__device__ __forceinline__ unsigned cvt_pk_bf16(float lo, float hi) { unsigned r; asm volatile("v_cvt_pk_bf16_f32 %0, %1, %2" : "=v"(r) : "v"(lo), "v"(hi)); return r; }
typedef float f32x2 __attribute__((ext_vector_type(2)));
__device__ __forceinline__ f32x2 gelu_pk(f32x2 v) {
    const f32x2 av = __builtin_elementwise_abs(v), d = av * 0.2316418882f + 1.0f;
    f32x2 t; t.x = __builtin_amdgcn_rcpf(d.x); t.y = __builtin_amdgcn_rcpf(d.y);
    f32x2 q = t * 0.5307027145f + (-0.7265760135f); q = q * t + 0.7107068705f; q = q * t + (-0.142248368f); q = q * t + 0.127414796f; q = q * t;
    const f32x2 s = (v * v) * (-0.72134752044f);
    f32x2 e; e.x = __builtin_amdgcn_exp2f(s.x); e.y = __builtin_amdgcn_exp2f(s.y);
    const f32x2 m = v * (q * e), r = v - m;
    f32x2 o; o.x = v.x < 0.f ? m.x : r.x; o.y = v.y < 0.f ? m.y : r.y; return o;
}
typedef unsigned u32x2 __attribute__((ext_vector_type(2)));
__device__ __forceinline__ float bf_lo(unsigned w) { return __uint_as_float(w << 16); }
__device__ __forceinline__ float bf_hi(unsigned w) { return __uint_as_float(w & 0xffff0000u); }
__device__ __forceinline__ float sigmoid_f(float x) { return __builtin_amdgcn_rcpf(1.0f + __builtin_amdgcn_exp2f(-1.4426950408889634f * x)); }

struct EpiInProj {
    static constexpr bool PERM = true, AFTER_DRAIN = false; static constexpr int VMEM_MIN = 16;
    bf16_t* uv; bf16_t* g1; size_t gstride; const PG8_LAS float* bias; float qscale;
    __device__ __forceinline__ void operator()(const f32x4 (&acc)[2][2][4][2], const Unit& u, int wr, int wc, int fr, int fq) const {
        asm volatile("" : "+v"(fr), "+v"(fq));
        const int t = u.pn >> 2;
        bf16_t* base = (t == 0) ? uv : g1 + (size_t)(t - 1) * gstride;
        const int row0 = u.pm * BM + wr * 64 + fr;
        const int col0 = (u.pn & 3) * BM + wc * 32 + 8 * fq, bcol0 = u.pn * BM + wc * 32 + 8 * fq;
        const float sc = (t == 1) ? qscale : 1.0f;
#pragma unroll
        for (int bj = 0; bj < 2; ++bj) {
            const f32x4 bv0 = *(const PG8_LAS f32x4*)(bias + bcol0 + bj * HALF), bv1 = *(const PG8_LAS f32x4*)(bias + bcol0 + bj * HALF + 4);
#pragma unroll
        for (int ai = 0; ai < 2; ++ai)
#pragma unroll
            for (int m = 0; m < 4; ++m) { bf16_t* rowp = base + (size_t)(row0 + ai * HALF + m * 16) * 1024 + col0;
                { f32x4 v0 = acc[ai][bj][m][0] + bv0, v1 = acc[ai][bj][m][1] + bv1;
                    if (t == 0) { const f32x2 a = gelu_pk((f32x2){v0[0], v0[1]}), b = gelu_pk((f32x2){v0[2], v0[3]}); v0 = (f32x4){a.x, a.y, b.x, b.y}; __builtin_amdgcn_sched_barrier(0);
                        const f32x2 c = gelu_pk((f32x2){v1[0], v1[1]}), d = gelu_pk((f32x2){v1[2], v1[3]}); v1 = (f32x4){c.x, c.y, d.x, d.y}; }
                    else if (t >= 4) {
#pragma unroll
                        for (int e = 0; e < 4; ++e) { v0[e] = sigmoid_f(v0[e]); v1[e] = sigmoid_f(v1[e]); } }
                    else if (t == 3) {
                        const int h = (u.pn & 3) * 2 + bj; const float w = __builtin_amdgcn_exp2f(__builtin_amdgcn_exp2f(-(float)(h + 1)) * 1.4426950408889634f * (float)(16 * m + fr));
                        v0 = v0 * w; v1 = v1 * w; }
                    else { v0 = v0 * sc; v1 = v1 * sc; }
                    u32x4 w; w.x = cvt_pk_bf16(v0[0], v0[1]); w.y = cvt_pk_bf16(v0[2], v0[3]); w.z = cvt_pk_bf16(v1[0], v1[1]); w.w = cvt_pk_bf16(v1[2], v1[3]);
                    *(u32x4*)(rowp + bj * HALF) = w; } }
        }
    }
};

template <int MODE  > struct EpiGateMix {
    static constexpr bool PERM = true, AFTER_DRAIN = false; static constexpr int VMEM_MIN = MODE ? 40 : 24;
    const bf16_t* io; const bf16_t* g2; bf16_t* outp;
    __device__ __forceinline__ void operator()(const f32x4 (&acc)[2][2][4][2], const Unit& u, int wr, int wc, int fr, int fq) const {
        asm volatile("" : "+v"(fr), "+v"(fq));
        const int row0 = u.pm * BM + wr * 64 + fr, col0 = u.pn * BM + wc * 32 + 8 * fq;
#pragma unroll
        for (int ai = 0; ai < 2; ++ai) {
            u32x4 xi[4][2], xg[4][2];
#pragma unroll
            for (int m = 0; m < 4; ++m)
#pragma unroll
                for (int bj = 0; bj < 2; ++bj) { const size_t off = (size_t)(row0 + ai * HALF + m * 16) * 1024 + col0 + bj * HALF;
                    xi[m][bj] = *(const u32x4*)(io + off); if (MODE == 1) xg[m][bj] = *(const u32x4*)(g2 + off); }
            __builtin_amdgcn_sched_barrier(0);
#pragma unroll
            for (int m = 0; m < 4; ++m)
#pragma unroll
                for (int bj = 0; bj < 2; ++bj) { const size_t off = (size_t)(row0 + ai * HALF + m * 16) * 1024 + col0 + bj * HALF;
                    const f32x4 a0 = acc[ai][bj][m][0], a1 = acc[ai][bj][m][1]; const u32x4 x = xi[m][bj];
                    float r[8];
                    if (MODE == 0) {
                        r[0] = bf_lo(x.x) * a0[0]; r[1] = bf_hi(x.x) * a0[1]; r[2] = bf_lo(x.y) * a0[2]; r[3] = bf_hi(x.y) * a0[3];
                        r[4] = bf_lo(x.z) * a1[0]; r[5] = bf_hi(x.z) * a1[1]; r[6] = bf_lo(x.w) * a1[2]; r[7] = bf_hi(x.w) * a1[3];
                    } else {
                        const u32x4 g = xg[m][bj];
                        r[0] = bf_lo(x.x) + bf_lo(g.x) * a0[0]; r[1] = bf_hi(x.x) + bf_hi(g.x) * a0[1]; r[2] = bf_lo(x.y) + bf_lo(g.y) * a0[2]; r[3] = bf_hi(x.y) + bf_hi(g.y) * a0[3];
                        r[4] = bf_lo(x.z) + bf_lo(g.z) * a1[0]; r[5] = bf_hi(x.z) + bf_hi(g.z) * a1[1]; r[6] = bf_lo(x.w) + bf_lo(g.w) * a1[2]; r[7] = bf_hi(x.w) + bf_hi(g.w) * a1[3];
                    }
                    u32x4 w; w.x = cvt_pk_bf16(r[0], r[1]); w.y = cvt_pk_bf16(r[2], r[3]); w.z = cvt_pk_bf16(r[4], r[5]); w.w = cvt_pk_bf16(r[6], r[7]);
                    *(u32x4*)(outp + off) = w; }
            __builtin_amdgcn_sched_barrier(0);
        }
    }
};

struct EpiResid {
    static constexpr bool PERM = false, AFTER_DRAIN = false; static constexpr int VMEM_MIN = 32;
    const float* x; float* out; float alpha; f32x2* part;
    __device__ __forceinline__ void operator()(const f32x4 (&acc)[2][2][4][2], const Unit& u, int wr, int wc, int fr, int fq) const {
        asm volatile("" : "+v"(fr), "+v"(fq));
        const int row0 = u.pm * BM + wr * 64 + fr, col0 = u.pn * BM + wc * 32 + 4 * fq;
#define ER_LOAD(xv, blk) do { _Pragma("unroll") for (int mm = 0; mm < 2; ++mm) _Pragma("unroll") for (int bj = 0; bj < 2; ++bj) _Pragma("unroll") for (int n = 0; n < 2; ++n) \
            xv[mm][bj][n] = *(const f32x4*)(x + (size_t)(row0 + ((blk) >> 1) * HALF + (2 * ((blk) & 1) + mm) * 16) * 1024 + col0 + bj * HALF + n * 16); } while (0)
#define ER_DO(xv, blk) do { constexpr int ai = (blk) >> 1, mp = (blk) & 1; _Pragma("unroll") for (int mm = 0; mm < 2; ++mm) { const int m = 2 * mp + mm; const int row = row0 + ai * HALF + m * 16; const size_t off = (size_t)row * 1024 + col0; float s1 = 0.f, s2 = 0.f; \
            _Pragma("unroll") for (int bj = 0; bj < 2; ++bj) _Pragma("unroll") for (int n = 0; n < 2; ++n) { const f32x4 r = xv[mm][bj][n] * alpha + acc[ai][bj][m][n]; \
                *(f32x4*)(out + off + bj * HALF + n * 16) = r; s1 += (r[0] + r[1]) + (r[2] + r[3]); s2 += (r[0] * r[0] + r[1] * r[1]) + (r[2] * r[2] + r[3] * r[3]); } \
            s1 += __shfl_xor(s1, 16); s1 += __shfl_xor(s1, 32); s2 += __shfl_xor(s2, 16); s2 += __shfl_xor(s2, 32); \
            if (fq == 0) part[(size_t)row * 16 + (u.pn & 3) * 4 + wc] = (f32x2){s1, s2}; } } while (0)
        f32x4 xa[2][2][2], xb[2][2][2];
        ER_LOAD(xa, 0); ER_LOAD(xb, 1); __builtin_amdgcn_sched_barrier(0);
        ER_DO(xa, 0); __builtin_amdgcn_sched_barrier(0); ER_LOAD(xa, 2); __builtin_amdgcn_sched_barrier(0);
        ER_DO(xb, 1); __builtin_amdgcn_sched_barrier(0); ER_LOAD(xb, 3); __builtin_amdgcn_sched_barrier(0);
        ER_DO(xa, 2); __builtin_amdgcn_sched_barrier(0);
        ER_DO(xb, 3);
#undef ER_LOAD
#undef ER_DO
    }
};

struct EpiGateUp {
    static constexpr bool PERM = true, AFTER_DRAIN = false; static constexpr int VMEM_MIN = 8;
    bf16_t* hb;
    __device__ __forceinline__ void operator()(const f32x4 (&acc)[2][2][4][2], const Unit& u, int wr, int wc, int fr, int fq) const {
        asm volatile("" : "+v"(fr), "+v"(fq));
        const int row0 = u.pm * BM + wr * 64 + fr, col0 = (u.pn & 3) * HALF + wc * 32 + 8 * fq;
#pragma unroll
        for (int ai = 0; ai < 2; ++ai)
#pragma unroll
            for (int m = 0; m < 4; ++m) { bf16_t* p = hb + (size_t)(row0 + ai * HALF + m * 16) * 512 + col0;
                float r[8];
#pragma unroll
                for (int n = 0; n < 2; ++n)
#pragma unroll
                    for (int e = 0; e < 4; ++e) { const float g = acc[ai][0][m][n][e], up = acc[ai][1][m][n][e]; r[n * 4 + e] = g * sigmoid_f(g) * up; }
                u32x4 w; w.x = cvt_pk_bf16(r[0], r[1]); w.y = cvt_pk_bf16(r[2], r[3]); w.z = cvt_pk_bf16(r[4], r[5]); w.w = cvt_pk_bf16(r[6], r[7]);
                *(u32x4*)p = w; }
    }
};

constexpr int MOE_LDS_TE = 0, MOE_LDS_TR = 2304, MOE_LDS_TB = 4608, MOE_LDS_SL = 6912, MOE_LDS_BYTES = 6912 + 3 * 2048;
struct EpiDown {
    static constexpr bool PERM = true, AFTER_DRAIN = false; static constexpr int VMEM_MIN = 0;
    bf16_t* ffn; const PG8_LAS int* ltr; const PG8_LAS int* lsl;
    __device__ __forceinline__ void operator()(const f32x4 (&acc)[2][2][4][2], const Unit& u, int wr, int wc, int fr, int fq) const {
        asm volatile("" : "+v"(fr), "+v"(fq));
        const int nvalid = ltr[u.pm];
        const int col0 = (u.pn & 3) * BM + wc * 32 + 8 * fq;
        const PG8_LAS int* sl = lsl + u.sl * 512;
        int aa[2][4]; float ww[2][4];
#pragma unroll
        for (int ai = 0; ai < 2; ++ai)
#pragma unroll
            for (int m = 0; m < 4; ++m) { const int rl = ai * HALF + wr * 64 + m * 16 + fr; aa[ai][m] = sl[rl]; ww[ai][m] = __int_as_float(sl[256 + rl]); }
#pragma unroll
        for (int ai = 0; ai < 2; ++ai)
#pragma unroll
            for (int m = 0; m < 4; ++m) { const int rl = ai * HALF + wr * 64 + m * 16 + fr;
                if (rl < nvalid) { const float wt = ww[ai][m];
                    bf16_t* p = ffn + (size_t)aa[ai][m] * 1024 + col0;
#pragma unroll
                    for (int bj = 0; bj < 2; ++bj) { const f32x4 v0 = acc[ai][bj][m][0] * wt, v1 = acc[ai][bj][m][1] * wt;
                        u32x4 w; w.x = cvt_pk_bf16(v0[0], v0[1]); w.y = cvt_pk_bf16(v0[2], v0[3]); w.z = cvt_pk_bf16(v1[0], v1[1]); w.w = cvt_pk_bf16(v1[2], v1[3]);
                        *(u32x4*)(p + bj * HALF) = w; } } }
    }
};

template <bool GATHER_> struct MoeOrder {
    static constexpr bool GATHER = GATHER_;
    const int* list_tok; const float* list_w; int ntiles, G, c;
    PG8_LAS int* lte; PG8_LAS int* ltr; PG8_LAS int* ltb; PG8_LAS int* lsl;
    static __device__ __forceinline__ int prime(const unsigned* cnt, const int* list_tok_, const float* list_w_, int cap, int c_, PG8_LAS int* lte_, PG8_LAS int* ltr_, PG8_LAS int* ltb_, PG8_LAS int* lsl_, PG8_LAS int* lnt, int tid) {
        if (tid < 64) { const int ln = tid;
            const int cn = (ln < 32) ? (int)__hip_atomic_load(cnt + (ln & 31), __ATOMIC_RELAXED, __HIP_MEMORY_SCOPE_AGENT) : 0; const int nt = (cn + 255) >> 8;
            int incl = nt;
#pragma unroll
            for (int off = 1; off < 32; off <<= 1) { const int t = __shfl_up(incl, off); if (ln >= off) incl += t; }
            const int excl = incl - nt;
            if (ln < 32) for (int t = 0; t < nt; ++t) { lte_[excl + t] = ln; const int rem = cn - t * 256; ltr_[excl + t] = rem < 256 ? rem : 256; ltb_[excl + t] = ln * cap + t * 256; }
            if (ln == 31) *lnt = incl; }
        __syncthreads();
        const int ntl = *lnt;
        if (c_ < ntl * 4 && tid < 256) { const int base = ltb_[c_ >> 2]; lsl_[tid] = list_tok_[base + tid]; lsl_[256 + tid] = __float_as_int(list_w_[base + tid]); }
        __syncthreads();
        return ntl;
    }
    __device__ bool next(int i, Unit& u) const {
        const long L = (long)i * G + c; if (L >= (long)ntiles * 4) return false;
        const int rt = (int)(L >> 2), ct = (int)(L & 3);
        u.pm = rt; u.pn = __builtin_amdgcn_readfirstlane(lte[rt]) * 4 + ct; u.sl = i % 3; return true;
    }
    __device__ __forceinline__ void stage(const Unit& n, int wid, int lane) const {
        if (wid == 0) { const int base = __builtin_amdgcn_readfirstlane(ltb[n.pm]);
            __builtin_amdgcn_global_load_lds((const unsigned*)(list_tok + base + lane * 4), (PG8_LAS unsigned*)(lsl + n.sl * 512), 16, 0, 0);
            if (!GATHER) __builtin_amdgcn_global_load_lds((const unsigned*)(list_w + base + lane * 4), (PG8_LAS unsigned*)(lsl + n.sl * 512 + 256), 16, 0, 0);
        }
    }
    __device__ __forceinline__ unsigned arow(const Unit& u, int rl) const { return rl < ltr[u.pm] ? (unsigned)(lsl[u.sl * 512 + rl] >> 1) : 0u; }
    __device__ __forceinline__ void a_ready(const Unit&) const {}
    __device__ __forceinline__ void done(const Unit&) const {}
};

template <class Epi, class Sched, bool ALIGN_EPI = false, bool SP2 = false>
__device__ __forceinline__ void gemm_phase(PG8_LAS unsigned char* lds, const Gemm g, const Sched& S, const Epi& E) {
    int tid = threadIdx.x; asm volatile("" : "+v"(tid));
    const int wid = __builtin_amdgcn_readfirstlane(tid >> 6), lane = tid & 63, wr = wid >> 2, wc = wid & 3, fr = lane & 15, fq = lane >> 4;
    const int K = g.K, nt = K / BK;
    unsigned voffA[2], voffB[2]; int gR[2], gC[2];
    static_assert(!Sched::GATHER || SP2, "gathered A rows: SP2 loop only");
    unsigned gvo[2][2] = {{0u, 0u}, {0u, 0u}}, ngvo[2][2] = {{0u, 0u}, {0u, 0u}}, pvo[2][2] = {{0u, 0u}, {0u, 0u}};
#pragma unroll
    for (int i = 0; i < 2; ++i) { int R, C; stage_rc(tid * 16 + i * 8192, R, C); const int Rb = Epi::PERM ? ((R & ~31) + perm32(R & 31)) : R;
        voffA[i] = (unsigned)(R * K + C) * 2u; voffB[i] = (unsigned)(Rb * K + C) * 2u; gR[i] = R; gC[i] = C; }
    const size_t kstep = (size_t)(BK * 2);
    const size_t hstep = (size_t)HALF * K * 2;
    const size_t tstep = 2 * hstep;
    const unsigned ldsw = (unsigned)wid * 1024u;
    const int aoff = lds_byte(wr * 64 + fr, fq * 8), boff = lds_byte(wc * 32 + fr, fq * 8);
#define PG8_SA(b, h) (((b) * 2 + (h)) * HTB)
#define PG8_SB(b, h) ((4 + (b) * 2 + (h)) * HTB)
#define PG8_STAGE(bufoff, gbase, voff) do { _Pragma("unroll") for (int _i = 0; _i < 2; ++_i) \
        __builtin_amdgcn_global_load_lds((const unsigned*)((const char*)(gbase) + (voff)[_i]), (PG8_LAS unsigned*)(lds + (bufoff) + ldsw + _i * 8192), 16, 0, 0); } while (0)
#define PG8_STAGEA(bufoff, kptr, half, VO) do { if constexpr (Sched::GATHER) { PG8_STAGE(bufoff, kptr, (VO)[half]); } else { PG8_STAGE(bufoff, (kptr) + (half) * hstep, voffA); } } while (0)
#define PG8_GOFF(dst, un) do { _Pragma("unroll") for (int h_ = 0; h_ < 2; ++h_) _Pragma("unroll") for (int i_ = 0; i_ < 2; ++i_) dst[h_][i_] = (unsigned)(((size_t)S.arow(un, h_ * HALF + gR[i_]) * K + gC[i_]) * 2u); } while (0)
#define PG8_LDA(dst, b, h) do { _Pragma("unroll") for (int m = 0; m < 4; ++m) _Pragma("unroll") for (int k = 0; k < 2; ++k) dst[m][k] = *(const PG8_LAS bf16x8*)(lds + PG8_SA(b, h) + aoff + m * 2048 + k * 1024); } while (0)
#define PG8_LDB(dst, b, h) do { _Pragma("unroll") for (int n = 0; n < 2; ++n) _Pragma("unroll") for (int k = 0; k < 2; ++k) dst[n][k] = *(const PG8_LAS bf16x8*)(lds + PG8_SB(b, h) + boff + n * 2048 + k * 1024); } while (0)
#define PG8_MMA(ai, bj, At, Bt) do { __builtin_amdgcn_s_setprio(1); _Pragma("unroll") for (int m = 0; m < 4; ++m) _Pragma("unroll") for (int n = 0; n < 2; ++n) _Pragma("unroll") for (int k = 0; k < 2; ++k) \
        acc[ai][bj][m][n] = __builtin_amdgcn_mfma_f32_16x16x32_bf16(Bt[n][k], At[m][k], acc[ai][bj][m][n], 0, 0, 0); __builtin_amdgcn_s_setprio(0); } while (0)
#define PG8_WAIT_V(n) asm volatile("s_waitcnt vmcnt(" #n ")" ::: "memory")
#define PG8_WAIT_L(n) asm volatile("s_waitcnt lgkmcnt(" #n ")" ::: "memory")
#define PG8_BAR __builtin_amdgcn_s_barrier()
#define PG8_SCHED __builtin_amdgcn_sched_barrier(0)
    Unit cur, nxt; int ui = 0;
    if (!S.next(0, cur)) return;
    f32x4 acc[2][2][4][2];
#pragma unroll
    for (int a = 0; a < 2; ++a)
#pragma unroll
        for (int b = 0; b < 2; ++b)
#pragma unroll
            for (int m = 0; m < 4; ++m)
#pragma unroll
                for (int n = 0; n < 2; ++n) acc[a][b][m][n] = (f32x4){0.f, 0.f, 0.f, 0.f};
    bf16x8 At[4][2], B0[2][2], B1[2][2];
    const char* cA = Sched::GATHER ? (const char*)g.A : (const char*)g.A + (size_t)cur.pm * tstep; const char* cB = (const char*)g.Bt + (size_t)cur.pn * tstep;
    if constexpr (Sched::GATHER) PG8_GOFF(gvo, cur);
    S.a_ready(cur);
    if constexpr (SP2) {
        PG8_STAGE(PG8_SB(0, 0), cB, voffB); PG8_STAGE(PG8_SB(0, 1), cB + hstep, voffB); PG8_STAGEA(PG8_SA(0, 0), cA, 0, gvo); PG8_STAGEA(PG8_SA(0, 1), cA, 1, gvo);
        if (wr == 1) PG8_BAR;
        PG8_WAIT_V(2); PG8_BAR;
        PG8_STAGE(PG8_SB(1, 0), cB + kstep, voffB); PG8_STAGEA(PG8_SA(1, 0), cA + kstep, 0, gvo); PG8_STAGE(PG8_SB(1, 1), cB + hstep + kstep, voffB);
        PG8_WAIT_V(6); PG8_BAR;
    } else {
        PG8_STAGE(PG8_SB(0, 0), cB, voffB); PG8_STAGE(PG8_SA(0, 0), cA, voffA); PG8_STAGE(PG8_SB(0, 1), cB + hstep, voffB); PG8_STAGE(PG8_SA(0, 1), cA + hstep, voffA);
        if (wr == 1) PG8_BAR;
        PG8_WAIT_V(4); PG8_BAR;
        PG8_STAGE(PG8_SB(1, 0), cB + kstep, voffB); PG8_STAGE(PG8_SA(1, 0), cA + kstep, voffA); PG8_STAGE(PG8_SB(1, 1), cB + hstep + kstep, voffB);
        PG8_WAIT_V(6); PG8_BAR;
    }
    for (;;) {
        const bool has_next = S.next(ui + 1, nxt);
        const char* nA = (has_next && !Sched::GATHER) ? (const char*)g.A + (size_t)nxt.pm * tstep : cA; const char* nB = has_next ? (const char*)g.Bt + (size_t)nxt.pn * tstep : cB;
        if (has_next) S.stage(nxt, wid, lane);
        if constexpr (Sched::GATHER) { _Pragma("unroll") for (int h_ = 0; h_ < 2; ++h_) _Pragma("unroll") for (int i_ = 0; i_ < 2; ++i_) ngvo[h_][i_] = gvo[h_][i_]; }
        for (int t = 0; t < nt; t += 2) {
            const bool last = (t == nt - 2);
            const char* a1 = cA + (size_t)(t + 1) * kstep;
            const char* a2 = last ? nA : cA + (size_t)(t + 2) * kstep; const char* b2 = last ? nB : cB + (size_t)(t + 2) * kstep;
            const char* a3 = a2 + kstep; const char* b3 = b2 + kstep;
            if (last && has_next) { if constexpr (Sched::GATHER) { PG8_GOFF(ngvo, nxt); } S.a_ready(nxt); }
            if constexpr (Sched::GATHER) { _Pragma("unroll") for (int h_ = 0; h_ < 2; ++h_) _Pragma("unroll") for (int i_ = 0; i_ < 2; ++i_) pvo[h_][i_] = last ? ngvo[h_][i_] : gvo[h_][i_]; }
            if constexpr (SP2) {
            PG8_LDB(B0, 0, 0); PG8_LDB(B1, 0, 1); PG8_SCHED; PG8_LDA(At, 0, 0); PG8_STAGEA(PG8_SA(1, 1), a1, 1, gvo);
            PG8_WAIT_V(8); PG8_WAIT_L(0); PG8_BAR; PG8_MMA(0, 0, At, B0); PG8_MMA(0, 1, At, B1); PG8_BAR; PG8_SCHED;
            PG8_LDA(At, 0, 1); PG8_STAGE(PG8_SB(0, 0), b2, voffB); PG8_STAGE(PG8_SB(0, 1), b2 + hstep, voffB); PG8_STAGEA(PG8_SA(0, 0), a2, 0, pvo);
            PG8_WAIT_V(8); PG8_WAIT_L(0); PG8_BAR; PG8_MMA(1, 0, At, B0); PG8_MMA(1, 1, At, B1); PG8_BAR; PG8_SCHED;
            PG8_LDB(B0, 1, 0); PG8_LDB(B1, 1, 1); PG8_SCHED; PG8_LDA(At, 1, 0); PG8_STAGEA(PG8_SA(0, 1), a2, 1, pvo);
            PG8_WAIT_V(8); PG8_WAIT_L(0); PG8_BAR; PG8_MMA(0, 0, At, B0); PG8_MMA(0, 1, At, B1); PG8_BAR; PG8_SCHED;
            PG8_LDA(At, 1, 1); PG8_STAGE(PG8_SB(1, 0), b3, voffB); PG8_STAGE(PG8_SB(1, 1), b3 + hstep, voffB); PG8_STAGEA(PG8_SA(1, 0), a3, 0, pvo);
            PG8_WAIT_V(8); PG8_WAIT_L(0); PG8_BAR; PG8_MMA(1, 0, At, B0); PG8_MMA(1, 1, At, B1); PG8_BAR; PG8_SCHED;
            } else {
            PG8_LDB(B0, 0, 0); PG8_SCHED; PG8_LDA(At, 0, 0); PG8_STAGE(PG8_SA(1, 1), a1 + hstep, voffA);
            PG8_WAIT_L(8); PG8_BAR; PG8_WAIT_L(0); PG8_MMA(0, 0, At, B0); PG8_BAR; PG8_SCHED;
            PG8_LDB(B1, 0, 1); PG8_STAGE(PG8_SB(0, 0), b2, voffB);
            PG8_BAR; PG8_WAIT_L(0); PG8_MMA(0, 1, At, B1); PG8_BAR;
            PG8_LDA(At, 0, 1); PG8_STAGE(PG8_SA(0, 0), a2, voffA);
            PG8_BAR; PG8_WAIT_L(0); PG8_MMA(1, 0, At, B0); PG8_BAR; PG8_SCHED;
            PG8_STAGE(PG8_SB(0, 1), b2 + hstep, voffB);
            PG8_WAIT_V(6); PG8_BAR; PG8_MMA(1, 1, At, B1); PG8_BAR;
            PG8_LDB(B0, 1, 0); PG8_SCHED; PG8_LDA(At, 1, 0); PG8_STAGE(PG8_SA(0, 1), a2 + hstep, voffA);
            PG8_WAIT_L(8); PG8_BAR; PG8_WAIT_L(0); PG8_MMA(0, 0, At, B0); PG8_BAR; PG8_SCHED;
            PG8_LDB(B1, 1, 1); PG8_STAGE(PG8_SB(1, 0), b3, voffB);
            PG8_BAR; PG8_WAIT_L(0); PG8_MMA(0, 1, At, B1); PG8_BAR;
            PG8_LDA(At, 1, 1); PG8_STAGE(PG8_SA(1, 0), a3, voffA);
            PG8_BAR; PG8_WAIT_L(0); PG8_MMA(1, 0, At, B0); PG8_BAR; PG8_SCHED;
            PG8_STAGE(PG8_SB(1, 1), b3 + hstep, voffB);
            PG8_WAIT_V(6); PG8_BAR; PG8_MMA(1, 1, At, B1); PG8_BAR;
            }
        }
        if constexpr (ALIGN_EPI) { if (wr == 0) PG8_BAR; }
        if constexpr (!Epi::AFTER_DRAIN) { E(acc, cur, wr, wc, fr, fq); S.done(cur); }
        if (!has_next) break;
#pragma unroll
        for (int a = 0; a < 2; ++a)
#pragma unroll
            for (int b = 0; b < 2; ++b)
#pragma unroll
                for (int m = 0; m < 4; ++m)
#pragma unroll
                    for (int n = 0; n < 2; ++n) acc[a][b][m][n] = (f32x4){0.f, 0.f, 0.f, 0.f};
        cur = nxt; cA = nA; cB = nB; ++ui;
        if constexpr (Sched::GATHER) { _Pragma("unroll") for (int h_ = 0; h_ < 2; ++h_) _Pragma("unroll") for (int i_ = 0; i_ < 2; ++i_) gvo[h_][i_] = ngvo[h_][i_]; }
        if constexpr (ALIGN_EPI) { if (wr == 1) PG8_BAR; }
    }
    PG8_WAIT_V(0);
    if constexpr (!ALIGN_EPI) { if (wr == 0) PG8_BAR; }
    PG8_BAR;
    if constexpr (Epi::AFTER_DRAIN) { E.fused(acc, cur, wr, wc, fr, fq, lds, wid, lane); S.done(cur); }
#undef PG8_SA
#undef PG8_SB
#undef PG8_STAGE
#undef PG8_LDA
#undef PG8_STAGEA
#undef PG8_GOFF
#undef PG8_LDB
#undef PG8_MMA
#undef PG8_WAIT_V
#undef PG8_WAIT_L
#undef PG8_BAR
#undef PG8_SCHED
}
}
namespace att {
using bf16x8 = __attribute__((ext_vector_type(8))) short;
using s16x4  = __attribute__((ext_vector_type(4))) short;
using f32x16 = __attribute__((ext_vector_type(16))) float;
using u32x4  = __attribute__((ext_vector_type(4))) unsigned;
using f32x4_t = __attribute__((ext_vector_type(4))) float;
typedef unsigned short bf16;
constexpr int NW = 8, QBLK = 32, KVBLK = 64, LD = 1024, SEQ = 8192;
constexpr int SLOT = KVBLK * 128 * 2;
constexpr int KSL = 4, VSL = 5;
constexpr int LDS_K = 0, LDS_V = KSL * SLOT, LDS_WS = (KSL + VSL) * SLOT, LDS_FLG = LDS_WS + NW * 64 * 4, LDS_NXT = LDS_FLG + 64, LDS_PMX = LDS_NXT + 16, LDS_BYTES = LDS_PMX + 1024;
constexpr float THR2 = 11.5f;
constexpr float EXIT_ARG = -135.0f;
#define SBAR() __builtin_amdgcn_sched_barrier(0)
#define WAIT_BAR(N) asm volatile("s_waitcnt vmcnt(" #N ") lgkmcnt(0)\n\ts_barrier" ::: "memory")
template <int M> __device__ __forceinline__ float swz_xor(float v) {
  return __int_as_float(__builtin_amdgcn_ds_swizzle(__float_as_int(v), (M << 10) | 0x1f)); }
__device__ __forceinline__ int crow(int r, int hi) { return (r & 3) + 8 * (r >> 2) + 4 * hi; }
__device__ __forceinline__ unsigned cvtpk(float lo, float hi) { unsigned r; asm volatile("v_cvt_pk_bf16_f32 %0, %1, %2" : "=v"(r) : "v"(lo), "v"(hi)); return r; }
__device__ __forceinline__ void glds16s(unsigned voff, const void* sbase, unsigned lds_dst) { unsigned keep;
  asm volatile("s_mov_b32 %0, m0\n\ts_mov_b32 m0, %3\n\ts_nop 0\n\tglobal_load_lds_dwordx4 %1, %2\n\ts_mov_b32 m0, %0" : "=&s"(keep) : "v"(voff), "s"(sbase), "s"(lds_dst) : "memory"); }

__device__ __forceinline__ void partialSM(f32x16& p0, f32x16& p1, float& m_reg, float& alpha, float bt, bool diag, float qrel4, float slope2x2) {
  if (diag) {
#pragma unroll
    for (int r = 0; r < 16; ++r) { const float kk = (float)((r & 3) + 8 * (r >> 2));
      p0[r] -= slope2x2 * fmaxf(kk - qrel4, 0.f); p1[r] -= slope2x2 * fmaxf(kk + 32.0f - qrel4, 0.f); }
  }
  float pmax = p0[0];
#pragma unroll
  for (int r = 1; r < 16; ++r) pmax = fmaxf(pmax, p0[r]);
#pragma unroll
  for (int r = 0; r < 16; ++r) pmax = fmaxf(pmax, p1[r]);
  { auto rr = __builtin_amdgcn_permlane32_swap(__float_as_uint(pmax), __float_as_uint(pmax), false, false);
    pmax = fmaxf(__uint_as_float(rr[0]), __uint_as_float(rr[1])); }
  const float b = pmax + bt; float mn;
  if (__builtin_expect(__all(b - m_reg <= THR2), 1)) { mn = m_reg; alpha = 1.f; }
  else { mn = fmaxf(m_reg, b); alpha = __builtin_amdgcn_exp2f(m_reg - mn); m_reg = mn; }
  const float sh = bt - mn;
#pragma unroll
  for (int r = 0; r < 16; ++r) p0[r] = p0[r] + sh;
#pragma unroll
  for (int r = 0; r < 16; ++r) p1[r] = p1[r] + sh;
#pragma unroll
  for (int r = 0; r < 16; ++r) p0[r] = __builtin_amdgcn_exp2f(p0[r]);
}
__device__ __forceinline__ void finishSM(f32x16& p0, f32x16& p1, float alpha, float& l_reg, const float (&u)[16], float whi, float w32, bf16x8& pa0, bf16x8& pa1, bf16x8& pa2, bf16x8& pa3) {
#pragma unroll
  for (int r = 0; r < 16; ++r) p1[r] = __builtin_amdgcn_exp2f(p1[r]);
  float s0 = 0.f, s1 = 0.f;
#pragma unroll
  for (int r = 0; r < 16; ++r) s0 = fmaf(p0[r], u[r], s0);
#pragma unroll
  for (int r = 0; r < 16; ++r) s1 = fmaf(p1[r], u[r], s1);
  float ps = fmaf(s1, w32, s0) * whi;
  { auto rr = __builtin_amdgcn_permlane32_swap(__float_as_uint(ps), __float_as_uint(ps), false, false);
    ps = __uint_as_float(rr[0]) + __uint_as_float(rr[1]); }
  l_reg = l_reg * alpha + ps;
#define PK4(P, BASE, OUT) do { unsigned a0 = cvtpk(P[BASE + 0], P[BASE + 1]), a1 = cvtpk(P[BASE + 2], P[BASE + 3]);   \
    unsigned b0 = cvtpk(P[BASE + 4], P[BASE + 5]), b1 = cvtpk(P[BASE + 6], P[BASE + 7]);                              \
    auto r0 = __builtin_amdgcn_permlane32_swap(a0, b0, false, false); auto r1 = __builtin_amdgcn_permlane32_swap(a1, b1, false, false); \
    u32x4 w = {r0[0], r1[0], r0[1], r1[1]}; OUT = *reinterpret_cast<bf16x8*>(&w); } while (0)
  PK4(p0, 0, pa0); PK4(p0, 8, pa1); PK4(p1, 0, pa2); PK4(p1, 8, pa3);
#undef PK4
}
__device__ __forceinline__ void qkt(f32x16& p0, f32x16& p1, const char* Ks, const bf16x8* qr, int r32, const int (&kq)[4]) {
  p0 = f32x16{}; p1 = f32x16{};
#pragma unroll
  for (int d0 = 0; d0 < 4; ++d0) {
    const bf16x8 b0 = *reinterpret_cast<const bf16x8*>(Ks + r32 * 256 + kq[d0]);
    const bf16x8 b1 = *reinterpret_cast<const bf16x8*>(Ks + (32 + r32) * 256 + kq[d0]);
    p0 = __builtin_amdgcn_mfma_f32_32x32x16_bf16(b0, qr[d0], p0, 0, 0, 0);
    p1 = __builtin_amdgcn_mfma_f32_32x32x16_bf16(b1, qr[d0], p1, 0, 0, 0); }
}
__device__ __forceinline__ int v_rd_base(int lane) { return ((lane & 3) << 3) | (((lane >> 2) & 3) << 6) | (((lane >> 4) & 1) << 5) | (((lane >> 5) & 1) << 8); }
constexpr int v_rd_off(int d0, int ks, int half) { return d0 * 512 + ks * 4096 + half * 2048; }
typedef short v4i16_t __attribute__((ext_vector_type(4)));
template <int OFF> __device__ __forceinline__ s16x4 tr_read(int vb) {
  return __builtin_bit_cast(s16x4, __builtin_amdgcn_ds_read_tr16_b64_v4i16((__attribute__((address_space(3))) v4i16_t*)(uintptr_t)(unsigned)(vb + OFF)));
}
template <int D0> __device__ __forceinline__ void pv_one(f32x16& od, int vb, bf16x8 pa0, bf16x8 pa1, bf16x8 pa2, bf16x8 pa3) {
  const s16x4 l0 = tr_read<v_rd_off(D0, 0, 0)>(vb), h0 = tr_read<v_rd_off(D0, 0, 1)>(vb), l1 = tr_read<v_rd_off(D0, 1, 0)>(vb), h1 = tr_read<v_rd_off(D0, 1, 1)>(vb);
  const s16x4 l2 = tr_read<v_rd_off(D0, 2, 0)>(vb), h2 = tr_read<v_rd_off(D0, 2, 1)>(vb), l3 = tr_read<v_rd_off(D0, 3, 0)>(vb), h3 = tr_read<v_rd_off(D0, 3, 1)>(vb);
  asm volatile("s_waitcnt lgkmcnt(0)" ::: "memory"); SBAR();
#define PK(L, H) (bf16x8){L[0], L[1], L[2], L[3], H[0], H[1], H[2], H[3]}
  od = __builtin_amdgcn_mfma_f32_32x32x16_bf16(pa0, PK(l0, h0), od, 0, 0, 0);
  od = __builtin_amdgcn_mfma_f32_32x32x16_bf16(pa1, PK(l1, h1), od, 0, 0, 0);
  od = __builtin_amdgcn_mfma_f32_32x32x16_bf16(pa2, PK(l2, h2), od, 0, 0, 0);
  od = __builtin_amdgcn_mfma_f32_32x32x16_bf16(pa3, PK(l3, h3), od, 0, 0, 0);
#undef PK
}
__device__ __forceinline__ void pv_d0(f32x16* o, int vb, bf16x8 pa0, bf16x8 pa1, bf16x8 pa2, bf16x8 pa3) {
  pv_one<0>(o[0], vb, pa0, pa1, pa2, pa3); pv_one<1>(o[1], vb, pa0, pa1, pa2, pa3); pv_one<2>(o[2], vb, pa0, pa1, pa2, pa3); pv_one<3>(o[3], vb, pa0, pa1, pa2, pa3);
}

__device__ __forceinline__ void softmax_tile(f32x16& p0, f32x16& p1, float& m_reg, float& mmin, float& l_reg, f32x16* o, float bt, bool diag, bool skipmax, float qrel4, float slope2x2, const float (&u)[16], float whi, float w32,
                                             float* al_l, int r32, int hi, bf16x8& pa0, bf16x8& pa1, bf16x8& pa2, bf16x8& pa3) {
  if (diag) {
#pragma unroll
    for (int r = 0; r < 16; ++r) { const float kk = (float)((r & 3) + 8 * (r >> 2));
      p0[r] -= slope2x2 * fmaxf(kk - qrel4, 0.f); p1[r] -= slope2x2 * fmaxf(kk + 32.0f - qrel4, 0.f); }
  }
  float pmax = -3e38f;
  if (!skipmax) {
  pmax = p0[0];
#pragma unroll
  for (int r = 1; r < 16; ++r) pmax = fmaxf(pmax, p0[r]);
#pragma unroll
  for (int r = 0; r < 16; ++r) pmax = fmaxf(pmax, p1[r]);
  { auto rr = __builtin_amdgcn_permlane32_swap(__float_as_uint(pmax), __float_as_uint(pmax), false, false);
    pmax = fmaxf(__uint_as_float(rr[0]), __uint_as_float(rr[1])); }
  }
  asm volatile("" : "+v"(pmax));
  const float b = pmax + bt;
  if (__builtin_expect(!__all(b - m_reg <= THR2), 0)) {
    const float mn = fmaxf(m_reg, b), alpha = __builtin_amdgcn_exp2f(m_reg - mn); m_reg = mn; l_reg *= alpha;
    { float mm = m_reg;
      mm = fminf(mm, swz_xor<1>(mm)); mm = fminf(mm, swz_xor<2>(mm)); mm = fminf(mm, swz_xor<4>(mm)); mm = fminf(mm, swz_xor<8>(mm)); mm = fminf(mm, swz_xor<16>(mm));
      mmin = __uint_as_float(__builtin_amdgcn_readfirstlane(__float_as_uint(mm))); }
#pragma unroll
    for (int d = 0; d < 4; ++d)
#pragma unroll
      for (int r = 0; r < 16; ++r) o[d][r] *= alpha;
  }
  const float sh = bt - m_reg;
#pragma unroll
  for (int r = 0; r < 16; ++r) p0[r] = __builtin_amdgcn_exp2f(p0[r] + sh);
#pragma unroll
  for (int r = 0; r < 16; ++r) p1[r] = __builtin_amdgcn_exp2f(p1[r] + sh);
  float s0 = 0.f, s1 = 0.f;
#pragma unroll
  for (int r = 0; r < 16; ++r) s0 = fmaf(p0[r], u[r], s0);
#pragma unroll
  for (int r = 0; r < 16; ++r) s1 = fmaf(p1[r], u[r], s1);
  float ps = fmaf(s1, w32, s0) * whi;
  { auto rr = __builtin_amdgcn_permlane32_swap(__float_as_uint(ps), __float_as_uint(ps), false, false);
    ps = __uint_as_float(rr[0]) + __uint_as_float(rr[1]); }
  l_reg += ps;
#define PK4(P, BASE, OUT) do { const u32x4 w = {cvtpk(P[BASE + 0], P[BASE + 1]), cvtpk(P[BASE + 2], P[BASE + 3]), cvtpk(P[BASE + 4], P[BASE + 5]), cvtpk(P[BASE + 6], P[BASE + 7])}; \
    OUT = *reinterpret_cast<const bf16x8*>(&w); } while (0)
  PK4(p0, 0, pa0); PK4(p0, 8, pa1); PK4(p1, 0, pa2); PK4(p1, 8, pa3);
#undef PK4
}
template <int D0> __device__ __forceinline__ void vload8(bf16x8 (&vf)[8], int vb) {
#define VF1(i, d0, ks) do { const s16x4 l_ = tr_read<v_rd_off(d0, ks, 0)>(vb), h_ = tr_read<v_rd_off(d0, ks, 1)>(vb); vf[i] = (bf16x8){l_[0], l_[1], l_[2], l_[3], h_[0], h_[1], h_[2], h_[3]}; } while (0)
  VF1(0, D0, 0); VF1(1, D0, 1); VF1(2, D0, 2); VF1(3, D0, 3); VF1(4, D0 + 1, 0); VF1(5, D0 + 1, 1); VF1(6, D0 + 1, 2); VF1(7, D0 + 1, 3);
#undef VF1
}
__device__ __forceinline__ void pv8(f32x16& oa, f32x16& ob, const bf16x8 (&vf)[8], bf16x8 pa0, bf16x8 pa1, bf16x8 pa2, bf16x8 pa3) {
  oa = __builtin_amdgcn_mfma_f32_32x32x16_bf16(vf[0], pa0, oa, 0, 0, 0); ob = __builtin_amdgcn_mfma_f32_32x32x16_bf16(vf[4], pa0, ob, 0, 0, 0);
  oa = __builtin_amdgcn_mfma_f32_32x32x16_bf16(vf[1], pa1, oa, 0, 0, 0); ob = __builtin_amdgcn_mfma_f32_32x32x16_bf16(vf[5], pa1, ob, 0, 0, 0);
  oa = __builtin_amdgcn_mfma_f32_32x32x16_bf16(vf[2], pa2, oa, 0, 0, 0); ob = __builtin_amdgcn_mfma_f32_32x32x16_bf16(vf[6], pa2, ob, 0, 0, 0);
  oa = __builtin_amdgcn_mfma_f32_32x32x16_bf16(vf[3], pa3, oa, 0, 0, 0); ob = __builtin_amdgcn_mfma_f32_32x32x16_bf16(vf[7], pa3, ob, 0, 0, 0);
}

template <bool CANEXIT> __device__ __forceinline__ int attn_unit(const bf16* Qb, const bf16* __restrict__ Kh, const bf16* __restrict__ Vh, bf16* Ob, int i, float slope2, const float (&u)[16], float w4, float w32, float lam,
                                          const float* __restrict__ subln_g, const float* pmx, const unsigned* kmx2, unsigned* qctr, char* lds, int probe = 0) {
  int tid = threadIdx.x; asm volatile("" : "+v"(tid));
  const int wid = __builtin_amdgcn_readfirstlane(tid >> 6), lane = tid & 63, r32 = lane & 31, hi = lane >> 5;
  const int c = wid & 1, rb = wid >> 1, grp = wid >> 2;
  const unsigned lds0 = (unsigned)(uintptr_t)lds;
  char* K_lds = lds + LDS_K;
  float* ws = (float*)(lds + LDS_WS) + wid * 64; float* li_l = ws; float* al_l = ws + 32;
  float m_reg = -1e30f, l_reg = 0; f32x16 o[4] = {}; bf16x8 qr[4];
  const bf16* Qw = Qb + (long)(rb * QBLK + r32) * LD + c * 64 + hi * 8;
#pragma unroll
  for (int d0 = 0; d0 < 4; ++d0) qr[d0] = *reinterpret_cast<const bf16x8*>(Qw + d0 * 16);
  const unsigned kmx_bits = kmx2[c];
  float qn;
  unsigned* flg = (unsigned*)(lds + LDS_FLG);
  unsigned kvo, vvo;
  { const int p = wid;
    { const int row = 4 * p + (lane >> 4), ch = (lane & 15) ^ (row & 15); kvo = (unsigned)((row * LD + ch * 8) * 2); }
    { const int lp = lane & 31, kk = 8 * (p >> 1) + (lp >> 2), key = kk, col = 32 * (2 * (p & 1) + (lane >> 5)) + 8 * (lp & 3); vvo = (unsigned)((key * LD + col) * 2); } }
  const unsigned kdst = lds0 + LDS_K + wid * 1024, vdst = lds0 + LDS_V + wid * 1024;
  const int NT = 2 * i + 2;
#define DMA_K(n, slotoff) do { const char* sb_ = (const char*)Kh + (size_t)(NT - 1 - (n)) * (KVBLK * LD * 2); \
    glds16s(kvo, sb_, (unsigned)__builtin_amdgcn_readfirstlane(kdst + (slotoff))); glds16s(kvo, sb_ + 32 * LD * 2, (unsigned)__builtin_amdgcn_readfirstlane(kdst + (slotoff) + 8192)); } while (0)
#define DMA_V(n, slotoff) do { const char* sb_ = (const char*)Vh + (size_t)(NT - 1 - (n)) * (KVBLK * LD * 2); \
    glds16s(vvo, sb_, (unsigned)__builtin_amdgcn_readfirstlane(vdst + (slotoff))); glds16s(vvo, sb_ + 32 * LD * 2, (unsigned)__builtin_amdgcn_readfirstlane(vdst + (slotoff) + 8192)); } while (0)
#define WAITB(cnt) do { SBAR(); const int c_ = (cnt); if (c_ >= 8) { WAIT_BAR(8); } else if (c_ >= 6) { WAIT_BAR(6); } else if (c_ >= 4) { WAIT_BAR(4); } else if (c_ >= 2) { WAIT_BAR(2); } else { WAIT_BAR(0); } SBAR(); } while (0)
#define BSZ(j) (((j) + 4 < NT ? 2 : 0) + ((j) + 3 < NT ? 2 : 0))
  const int kq0 = r32 * 256 + (((c * 8 + hi) ^ (r32 & 15)) * 16);
  const int vb0 = (int)(lds0 + LDS_V) + v_rd_base(lane);
  const bool skiplast = rb < 2;
  const float qloc = (float)(rb * QBLK + r32 - 4 * hi);
  const float whi = hi ? w4 : 1.0f;
  const float slope64 = slope2 * 64.0f, slope2x2 = 2.0f * slope2;
  bf16x8 kf[8], vfa[8], vfb[8], pa0, pa1, pa2, pa3; f32x16 p0, p1;
#define KLOAD(slotoff) do { const char* ks_ = K_lds + (slotoff); _Pragma("unroll") for (int d0 = 0; d0 < 4; ++d0) { \
    kf[2 * d0] = *reinterpret_cast<const bf16x8*>(ks_ + (kq0 ^ (32 * d0))); kf[2 * d0 + 1] = *reinterpret_cast<const bf16x8*>(ks_ + (kq0 ^ (32 * d0)) + 8192); } } while (0)
  if (CANEXIT && wid == 0) glds16s((unsigned)lane * 16u, pmx, (unsigned)__builtin_amdgcn_readfirstlane(lds0 + LDS_PMX));
  DMA_K(0, 0); DMA_K(1, SLOT); DMA_V(0, 0);
  { float s = 0.f;
#pragma unroll
    for (int d0 = 0; d0 < 4; ++d0)
#pragma unroll
      for (int e = 0; e < 8; ++e) { const float v = __uint_as_float(((unsigned)(unsigned short)qr[d0][e]) << 16); s = fmaf(v, v, s); }
    { auto rr = __builtin_amdgcn_permlane32_swap(__float_as_uint(s), __float_as_uint(s), false, false); s = __uint_as_float(rr[0]) + __uint_as_float(rr[1]); }
    s = fmaxf(s, swz_xor<1>(s)); s = fmaxf(s, swz_xor<2>(s)); s = fmaxf(s, swz_xor<4>(s)); s = fmaxf(s, swz_xor<8>(s)); s = fmaxf(s, swz_xor<16>(s));
    qn = __uint_as_float(__builtin_amdgcn_readfirstlane(__float_as_uint(sqrtf(s) * 1.001f))); }
  const bool safe = __builtin_amdgcn_readfirstlane((qn * (sqrtf(__uint_as_float(kmx_bits)) * 1.001f) < 34.0f) ? 1 : 0) != 0;
  if (2 < NT) { DMA_K(2, 2 * SLOT); } DMA_V(1, SLOT);
  if (3 < NT) { DMA_K(3, 3 * SLOT); } if (2 < NT) { DMA_V(2, 2 * SLOT); }
  SBAR(); if (2 < NT) { WAIT_BAR(12); } else { WAIT_BAR(6); } SBAR();
  KLOAD(0);
  if (CANEXIT && wid < 2) {
    float* pm_ = (float*)(lds + LDS_PMX) + wid * 128;
    float a = pm_[lane], b2 = pm_[64 + lane];
#define DPP_MAX(v, ctrl, rmask) v = fmaxf(v, __int_as_float(__builtin_amdgcn_update_dpp(__float_as_int(v), __float_as_int(v), ctrl, rmask, 0xf, false)))
    DPP_MAX(a, 0x111, 0xf); DPP_MAX(a, 0x112, 0xf); DPP_MAX(a, 0x114, 0xf); DPP_MAX(a, 0x118, 0xf); DPP_MAX(a, 0x142, 0xa); DPP_MAX(a, 0x143, 0xc);
    DPP_MAX(b2, 0x111, 0xf); DPP_MAX(b2, 0x112, 0xf); DPP_MAX(b2, 0x114, 0xf); DPP_MAX(b2, 0x118, 0xf); DPP_MAX(b2, 0x142, 0xa); DPP_MAX(b2, 0x143, 0xc);
#undef DPP_MAX
    b2 = fmaxf(b2, __int_as_float(__builtin_amdgcn_readlane(__float_as_int(a), 63)));
    pm_[lane] = sqrtf(a) * 1.001f; pm_[64 + lane] = sqrtf(b2) * 1.001f;
  }
  if (grp == 1) WAITB(BSZ(-2) + BSZ(-1));
  int v5 = 0;
  float mmin = -1e30f;
  const int n0 = (int)(100.0f / slope64);
  for (int n = 0; n < NT; ++n) {
    const int v5p = (v5 == 0) ? 4 : v5 - 1, v5n2 = (v5 >= 3) ? v5 - 3 : v5 + 2;
    int vbp = vb0 + v5p * SLOT; asm volatile("" : "+v"(vbp));
    p0 = f32x16{}; p1 = f32x16{};
#define QKM(i) do { if ((i) & 1) p1 = __builtin_amdgcn_mfma_f32_32x32x16_bf16(kf[i], qr[(i) >> 1], p1, 0, 0, 0); else p0 = __builtin_amdgcn_mfma_f32_32x32x16_bf16(kf[i], qr[(i) >> 1], p0, 0, 0, 0); } while (0)
#define VFR(vf, i, D0) do { const s16x4 l_ = tr_read<v_rd_off((D0) + ((i) >> 2), (i) & 3, 0)>(vbp), h_ = tr_read<v_rd_off((D0) + ((i) >> 2), (i) & 3, 1)>(vbp); vf[i] = (bf16x8){l_[0], l_[1], l_[2], l_[3], h_[0], h_[1], h_[2], h_[3]}; } while (0)
#define PVM(oo, pa, vf, i) oo = __builtin_amdgcn_mfma_f32_32x32x16_bf16(vf[i], pa, oo, 0, 0, 0)
    if (n > 0) {
      QKM(0); SBAR(); VFR(vfa, 0, 0); SBAR(); QKM(1); SBAR(); VFR(vfa, 4, 0); SBAR(); QKM(2); SBAR(); VFR(vfa, 1, 0); SBAR(); QKM(3); SBAR(); VFR(vfa, 5, 0); SBAR();
      QKM(4); SBAR(); VFR(vfa, 2, 0); SBAR(); QKM(5); SBAR(); VFR(vfa, 6, 0); SBAR(); QKM(6); SBAR(); VFR(vfa, 3, 0); SBAR(); QKM(7); SBAR(); VFR(vfa, 7, 0); SBAR();
      if (n + 3 < NT) DMA_K(n + 3, ((n + 3) & 3) * SLOT);
      SBAR();
      PVM(o[0], pa0, vfa, 0); SBAR(); VFR(vfb, 0, 2); SBAR(); PVM(o[1], pa0, vfa, 4); SBAR(); VFR(vfb, 4, 2); SBAR(); PVM(o[0], pa1, vfa, 1); SBAR(); VFR(vfb, 1, 2); SBAR(); PVM(o[1], pa1, vfa, 5); SBAR(); VFR(vfb, 5, 2); SBAR();
      PVM(o[0], pa2, vfa, 2); SBAR(); VFR(vfb, 2, 2); SBAR(); PVM(o[1], pa2, vfa, 6); SBAR(); VFR(vfb, 6, 2); SBAR(); PVM(o[0], pa3, vfa, 3); SBAR(); VFR(vfb, 3, 2); SBAR(); PVM(o[1], pa3, vfa, 7); SBAR(); VFR(vfb, 7, 2); SBAR();
      if (n + 2 < NT) DMA_V(n + 2, v5n2 * SLOT);
      SBAR();
      pv8(o[2], o[3], vfb, pa0, pa1, pa2, pa3);
    } else {
#pragma unroll
      for (int d0 = 0; d0 < 4; ++d0) { p0 = __builtin_amdgcn_mfma_f32_32x32x16_bf16(kf[2 * d0], qr[d0], p0, 0, 0, 0); p1 = __builtin_amdgcn_mfma_f32_32x32x16_bf16(kf[2 * d0 + 1], qr[d0], p1, 0, 0, 0); }
    }
#undef QKM
#undef VFR
#undef PVM
    WAITB(BSZ(n - 2) + BSZ(n - 1));
    __builtin_amdgcn_s_setprio(1);
    u32x4 f0 = {0u, 0u, 0u, 0u}, f1 = {0u, 0u, 0u, 0u};
    if (CANEXIT && n > n0) { f0 = *(const u32x4*)(flg + ((n - 1) & 1) * 8); f1 = *(const u32x4*)(flg + ((n - 1) & 1) * 8 + 4); }
    const int tn = NT - 1 - n;
    const float pmv = (CANEXIT && n >= n0) ? ((const float*)(lds + LDS_PMX))[c * 128 + (tn > 1 ? tn - 2 : 0)] : 0.f;
    KLOAD(((n + 1) & 3) * SLOT); SBAR();
    if (!(skiplast && n == 0))
      softmax_tile(p0, p1, m_reg, mmin, l_reg, o, slope64 * (float)(NT - 1 - n), (n == 0) || (skiplast && n == 1), safe && !((n == 0) || (skiplast && n == 1)), (n == 0) ? qloc - 64.0f : qloc, slope2x2, u, whi, w32, al_l, r32, hi, pa0, pa1, pa2, pa3);
    else { pa0 = bf16x8{}; pa1 = bf16x8{}; pa2 = bf16x8{}; pa3 = bf16x8{}; }
    if (CANEXIT && n >= n0) { const float argb = (tn > 1) ? fmaf(qn, pmv, slope64 * (float)(tn - 2) - mmin) : 0.f;
      if (lane == 0) flg[(n & 1) * 8 + wid] = (argb < EXIT_ARG) ? 1u : 0u; }
    const bool stop = CANEXIT && __builtin_amdgcn_readfirstlane(f0.x & f0.y & f0.z & f0.w & f1.x & f1.y & f1.z & f1.w) != 0u;
    __builtin_amdgcn_s_setprio(0);
    WAITB(BSZ(n - 1));
    v5 = (v5 == 4) ? 0 : v5 + 1;
    if (stop) break;
  }
  __builtin_amdgcn_s_setprio(0);
  f32x4_t gs4[2][4];
#pragma unroll
  for (int dd = 0; dd < 2; ++dd)
#pragma unroll
    for (int g = 0; g < 4; ++g) gs4[dd][g] = *(const f32x4_t*)(subln_g + (2 * c + dd) * 32 + 8 * g + 4 * hi);
  { int vbl = vb0 + ((v5 == 0) ? 4 : v5 - 1) * SLOT; asm volatile("" : "+v"(vbl));
    vload8<0>(vfa, vbl); vload8<2>(vfb, vbl); SBAR();
    pv8(o[0], o[1], vfa, pa0, pa1, pa2, pa3);
    SBAR(); asm volatile("s_waitcnt lgkmcnt(0)" ::: "memory"); SBAR();
    pv8(o[2], o[3], vfb, pa0, pa1, pa2, pa3); }
  if (grp == 0) WAITB(0);
  if (probe == 2) {
    WAITB(0);
    if (wid == 1 && lane == 0) *(unsigned*)(lds + LDS_NXT) = __hip_atomic_fetch_add(qctr, 1u, __ATOMIC_RELAXED, __HIP_MEMORY_SCOPE_AGENT);
    if (wid == 0 && lane == 0) Ob[0] = (bf16)__float_as_uint(o[0][0] + o[1][1] + o[2][2] + o[3][3] + l_reg);
    WAITB(0);
    return (int)__builtin_amdgcn_readfirstlane(*(const unsigned*)(lds + LDS_NXT));
  }
  { const float rl = __builtin_amdgcn_rcpf(l_reg) * (c ? lam : 1.0f);
#pragma unroll
    for (int d0 = 0; d0 < 4; ++d0)
#pragma unroll
      for (int r = 0; r < 16; ++r) o[d0][r] *= rl; }
  WAITB(0);
  float* ex = (float*)lds + (size_t)rb * (4 * 16 * 64);
#define EPI_SEND(B0) do { _Pragma("unroll") for (int dd = 0; dd < 2; ++dd) _Pragma("unroll") for (int r = 0; r < 16; ++r) ex[((c * 2 + dd) * 16 + r) * 64 + lane] = o[(B0) + dd][r]; } while (0)
  if (c == 0) { EPI_SEND(2); } else { EPI_SEND(0); }
#undef EPI_SEND
  WAITB(0);
  if (wid == 1 && lane == 0) *(unsigned*)(lds + LDS_NXT) = __hip_atomic_fetch_add(qctr, 1u, __ATOMIC_RELAXED, __HIP_MEMORY_SCOPE_AGENT);
  float vo[2][16]; float ssq = 0.f;
#define EPI_COMBINE(B0) do { _Pragma("unroll") for (int dd = 0; dd < 2; ++dd) _Pragma("unroll") for (int r = 0; r < 16; ++r) { \
      const float oth_ = ex[(((1 - c) * 2 + dd) * 16 + r) * 64 + lane]; const float v_ = (c == 0) ? o[(B0) + dd][r] - oth_ : oth_ - o[(B0) + dd][r]; vo[dd][r] = v_; ssq = fmaf(v_, v_, ssq); } } while (0)
  if (c == 0) { EPI_COMBINE(0); } else { EPI_COMBINE(2); }
#undef EPI_COMBINE
  { auto rr = __builtin_amdgcn_permlane32_swap(__float_as_uint(ssq), __float_as_uint(ssq), false, false); ssq = __uint_as_float(rr[0]) + __uint_as_float(rr[1]); }
  if (hi == 0) ws[r32] = ssq;
  SBAR(); asm volatile("s_waitcnt lgkmcnt(0)\n\ts_barrier" ::: "memory"); SBAR();
  ssq += ((const float*)(lds + LDS_WS))[(wid ^ 1) * 64 + r32];
  const float rs = __builtin_amdgcn_rsqf(ssq * (1.0f / 128.0f) + 1e-5f) * 0.8f;
  { int lane2 = lane; asm volatile("" : "+v"(lane2));
    bf16* Ow = Ob + (long)(rb * QBLK + (lane2 & 31)) * LD + c * 64 + ((lane2 >> 5) ? 8 : 0);
#pragma unroll
    for (int dd = 0; dd < 2; ++dd)
#pragma unroll
      for (int g = 0; g < 4; g += 2) {
        const f32x4_t ga = gs4[dd][g], gb = gs4[dd][g + 1];
        const unsigned a0 = cvtpk(vo[dd][4 * g] * rs * ga[0], vo[dd][4 * g + 1] * rs * ga[1]), a1 = cvtpk(vo[dd][4 * g + 2] * rs * ga[2], vo[dd][4 * g + 3] * rs * ga[3]);
        const unsigned b0 = cvtpk(vo[dd][4 * g + 4] * rs * gb[0], vo[dd][4 * g + 5] * rs * gb[1]), b1 = cvtpk(vo[dd][4 * g + 6] * rs * gb[2], vo[dd][4 * g + 7] * rs * gb[3]);
        auto r0 = __builtin_amdgcn_permlane32_swap(a0, b0, false, false); auto r1 = __builtin_amdgcn_permlane32_swap(a1, b1, false, false);
        const u32x4 w = {r0[0], r1[0], r0[1], r1[1]};
        *(u32x4*)(Ow + dd * 32 + 8 * g) = w; } }
  SBAR(); asm volatile("s_waitcnt lgkmcnt(0)\n\ts_barrier" ::: "memory"); SBAR();
  return (int)__builtin_amdgcn_readfirstlane(*(const unsigned*)(lds + LDS_NXT));
#undef DMA_K
#undef DMA_V
#undef WAITB
#undef BSZ
#undef KLOAD
}
#undef SBAR
#undef WAIT_BAR
}

#define GAS __attribute__((address_space(1)))
#define LAS __attribute__((address_space(3)))
typedef unsigned short bf16;
typedef unsigned v4u __attribute__((ext_vector_type(4)));
typedef float f32x4 __attribute__((ext_vector_type(4)));
typedef short bf16x8 __attribute__((ext_vector_type(8)));
typedef GAS unsigned gu32;
typedef GAS unsigned long long gu64;
#define RLX_AGENT __ATOMIC_RELAXED, __HIP_MEMORY_SCOPE_AGENT
#define LDS_WAIT() asm volatile("s_waitcnt lgkmcnt(0)" ::: "memory")
#define VM_WAIT() asm volatile("s_waitcnt vmcnt(0)" ::: "memory")
__device__ __forceinline__ unsigned long long rt() { return __builtin_amdgcn_s_memrealtime(); }
__device__ __forceinline__ unsigned f2bf(float f) { unsigned u = __builtin_bit_cast(unsigned, f); return (u + 0x7fffu + ((u >> 16) & 1u)) >> 16; }
__device__ __forceinline__ unsigned pk2(float lo, float hi) { unsigned r; asm("v_cvt_pk_bf16_f32 %0, %1, %2" : "=v"(r) : "v"(lo), "v"(hi)); return r; }

#define XB_TMO      128
#define XB_XCNT(j)  (256  + 64 * (j))
#define XB_XSUB(j)  (1280 + 64 * (j))
#define XB_XGEN(j)  (2304 + 64 * (j))
#define XB_TOP      3328
#define XB_TOPGEN   3392
#define XCD_BAR_WORDS 3456
#define XB_SPIN_CAP (1u << 18)

__device__ __forceinline__ unsigned xb_ld(unsigned* p)              { return __hip_atomic_load(p, __ATOMIC_RELAXED, __HIP_MEMORY_SCOPE_AGENT); }
__device__ __forceinline__ unsigned xb_add(unsigned* p, unsigned v) { return __hip_atomic_fetch_add(p, v, __ATOMIC_RELAXED, __HIP_MEMORY_SCOPE_AGENT); }
__device__ __forceinline__ unsigned xb_xcc_id() { return (unsigned)__builtin_amdgcn_s_getreg((3 << 11) | 20) & 0xFu; }
#define XB_SPIN(cond, bar) do { unsigned _sp = 0; while (cond) { __builtin_amdgcn_s_sleep(1); \
    if ((++_sp & 255u) == 0u) { if (xb_ld(&(bar)[XB_TMO])) break; if (_sp > XB_SPIN_CAP) { atomicAdd(&(bar)[XB_TMO], 1u); break; } } } } while (0)

struct XcdBarrier {
    unsigned* bar; unsigned x;
    volatile LAS unsigned* st;
};

__device__ __forceinline__ XcdBarrier xcd_barrier_post(unsigned* bar, volatile LAS unsigned* st) {
    XcdBarrier b; b.bar = bar; b.x = xb_xcc_id(); b.st = st;
    if (threadIdx.x == 0) (void)xb_add(&bar[XB_XCNT(b.x)], 1u);
    return b;
}
__device__ __forceinline__ void xcd_barrier_complete(unsigned* bar, unsigned x, unsigned& nloc, unsigned& nx) {
    const unsigned G = gridDim.x * gridDim.y * gridDim.z;
    unsigned sum, cnt, mine, sp = 0u;
    for (;;) {
        sum = 0u; cnt = 0u; mine = 0u;
#pragma unroll
        for (unsigned j = 0; j < 16; ++j) { const unsigned c = xb_ld(&bar[XB_XCNT(j)]); sum += c; cnt += (c > 0u) ? 1u : 0u; mine = (j == x) ? c : mine; }
        if (sum == G) break;
        __builtin_amdgcn_s_sleep(1);
        if ((++sp & 255u) == 0u) { if (xb_ld(&bar[XB_TMO])) break; if (sp > XB_SPIN_CAP) { atomicAdd(&bar[XB_TMO], 1u); break; } }
    }
    nloc = mine > 0u ? mine : 1u; nx = cnt > 0u ? cnt : 1u;
}

__device__ __forceinline__ void xcd_barrier(const XcdBarrier& b) {
    asm volatile("s_waitcnt vmcnt(0)" ::: "memory");
    __syncthreads();
    if (threadIdx.x == 0) {
        unsigned* bar = b.bar;
        __builtin_amdgcn_s_waitcnt(0);
        unsigned nloc = b.st[0], nx = b.st[1];
        if (nloc == 0u) { xcd_barrier_complete(bar, b.x, nloc, nx); b.st[0] = nloc; b.st[1] = nx; }
        const unsigned old = xb_add(&bar[XB_XSUB(b.x)], 1u);
        const unsigned gen = old / nloc;
        if (old + 1u == (gen + 1u) * nloc) {
            __builtin_amdgcn_fence(__ATOMIC_RELEASE, "agent");
            asm volatile("s_waitcnt vmcnt(0)" ::: "memory");
            const unsigned og = xb_add(&bar[XB_TOP], 1u);
            const unsigned tg = og / nx;
            if (og + 1u == (tg + 1u) * nx) xb_add(&bar[XB_TOPGEN], 1u);
            else XB_SPIN(xb_ld(&bar[XB_TOPGEN]) == tg, bar);
            __builtin_amdgcn_fence(__ATOMIC_ACQUIRE, "agent");
            xb_add(&bar[XB_XGEN(b.x)], 1u);
            asm volatile("s_waitcnt vmcnt(0)" ::: "memory");
        } else {
            XB_SPIN(xb_ld(&bar[XB_XGEN(b.x)]) == gen, bar);
            __builtin_amdgcn_fence(__ATOMIC_ACQUIRE, "agent");
            asm volatile("s_waitcnt vmcnt(0)" ::: "memory");
        }
    }
    __syncthreads();
}

typedef unsigned v2u __attribute__((ext_vector_type(2)));

constexpr int NWAVES = 8, NTHREADS = NWAVES * 64;
constexpr int BATCH = 8, SEQ = 8192, D = 1024, T = BATCH * SEQ;
constexpr int INW = 6144, GW = 512, NHEAD = 8;
constexpr int NEXP = 32, EHID = 512, NASSIGN = T * 2;
constexpr int MAXTILES = (NASSIGN + NEXP * 255) / 256 + 1;
constexpr int MOE_CAP = NASSIGN;
constexpr float LN_EPS = 1e-5f;
constexpr float ALPHA = 1.189207115002721f;
constexpr float C2 = 0.125f * 1.4426950408889634f;
constexpr int NPHASE = 12;
constexpr unsigned STAGGER_P1_TICKS = 900;
#ifndef MK_ONE_LAUNCH
#define MK_ONE_LAUNCH 1
#endif
#ifndef MK_PROBE_PHASE
#define MK_PROBE_PHASE -1
#endif

constexpr size_t MiB = 1u << 20;
constexpr size_t WS_CTL = 0, CTL_ZERO_BYTES = 64 * 1024;
constexpr size_t WS_ROUTE_E = 1 * MiB;
constexpr size_t WS_ROUTE_W = WS_ROUTE_E + (size_t)NASSIGN * 4;
constexpr size_t WS_SLOT_TOK = WS_ROUTE_W + (size_t)NASSIGN * 4;
constexpr size_t WS_SLOT_W = WS_SLOT_TOK + (size_t)MAXTILES * 256 * 4;
constexpr size_t WS_TILE_E = WS_SLOT_W + (size_t)MAXTILES * 256 * 4;
constexpr size_t WS_TILE_ROWS = WS_TILE_E + 4096;
constexpr size_t WS_KN2 = WS_TILE_ROWS + 4096;
constexpr size_t WS_PMX = WS_KN2 + 8 * 8 * 2 * 128 * 4;
constexpr size_t WS_MISC_END = WS_PMX + 8 * 8 * 2 * 128 * 4;
static_assert(WS_MISC_END <= 4 * MiB, "misc tables");
constexpr size_t WS_WIN = 4 * MiB;
constexpr size_t WS_WA = 16 * MiB;
constexpr size_t WS_WB = 17 * MiB;
constexpr size_t WS_WO = 19 * MiB;
constexpr size_t WS_SGW = 21 * MiB;
constexpr size_t WS_WGU = 22 * MiB;
constexpr size_t WS_WD = 86 * MiB;
constexpr size_t WS_XB = 128 * MiB;
constexpr size_t WS_Q = 256 * MiB;
constexpr size_t WS_K = 384 * MiB, WS_VAL = 512 * MiB, WS_GA = 640 * MiB, WS_GB = 768 * MiB;
constexpr size_t WS_LIST_TOK = 384 * MiB, WS_LIST_W = 416 * MiB;
static_assert((size_t)NEXP * MOE_CAP * 4 + 1024 <= 32 * MiB, "dispatch lists");
constexpr size_t WS_PART = 256 * MiB;
constexpr size_t WS_STATS = 272 * MiB;
constexpr size_t WS_XS = 256 * MiB;
constexpr size_t WS_HB = 528 * MiB;
constexpr size_t WS_FFN = 664 * MiB;
constexpr size_t WS_END = 920 * MiB;
static_assert(WS_XS + (size_t)MAXTILES * 256 * 1024 * 2 <= WS_HB && WS_HB + (size_t)MAXTILES * 256 * 512 * 2 <= WS_FFN && WS_FFN + (size_t)NASSIGN * 1024 * 2 <= WS_END, "moe buffers");
constexpr size_t OUT_UV = 0, OUT_SG = 128 * MiB;
constexpr int CW_BAR = 1024;
constexpr int CW_CNT = 12288;
constexpr int CW_CUR = 12288 + 64;
constexpr int CW_KMX = 14336;
constexpr int CW_AQ = 12288 + 128;
static_assert((CW_BAR + 3 * 3456) <= CW_CNT && (CW_AQ + 3 * 512) * 4 <= (int)CTL_ZERO_BYTES, "ctl map");

constexpr int RING_OFF = 0, RING_BYTES = 155648;
constexpr int LDSCTL_OFF = RING_BYTES, MISC_OFF = LDSCTL_OFF + 320;
constexpr int MOE_LDS_OFF = 131072;
static_assert(MOE_LDS_OFF + pg8::MOE_LDS_BYTES <= RING_BYTES && MOE_LDS_OFF + INW * 4 <= RING_BYTES, "MoE LDS tables / P1 bias copy");
constexpr int LDS_BYTES = 163840;
static_assert(MISC_OFF + 128 <= LDS_BYTES, "LDS map");

__device__ __forceinline__ float wave_sum(float v) {
#pragma unroll
    for (int o = 1; o < 64; o <<= 1) v += __shfl_xor(v, o);
    return v;
}

__device__ __forceinline__ void p0_transpose_item(const float* W, int K, int N, bf16* WT, int row_off, LAS float* scr, int item, int lane) {
    const int nblk = N / 32, kb = item / nblk, nb = item % nblk, k0 = 64 * kb, n0 = 32 * nb;
    float tv[32];
#pragma unroll
    for (int i = 0; i < 32; ++i) tv[i] = W[(size_t)(k0 + 2 * i + (lane >> 5)) * N + n0 + (lane & 31)];
#pragma unroll
    for (int i = 0; i < 32; ++i) scr[(2 * i + (lane >> 5)) * 33 + (lane & 31)] = tv[i];
    LDS_WAIT(); asm volatile("" ::: "memory");
    const int c = lane & 7;
#pragma unroll
    for (int j = 0; j < 4; ++j) { const int n = (lane >> 3) + 8 * j; const LAS float* s = scr + (8 * c) * 33 + n;
        v4u o; o.x = pk2(s[0 * 33], s[1 * 33]); o.y = pk2(s[2 * 33], s[3 * 33]); o.z = pk2(s[4 * 33], s[5 * 33]); o.w = pk2(s[6 * 33], s[7 * 33]);
        *(GAS v4u*)(WT + (size_t)(row_off + n0 + n) * K + k0 + 8 * c) = o; }
    LDS_WAIT(); asm volatile("" ::: "memory");
}
struct P0Args { const float *x, *w_in, *w_a, *w_b, *w_out, *sg_w, *w_gate, *w_up, *w_down; bf16 *win_t, *wa_t, *wb_t, *wo_t, *sgw, *wgu_t, *wd_t, *xb; };
__device__ __forceinline__ void p0_prologue(const P0Args& a, LAS unsigned char* lds, int gw, int NGW, int wave, int lane) {
    LAS float* scr = (LAS float*)(lds + RING_OFF + wave * 16384);
    constexpr int I_IN = (D / 64) * (INW / 32), I_A = (GW / 64) * (D / 32), I_B = (D / 64) * (D / 32), I_O = I_B;
    constexpr int I_G1 = (D / 64) * (EHID / 32), I_G = NEXP * I_G1, I_D1 = (EHID / 64) * (D / 32), I_DN = NEXP * I_D1;
    constexpr int NITEMS = I_IN + I_A + I_B + I_O + 2 * I_G + I_DN;
    for (int it = gw; it < NITEMS; it += NGW) {
        int r = it;
        if (r < I_IN) { p0_transpose_item(a.w_in, D, INW, a.win_t, 0, scr, r, lane); continue; } r -= I_IN;
        if (r < I_A) { p0_transpose_item(a.w_a, GW, D, a.wa_t, 0, scr, r, lane); continue; } r -= I_A;
        if (r < I_B) { p0_transpose_item(a.w_b, D, D, a.wb_t, 0, scr, r, lane); continue; } r -= I_B;
        if (r < I_O) { p0_transpose_item(a.w_out, D, D, a.wo_t, 0, scr, r, lane); continue; } r -= I_O;
        if (r < 2 * I_G) {
            const int which = r >= I_G; if (which) r -= I_G;
            const int e = r / I_G1, item = r % I_G1, nb = item % (EHID / 32), n0 = nb * 32, ct = n0 >> 7;
            const int row_off = e * 1024 + ct * 128 + which * 128;
            p0_transpose_item((which ? a.w_up : a.w_gate) + (size_t)e * D * EHID, D, EHID, a.wgu_t, row_off, scr, item, lane); continue; }
        r -= 2 * I_G;
        { const int e = r / I_D1, item = r % I_D1; p0_transpose_item(a.w_down + (size_t)e * EHID * D, EHID, D, a.wd_t, e * 1024, scr, item, lane); }
    }
    for (int idx = gw * 64 + lane; idx < 8 * 128 * 128; idx += NGW * 64) { const int s = idx & 127, t = (idx >> 7) & 127; const float w = a.sg_w[idx]; a.sgw[idx] = (bf16)f2bf(((t >> 6) >= (s >> 6)) ? w : 0.f); }
    const size_t n8 = (size_t)T * D / 8;
    for (size_t idx = (size_t)gw * 64 + lane; idx < n8; idx += (size_t)NGW * 64) { const f32x4 v0 = *(const GAS f32x4*)(a.x + idx * 8), v1 = *(const GAS f32x4*)(a.x + idx * 8 + 4);
        v4u o; o.x = pk2(v0.x, v0.y); o.y = pk2(v0.z, v0.w); o.z = pk2(v1.x, v1.y); o.w = pk2(v1.z, v1.w); *(GAS v4u*)(a.xb + idx * 8) = o; }
}

__device__ __forceinline__ void p2_knorm(const bf16* KB, float* kn2, unsigned* kmx, int gw, int NGW, int lane) {
    for (int it = gw; it < BATCH * NHEAD * 2 * 128; it += NGW) {
        const int t = it & 127, c = (it >> 7) & 1, h = (it >> 8) & 7, b = it >> 11;
        const GAS v4u* kp = (const GAS v4u*)(KB + ((size_t)b * SEQ + (size_t)t * 64 + lane) * D + h * 128 + c * 64);
        float s = 0.f;
#pragma unroll
        for (int q = 0; q < 8; ++q) { const v4u w = kp[q];
#pragma unroll
            for (int e = 0; e < 4; ++e) { const float x = __uint_as_float(w[e] << 16), y = __uint_as_float(w[e] & 0xffff0000u); s = fmaf(x, x, s); s = fmaf(y, y, s); } }
#pragma unroll
        for (int o = 1; o < 64; o <<= 1) s = fmaxf(s, __shfl_xor(s, o));
        if (lane == 0) { kn2[it] = s; __hip_atomic_fetch_max(kmx + (it >> 7), __float_as_uint(s), __ATOMIC_RELAXED, __HIP_MEMORY_SCOPE_AGENT); }
    }
}

__device__ __forceinline__ void p3_pmx(const float* kn2, float* pmx, int gw, int lane) {
    if (gw < BATCH * NHEAD * 2) {
        float a = kn2[gw * 128 + lane], b2 = kn2[gw * 128 + 64 + lane];
#pragma unroll
        for (int off = 1; off < 64; off <<= 1) { const float ta = __shfl_up(a, off), tb = __shfl_up(b2, off); if (lane >= off) { a = fmaxf(a, ta); b2 = fmaxf(b2, tb); } }
        const float tot = __shfl(a, 63); b2 = fmaxf(b2, tot);
        pmx[gw * 128 + lane] = sqrtf(a) * 1.001f; pmx[gw * 128 + 64 + lane] = sqrtf(b2) * 1.001f;
    }
}

constexpr int P2_PITCH = 136;
__device__ __forceinline__ void p2_gmlp(const bf16* UV, bf16* SG, const bf16* SGW, const float* ln_g, const float* ln_b, const float* sg_b, LAS unsigned char* lds, int G) {
    typedef float f32x2v __attribute__((ext_vector_type(2)));
    LAS bf16* vnT = (LAS bf16*)lds;
    LAS f32x2v* red = (LAS f32x2v*)(lds + 256 * P2_PITCH * 2);
    const int tid = threadIdx.x, lane = tid & 63, wave = __builtin_amdgcn_readfirstlane(tid >> 6), fr = lane & 15, fq = lane >> 4;
    for (int unit = blockIdx.x; unit < 1024; unit += G) {
        const int blk = unit >> 1, half = unit & 1, row0 = blk * 128;
        const int s = tid & 127, cg = __builtin_amdgcn_readfirstlane(tid >> 7);
        const bf16* vrow = UV + (size_t)(row0 + s) * 1024 + 512;
        float s1 = 0.f, s2 = 0.f;
#pragma unroll
        for (int q = 0; q < 16; ++q) { const v4u w = *(const GAS v4u*)(vrow + cg * 128 + q * 8);
#pragma unroll
            for (int e = 0; e < 4; ++e) { const float a = __uint_as_float(w[e] << 16), b = __uint_as_float(w[e] & 0xffff0000u); s1 += a + b; s2 += a * a + b * b; } }
        red[cg * 128 + s] = (f32x2v){s1, s2};
        __syncthreads();
        float t1 = 0.f, t2 = 0.f;
#pragma unroll
        for (int k = 0; k < 4; ++k) { const f32x2v p = red[k * 128 + s]; t1 += p.x; t2 += p.y; }
        const float mean = t1 * (1.f / 512.f), var = fmaxf(t2 * (1.f / 512.f) - mean * mean, 0.f), rstd = 1.0f / sqrtf(var + LN_EPS);
        const int g = half * 4 + cg;
#pragma unroll
        for (int q = 0; q < 8; ++q) { const v4u w = *(const GAS v4u*)(vrow + g * 64 + q * 8);
#pragma unroll
            for (int e = 0; e < 4; ++e) { const int c0 = q * 8 + 2 * e;
                const float a = (__uint_as_float(w[e] << 16) - mean) * rstd * ln_g[g * 64 + c0] + ln_b[g * 64 + c0];
                const float b = (__uint_as_float(w[e] & 0xffff0000u) - mean) * rstd * ln_g[g * 64 + c0 + 1] + ln_b[g * 64 + c0 + 1];
                vnT[(cg * 64 + c0) * P2_PITCH + s] = (bf16)f2bf(a); vnT[(cg * 64 + c0 + 1) * P2_PITCH + s] = (bf16)f2bf(b); } }
        __syncthreads();
        const int gl = wave >> 1, th = wave & 1, gg = half * 4 + gl;
        f32x4 acc[4][4];
#pragma unroll
        for (int a = 0; a < 4; ++a)
#pragma unroll
            for (int b = 0; b < 4; ++b) acc[a][b] = (f32x4){0.f, 0.f, 0.f, 0.f};
        const int nks = th ? 4 : 2;
        for (int ks = 0; ks < nks; ++ks) {
            bf16x8 wf[4], vf[4];
#pragma unroll
            for (int tt = 0; tt < 4; ++tt) wf[tt] = *(const GAS bf16x8*)(SGW + ((size_t)(gg * 128 + th * 64 + tt * 16 + fr) * 128 + ks * 32 + fq * 8));
#pragma unroll
            for (int ct = 0; ct < 4; ++ct) vf[ct] = *(const LAS bf16x8*)(vnT + (gl * 64 + 32 * (ct >> 1) + 8 * (fr >> 2) + 4 * (ct & 1) + (fr & 3)) * P2_PITCH + ks * 32 + fq * 8);
#pragma unroll
            for (int tt = 0; tt < 4; ++tt)
#pragma unroll
                for (int ct = 0; ct < 4; ++ct) acc[tt][ct] = __builtin_amdgcn_mfma_f32_16x16x32_bf16(vf[ct], wf[tt], acc[tt][ct], 0, 0, 0);
        }
#pragma unroll
        for (int tt = 0; tt < 4; ++tt) { const int t = th * 64 + tt * 16 + fr; const float bs = sg_b[gg * 128 + t];
#pragma unroll
            for (int cp = 0; cp < 2; ++cp) { const int c0 = gg * 64 + 32 * cp + 8 * fq;
                const v4u uw = *(const GAS v4u*)(UV + (size_t)(row0 + t) * 1024 + c0);
                const f32x4 a = acc[tt][2 * cp], b = acc[tt][2 * cp + 1];
                v4u o;
                o.x = pk2(__uint_as_float(uw.x << 16) * (a[0] + bs), __uint_as_float(uw.x & 0xffff0000u) * (a[1] + bs));
                o.y = pk2(__uint_as_float(uw.y << 16) * (a[2] + bs), __uint_as_float(uw.y & 0xffff0000u) * (a[3] + bs));
                o.z = pk2(__uint_as_float(uw.z << 16) * (b[0] + bs), __uint_as_float(uw.z & 0xffff0000u) * (b[1] + bs));
                o.w = pk2(__uint_as_float(uw.w << 16) * (b[2] + bs), __uint_as_float(uw.w & 0xffff0000u) * (b[3] + bs));
                *(GAS v4u*)(SG + (size_t)(row0 + t) * 512 + c0) = o; } }
        __syncthreads();
    }
}

typedef float f32x2v __attribute__((ext_vector_type(2)));
constexpr int P7_WPITCH = 52;
__device__ __forceinline__ void p7_ln_route(const float* H, const float* part, float* stats, bf16* H1B, const float* ln_g, const float* ln_b, const float* w_group, const float* b_group, const float* w_expert, const float* b_expert,
                                            int* list_tok, float* list_w, unsigned* cnt, LAS unsigned char* lds, int G, bool dry = false) {
    constexpr int WLB = 256 * P7_WPITCH * 4;
    LAS float* WL0 = (LAS float*)lds;
    LAS float* LG = (LAS float*)(lds + 2 * WLB);
    LAS unsigned* hist = (LAS unsigned*)(lds + 2 * WLB + 8 * 16 * 48 * 4);
    LAS unsigned* ebase = hist + 32;
    LAS float* LNG = (LAS float*)(lds + 2 * WLB + 8 * 16 * 48 * 4 + 256);
    LAS float* LBI = LNG + 2 * D;
    static_assert(2 * WLB + 8 * 16 * 48 * 4 + 256 + 2 * D * 4 + 256 <= RING_BYTES, "P7 LDS map");
    const int tid = threadIdx.x, lane = tid & 63, wave = __builtin_amdgcn_readfirstlane(tid >> 6), li = lane & 15, kq = lane >> 4;
    if (tid < 32) hist[tid] = 0u;
    for (int i = tid; i < 2 * 256 * 3; i += NTHREADS) *(LAS f32x4*)(WL0 + (i / 3) * P7_WPITCH + 36 + 4 * (i % 3)) = (f32x4){0.f, 0.f, 0.f, 0.f};
    for (int i = tid; i < D / 4; i += NTHREADS) { ((LAS f32x4*)LNG)[i] = ((const GAS f32x4*)ln_g)[i]; ((LAS f32x4*)(LNG + D))[i] = ((const GAS f32x4*)ln_b)[i]; }
    if (tid < 4) LBI[tid] = b_group[tid]; else if (tid < 36) LBI[tid] = b_expert[tid - 4];
#define P7_WLOAD(we, wg, ch_) do { _Pragma("unroll") for (int q = 0; q < 4; ++q) we[q] = *((const GAS f32x4*)(w_expert + (size_t)(ch_) * 256 * 32) + tid + q * NTHREADS); \
        wg = (f32x4){0.f, 0.f, 0.f, 0.f}; if (tid < 256) wg = *((const GAS f32x4*)(w_group + (size_t)(ch_) * 256 * 4) + tid); } while (0)
#define P7_WSTORE(we, wg, buf) do { LAS float* W_ = WL0 + (buf) * (WLB / 4); _Pragma("unroll") for (int q = 0; q < 4; ++q) { const int f = (tid + q * NTHREADS) * 4, kl = f >> 5, n = f & 31; *(LAS f32x4*)(W_ + kl * P7_WPITCH + 4 + n) = we[q]; } \
        if (tid < 256) *(LAS f32x4*)(W_ + tid * P7_WPITCH) = wg; } while (0)
#define P7_VLOAD(vv, hrow_, ch_) do { _Pragma("unroll") for (int g = 0; g < 8; ++g) { vv[2 * g] = *(const GAS f32x4*)((hrow_) + (ch_) * 256 + 32 * g); vv[2 * g + 1] = *(const GAS f32x4*)((hrow_) + (ch_) * 256 + 32 * g + 4); } } while (0)
    f32x4 vc[16], we[4], wg;
    const int rd0 = blockIdx.x;
    if (rd0 < T / 128) { P7_WLOAD(we, wg, 0); P7_VLOAD(vc, H + (size_t)(rd0 * 128 + wave * 16 + li) * D + 8 * kq, 0); P7_WSTORE(we, wg, 0); }
    __syncthreads();
    for (int rd = blockIdx.x; rd < T / 128; rd += G) {
        const int R0 = rd * 128 + wave * 16;
        const float* hrow = H + (size_t)(R0 + li) * D + 8 * kq;
        const int rdn = (rd + G < T / 128) ? rd + G : rd;
        const float* hrown = H + (size_t)(rdn * 128 + wave * 16 + li) * D + 8 * kq;
        float s1 = 0.f, s2 = 0.f;
        { const f32x4 pa = *(const GAS f32x4*)(part + (size_t)(R0 + li) * 32 + kq * 8), pb = *(const GAS f32x4*)(part + (size_t)(R0 + li) * 32 + kq * 8 + 4);
          s1 = (pa.x + pa.z) + (pb.x + pb.z); s2 = (pa.y + pa.w) + (pb.y + pb.w); }
        s1 += __shfl_xor(s1, 16); s1 += __shfl_xor(s1, 32); s2 += __shfl_xor(s2, 16); s2 += __shfl_xor(s2, 32);
        const float mean = s1 * (1.f / D), var = fmaxf(s2 * (1.f / D) - mean * mean, 0.f), rstd = 1.0f / sqrtf(var + LN_EPS);
        if (kq == 0) *(GAS f32x2v*)(stats + (size_t)(R0 + li) * 2) = (f32x2v){mean, rstd};
        f32x4 acc[3];
#pragma unroll
        for (int n = 0; n < 3; ++n) acc[n] = (f32x4){0.f, 0.f, 0.f, 0.f};
#pragma unroll 1
        for (int ch = 0; ch < 4; ++ch) {
            f32x4 vn[16];
            P7_WLOAD(we, wg, (ch + 1) & 3); P7_VLOAD(vn, (ch == 3) ? hrown : hrow, (ch + 1) & 3);
            __builtin_amdgcn_sched_barrier(0);
            const LAS float* W = WL0 + (ch & 1) * (WLB / 4);
#pragma unroll
            for (int g = 0; g < 8; ++g) { const int cl = 32 * g + 8 * kq, col = ch * 256 + cl;
                float wv[24];
#pragma unroll
                for (int e8 = 0; e8 < 8; ++e8)
#pragma unroll
                    for (int n = 0; n < 3; ++n) wv[e8 * 3 + n] = W[(cl + e8) * P7_WPITCH + li + 16 * n];
                __builtin_amdgcn_sched_barrier(0);
                float h[8];
#pragma unroll
                for (int q = 0; q < 2; ++q) { const f32x4 v = vc[2 * g + q]; const f32x4 gv = *(const LAS f32x4*)(LNG + col + 4 * q), bv = *(const LAS f32x4*)(LNG + D + col + 4 * q);
                    h[4 * q] = (v.x - mean) * rstd * gv.x + bv.x; h[4 * q + 1] = (v.y - mean) * rstd * gv.y + bv.y; h[4 * q + 2] = (v.z - mean) * rstd * gv.z + bv.z; h[4 * q + 3] = (v.w - mean) * rstd * gv.w + bv.w; }
                v4u o; o.x = pk2(h[0], h[1]); o.y = pk2(h[2], h[3]); o.z = pk2(h[4], h[5]); o.w = pk2(h[6], h[7]); *(GAS v4u*)(H1B + (size_t)(R0 + li) * D + col) = o;
#pragma unroll
                for (int e8 = 0; e8 < 8; ++e8)
#pragma unroll
                    for (int n = 0; n < 3; ++n) acc[n] = __builtin_amdgcn_mfma_f32_16x16x4f32(h[e8], wv[e8 * 3 + n], acc[n], 0, 0, 0); }
            __builtin_amdgcn_sched_barrier(0);
            P7_WSTORE(we, wg, (ch + 1) & 1);
#pragma unroll
            for (int q = 0; q < 16; ++q) vc[q] = vn[q];
            __syncthreads();
        }
        LAS float* lg = LG + wave * 16 * 48;
#pragma unroll
        for (int n = 0; n < 3; ++n)
#pragma unroll
            for (int r = 0; r < 4; ++r) lg[(4 * kq + r) * 48 + 16 * n + li] = acc[n][r];
        LDS_WAIT(); asm volatile("" ::: "memory");
        int e0 = 0, e1 = 0; unsigned r0 = 0u, r1 = 0u; float wt0 = 0.f, wt1 = 0.f;
        if (lane < 16) {
            const LAS float* l = lg + lane * 48;
            float gl[4]; int gs = 0; float gm;
#pragma unroll
            for (int q = 0; q < 4; ++q) gl[q] = l[q] + LBI[q];
            gm = gl[0];
#pragma unroll
            for (int q = 1; q < 4; ++q) if (gl[q] > gm) { gm = gl[q]; gs = q; }
            float den = 0.f;
#pragma unroll
            for (int q = 0; q < 4; ++q) den += __expf(gl[q] - gm);
            const float gwt = 1.0f / den;
            float ev[8];
#pragma unroll
            for (int q = 0; q < 8; ++q) ev[q] = l[4 + gs * 8 + q] + LBI[4 + gs * 8 + q];
            int i0 = 0; float v0 = ev[0];
#pragma unroll
            for (int q = 1; q < 8; ++q) if (ev[q] > v0) { v0 = ev[q]; i0 = q; }
            int i1 = -1; float v1 = -3.0e38f;
#pragma unroll
            for (int q = 0; q < 8; ++q) if (q != i0 && ev[q] > v1) { v1 = ev[q]; i1 = q; }
            const float ex = __expf(v1 - v0), p0 = 1.0f / (1.0f + ex), p1 = ex * p0;
            e0 = gs * 8 + i0; e1 = gs * 8 + i1; wt0 = p0 * gwt; wt1 = p1 * gwt;
            r0 = __hip_atomic_fetch_add(&hist[e0], 1u, __ATOMIC_RELAXED, __HIP_MEMORY_SCOPE_WORKGROUP); r1 = __hip_atomic_fetch_add(&hist[e1], 1u, __ATOMIC_RELAXED, __HIP_MEMORY_SCOPE_WORKGROUP);
        }
        __syncthreads();
        if (tid < 32) { const unsigned n = hist[tid]; hist[tid] = 0u; ebase[tid] = (n && !dry) ? __hip_atomic_fetch_add(cnt + tid, n, RLX_AGENT) : 0u; }
        __syncthreads();
        if (lane < 16 && !dry) { const int tok = R0 + lane;
            const size_t s0 = (size_t)e0 * MOE_CAP + ebase[e0] + r0, s1 = (size_t)e1 * MOE_CAP + ebase[e1] + r1;
            list_tok[s0] = tok * 2; list_w[s0] = wt0; list_tok[s1] = tok * 2 + 1; list_w[s1] = wt1; }
    }
}

#undef P7_WLOAD
#undef P7_WSTORE
#undef P7_VLOAD
__device__ __forceinline__ void p11_final(float* H, const bf16* H1, const bf16* FFN, const float* ln_g, const float* ln_b, int gw, int NGW, int lane) {
    f32x4 G4[4], B4[4];
#pragma unroll
    for (int j = 0; j < 4; ++j) { G4[j] = *((const GAS f32x4*)ln_g + lane + 64 * j); B4[j] = *((const GAS f32x4*)ln_b + lane + 64 * j); }
    v2u nh[4], na[4], nb[4];
    if (gw < T) {
        const GAS v2u* hp = (const GAS v2u*)(H1 + (size_t)gw * D) + lane; const GAS v2u* f0 = (const GAS v2u*)(FFN + (size_t)(2 * gw) * D) + lane; const GAS v2u* f1 = (const GAS v2u*)(FFN + (size_t)(2 * gw + 1) * D) + lane;
#pragma unroll
        for (int j = 0; j < 4; ++j) { nh[j] = hp[64 * j]; na[j] = f0[64 * j]; nb[j] = f1[64 * j]; }
    }
    for (int m = gw; m < T; m += NGW) {
        GAS f32x4* hr = (GAS f32x4*)(H + (size_t)m * D) + lane;
        v2u ch[4], ca[4], cb[4];
#pragma unroll
        for (int j = 0; j < 4; ++j) { ch[j] = nh[j]; ca[j] = na[j]; cb[j] = nb[j]; }
        { const int mn = (m + NGW < T) ? m + NGW : m;
          const GAS v2u* hp = (const GAS v2u*)(H1 + (size_t)mn * D) + lane; const GAS v2u* f0 = (const GAS v2u*)(FFN + (size_t)(2 * mn) * D) + lane; const GAS v2u* f1 = (const GAS v2u*)(FFN + (size_t)(2 * mn + 1) * D) + lane;
#pragma unroll
          for (int j = 0; j < 4; ++j) { nh[j] = hp[64 * j]; na[j] = f0[64 * j]; nb[j] = f1[64 * j]; } }
        f32x4 v[4]; float s = 0.f;
#pragma unroll
        for (int j = 0; j < 4; ++j) { const v2u hb = ch[j]; const v2u a = ca[j], b = cb[j];
            v[j].x = __uint_as_float(hb.x << 16) * ALPHA + (__uint_as_float(a.x << 16) + __uint_as_float(b.x << 16)); v[j].y = __uint_as_float(hb.x & 0xffff0000u) * ALPHA + (__uint_as_float(a.x & 0xffff0000u) + __uint_as_float(b.x & 0xffff0000u));
            v[j].z = __uint_as_float(hb.y << 16) * ALPHA + (__uint_as_float(a.y << 16) + __uint_as_float(b.y << 16)); v[j].w = __uint_as_float(hb.y & 0xffff0000u) * ALPHA + (__uint_as_float(a.y & 0xffff0000u) + __uint_as_float(b.y & 0xffff0000u));
            s += (v[j].x + v[j].y) + (v[j].z + v[j].w); }
        const float mean = wave_sum(s) * (1.f / D); float s2 = 0.f;
#pragma unroll
        for (int j = 0; j < 4; ++j) { v[j] = v[j] - mean; s2 += (v[j].x * v[j].x + v[j].y * v[j].y) + (v[j].z * v[j].z + v[j].w * v[j].w); }
        const float rstd = 1.f / sqrtf(wave_sum(s2) * (1.f / D) + LN_EPS);
#pragma unroll
        for (int j = 0; j < 4; ++j) { const f32x4 g = G4[j], b = B4[j];
            f32x4 o; o.x = v[j].x * rstd * g.x + b.x; o.y = v[j].y * rstd * g.y + b.y; o.z = v[j].z * rstd * g.z + b.z; o.w = v[j].w * rstd * g.w + b.w; hr[64 * j] = o; }
    }
}
#ifndef PROBE_SHORT_UNITS
#define PROBE_SHORT_UNITS 0
#endif

enum { I_X = 0, I_WIN, I_BIN, I_SGLNG, I_SGLNB, I_SGW, I_SGB, I_WA, I_LQ1, I_LK1, I_LQ2, I_LK2, I_SUBLN, I_WB, I_WOUT, I_LN1G, I_LN1B, I_WGRP, I_BGRP, I_WEXP, I_BEXP, I_WGATE, I_WUP, I_WDOWN, I_LN2G, I_LN2B, N_IN };
struct Args { const float* in[N_IN]; float* out; unsigned char* ws; int ph_lo, ph_hi, dummy, li; };
static_assert(sizeof(Args) == (N_IN + 2) * 8 + 16, "no padding bytes in Args");

__device__ __forceinline__ const float* karg_ptr(int k) {
    const __attribute__((address_space(4))) unsigned long long* p = (const __attribute__((address_space(4))) unsigned long long*)__builtin_amdgcn_kernarg_segment_ptr();
    asm volatile("" : "+s"(p));
    return (const float*)p[k];
}
#define KARG(k) karg_ptr(k)
__device__ __forceinline__ int fresh_lane() { int t = threadIdx.x; asm volatile("" : "+v"(t)); return t & 63; }
__global__ void __launch_bounds__(NTHREADS, 2) mk_fwd(Args args) {
    extern __shared__ __attribute__((aligned(16))) unsigned char lds[];
    LAS unsigned char* L = (LAS unsigned char*)lds;
    volatile LAS unsigned* MISC = (volatile LAS unsigned*)(L + MISC_OFF);
    const int tid = threadIdx.x, wave = __builtin_amdgcn_readfirstlane(tid >> 6);
#define lane fresh_lane()
    const int G = gridDim.x; const int bx = blockIdx.x; const int vcu = (G % 8 == 0) ? (bx % 8) * (G / 8) + bx / 8 : bx;
    unsigned char* ws = args.ws;
    gu32* ctl = (gu32*)(ws + WS_CTL);
    for (int u = tid; u < (LDS_BYTES - LDSCTL_OFF) / 4; u += NTHREADS) ((LAS unsigned*)(L + LDSCTL_OFF))[u] = 0u;
    __syncthreads();
    XcdBarrier bar; bar.bar = (unsigned*)(ctl + CW_BAR) + args.li * XCD_BAR_WORDS; bar.x = 0; bar.st = nullptr;
#if MK_ONE_LAUNCH
    bar = xcd_barrier_post((unsigned*)(ctl + CW_BAR) + args.li * XCD_BAR_WORDS, MISC + 8);
#define GRID_BAR() xcd_barrier(bar)
#else
#define GRID_BAR() do {} while (0)
#endif
    const int lo = args.ph_lo, hi = args.ph_hi;
#ifndef MK_PHASE_MASK
#define MK_PHASE_MASK 0xFFF
#endif
#define IN(k) (((MK_PHASE_MASK >> (k)) & 1) && lo <= (k) && (k) < hi)
#define BOTH(k) (IN(k) && IN((k) + 1))
#define CHAIN_SYNC() do { asm volatile("s_waitcnt vmcnt(0)" ::: "memory"); __syncthreads(); \
        if (tid == 0) { __builtin_amdgcn_fence(__ATOMIC_ACQUIRE, "agent"); asm volatile("s_waitcnt vmcnt(0)" ::: "memory"); } __syncthreads(); } while (0)
#define SEAM(k, chained) do { if (BOTH(k)) { if (chained) CHAIN_SYNC(); else GRID_BAR(); } } while (0)
    const bool dummy = args.dummy != 0;
    const int gw = vcu * NWAVES + wave, NGW = G * NWAVES;
    bf16* win_t = (bf16*)(ws + WS_WIN); bf16* wa_t = (bf16*)(ws + WS_WA); bf16* wb_t = (bf16*)(ws + WS_WB); bf16* wo_t = (bf16*)(ws + WS_WO);
    bf16* sgw = (bf16*)(ws + WS_SGW); bf16* wgu_t = (bf16*)(ws + WS_WGU); bf16* wd_t = (bf16*)(ws + WS_WD);
    bf16* XB = (bf16*)(ws + WS_XB); bf16* QB = (bf16*)(ws + WS_Q); bf16* KB = (bf16*)(ws + WS_K); bf16* VB = (bf16*)(ws + WS_VAL); bf16* GA = (bf16*)(ws + WS_GA); bf16* GB = (bf16*)(ws + WS_GB);
    bf16* XS = (bf16*)(ws + WS_XS); bf16* HB = (bf16*)(ws + WS_HB); bf16* FFN = (bf16*)(ws + WS_FFN);
    bf16* UV = (bf16*)((unsigned char*)args.out + OUT_UV); bf16* SG = (bf16*)((unsigned char*)args.out + OUT_SG);
    int* list_tok = (int*)(ws + WS_LIST_TOK); float* list_w = (float*)(ws + WS_LIST_W);
    float* kn2 = (float*)(ws + WS_KN2); float* pmx = (float*)(ws + WS_PMX);

    if (IN(0)) {
        P0Args a{KARG(I_X), KARG(I_WIN), KARG(I_WA), KARG(I_WB), KARG(I_WOUT), KARG(I_SGW), KARG(I_WGATE), KARG(I_WUP), KARG(I_WDOWN), win_t, wa_t, wb_t, wo_t, sgw, wgu_t, wd_t, XB};
        p0_prologue(a, L, gw, NGW, wave, lane);
        if (BOTH(0)) GRID_BAR();
    }
    if (IN(1)) {
        pg8::Gemm g{XB, win_t, T, INW, D}; pg8::StaticOrder S; S.init(T, INW, G, bx);
        LAS float* lbias = (LAS float*)(L + RING_OFF + MOE_LDS_OFF);
        { const float* bin = KARG(I_BIN); for (int i = tid; i < INW / 4; i += NTHREADS) ((LAS f32x4*)lbias)[i] = ((const f32x4*)bin)[i]; }
        __syncthreads();
        pg8::EpiInProj E{UV, QB, (size_t)(WS_K - WS_Q) / 2, lbias, C2};
        pg8::gemm_phase<pg8::EpiInProj, pg8::StaticOrder, true, true>(L + RING_OFF, g, S, E);
        if (BOTH(1)) GRID_BAR();
    }
    if (IN(2)) {
        p2_knorm(KB, kn2, (unsigned*)(ctl + CW_KMX), gw, NGW, lane);
        p2_gmlp(UV, SG, sgw, KARG(I_SGLNG), KARG(I_SGLNB), KARG(I_SGB), L, G);
        if (BOTH(2)) GRID_BAR();
    }
    if (IN(3)) {
        pg8::Gemm g{SG, wa_t, T, D, GW}; pg8::StaticOrder S; S.init(T, D, G, bx);
        pg8::EpiGateMix<0> E{GA, nullptr, dummy ? XB : GA};
        pg8::gemm_phase<pg8::EpiGateMix<0>, pg8::StaticOrder, true, true>(L + RING_OFF, g, S, E);
    }
    if (IN(4)) {
        float lam;
        { const float a = KARG(I_LQ1)[lane] * KARG(I_LK1)[lane], b = KARG(I_LQ2)[lane] * KARG(I_LK2)[lane];
          lam = __expf(wave_sum(a)) - __expf(wave_sum(b)) + 0.2f; lam = __uint_as_float(__builtin_amdgcn_readfirstlane(__float_as_uint(lam))); }
        unsigned* aq = (unsigned*)(ctl + CW_AQ) + args.li * 512;
        int q = (int)(((long)vcu * 8) / G) & 7, tries = 0;
        if (tid == 0) *(LAS unsigned*)(L + RING_OFF + att::LDS_NXT) = __hip_atomic_fetch_add(aq + 64 * q, 1u, RLX_AGENT);
        __syncthreads();
        int item = (int)__builtin_amdgcn_readfirstlane(*(LAS unsigned*)(L + RING_OFF + att::LDS_NXT));
        __syncthreads();
        for (;;) {
            while (item >= 512 && tries < 7) { ++tries; q = (q + 1) & 7;
                if (tid == 0) *(LAS unsigned*)(L + RING_OFF + att::LDS_NXT) = __hip_atomic_fetch_add(aq + 64 * q, 1u, RLX_AGENT);
                __syncthreads();
                item = (int)__builtin_amdgcn_readfirstlane(*(LAS unsigned*)(L + RING_OFF + att::LDS_NXT));
                __syncthreads(); }
            if (item >= 512) break;
            const int rnd = item >> 6, i = 63 - (item & 63), h = 7 - rnd, b = (q + rnd) & 7;
#define UNI_F(x) __uint_as_float(__builtin_amdgcn_readfirstlane(__float_as_uint(x)))
            const float slope2 = UNI_F(exp2f(-(float)(h + 1)) * 1.4426950408889634f);
            float u[16];
#pragma unroll
            for (int r = 0; r < 16; ++r) u[r] = __uint_as_float(__builtin_amdgcn_readfirstlane(__float_as_uint(exp2f(slope2 * (float)((r & 3) + 8 * (r >> 2))))));
            const float w4 = UNI_F(exp2f(slope2 * 4.0f)), w32 = UNI_F(exp2f(slope2 * 32.0f));
            const bf16* Kh = KB + (size_t)b * SEQ * D + h * 128; const bf16* Vh = VB + (size_t)b * SEQ * D + h * 128;
            bf16* Qb = QB + ((size_t)b * SEQ + (size_t)i * 128) * D + h * 128;
            bf16* Ob = dummy ? XB + ((size_t)b * SEQ + (size_t)i * 128) * D + h * 128 : Qb;
            if (slope2 * 64.0f * (float)(2 * i + 2) < 120.0f) item = att::attn_unit<false>(Qb, Kh, Vh, Ob, PROBE_SHORT_UNITS && dummy ? 0 : i, slope2, u, w4, w32, lam, KARG(I_SUBLN), kn2 + (size_t)(b * 8 + h) * 256, (const unsigned*)(ctl + CW_KMX) + (b * 8 + h) * 2, aq + 64 * q, (char*)lds + RING_OFF, PROBE_SHORT_UNITS && dummy ? PROBE_SHORT_UNITS : 0);
            else item = att::attn_unit<true>(Qb, Kh, Vh, Ob, PROBE_SHORT_UNITS && dummy ? 0 : i, slope2, u, w4, w32, lam, KARG(I_SUBLN), kn2 + (size_t)(b * 8 + h) * 256, (const unsigned*)(ctl + CW_KMX) + (b * 8 + h) * 2, aq + 64 * q, (char*)lds + RING_OFF, PROBE_SHORT_UNITS && dummy ? PROBE_SHORT_UNITS : 0);
        }
        if (BOTH(4)) GRID_BAR();
    }
    if (IN(5)) {
        pg8::Gemm g{QB, wb_t, T, D, D}; pg8::StaticOrder S; S.init(T, D, G, bx);
        pg8::EpiGateMix<1> E{GA, GB, dummy ? XB : GA};
        pg8::gemm_phase<pg8::EpiGateMix<1>, pg8::StaticOrder, true, true>(L + RING_OFF, g, S, E);
        SEAM(5, false);
    }
    if (IN(6)) {
        pg8::Gemm g{GA, wo_t, T, D, D}; pg8::StaticOrder S; S.init(T, D, G, bx);
        pg8::EpiResid E{KARG(I_X), args.out, ALPHA, (pg8::f32x2*)(ws + WS_PART)};
        pg8::gemm_phase<pg8::EpiResid, pg8::StaticOrder, true, true>(L + RING_OFF, g, S, E);
        SEAM(6, false);
    }
    if (IN(7)) {
        p7_ln_route(args.out, (const float*)(ws + WS_PART), (float*)(ws + WS_STATS), XB, KARG(I_LN1G), KARG(I_LN1B), KARG(I_WGRP), KARG(I_BGRP), KARG(I_WEXP), KARG(I_BEXP), list_tok, list_w, (unsigned*)(ctl + CW_CNT), L, G, dummy);
        if (BOTH(7)) GRID_BAR();
    }
    if (IN(9)) {
        LAS int* ml = (LAS int*)(L + RING_OFF + MOE_LDS_OFF);
        const int ntiles = pg8::MoeOrder<true>::prime((const unsigned*)(ctl + CW_CNT), list_tok, list_w, MOE_CAP, bx, ml + pg8::MOE_LDS_TE / 4, ml + pg8::MOE_LDS_TR / 4, ml + pg8::MOE_LDS_TB / 4, ml + pg8::MOE_LDS_SL / 4, (LAS int*)(MISC + 12), tid);
        pg8::Gemm g{XB, wgu_t, 0, 0, D}; pg8::MoeOrder<true> S{list_tok, list_w, ntiles, G, bx, ml + pg8::MOE_LDS_TE / 4, ml + pg8::MOE_LDS_TR / 4, ml + pg8::MOE_LDS_TB / 4, ml + pg8::MOE_LDS_SL / 4};
        pg8::EpiGateUp E{HB};
        pg8::gemm_phase<pg8::EpiGateUp, pg8::MoeOrder<true>, true, true>(L + RING_OFF, g, S, E);
        if (BOTH(9)) GRID_BAR();
    }
    if (IN(10)) {
        LAS int* ml = (LAS int*)(L + RING_OFF + MOE_LDS_OFF);
        const int ntiles = pg8::MoeOrder<false>::prime((const unsigned*)(ctl + CW_CNT), list_tok, list_w, MOE_CAP, bx, ml + pg8::MOE_LDS_TE / 4, ml + pg8::MOE_LDS_TR / 4, ml + pg8::MOE_LDS_TB / 4, ml + pg8::MOE_LDS_SL / 4, (LAS int*)(MISC + 12), tid);
        pg8::Gemm g{HB, wd_t, 0, 0, EHID}; pg8::MoeOrder<false> S{list_tok, list_w, ntiles, G, bx, ml + pg8::MOE_LDS_TE / 4, ml + pg8::MOE_LDS_TR / 4, ml + pg8::MOE_LDS_TB / 4, ml + pg8::MOE_LDS_SL / 4};
        pg8::EpiDown E{FFN, ml + pg8::MOE_LDS_TR / 4, ml + pg8::MOE_LDS_SL / 4};
        pg8::gemm_phase<pg8::EpiDown, pg8::MoeOrder<false>, true, true>(L + RING_OFF, g, S, E);
        if (BOTH(10)) GRID_BAR();
    }
    if (IN(11)) {
        p11_final(args.out, XB, FFN, KARG(I_LN2G), KARG(I_LN2B), gw, NGW, lane);
    }
#undef IN
#undef BOTH
#undef lane
}

extern "C" void kernel_launch(void* const* d_in, const int* in_sizes, int n_in, void* d_out, int out_size, void* d_ws, size_t ws_size, hipStream_t stream) {
    static int grid = 0;
    if (grid == 0) {
        if (n_in != N_IN || in_sizes[0] != T * D || out_size != T * D || ws_size < WS_END) {
            fprintf(stderr, "kernel_launch: shape mismatch: n_in %d in0 %d out %d ws %zu (need %zu)\n", n_in, n_in > 0 ? in_sizes[0] : -1, out_size, ws_size, (size_t)WS_END); grid = -1; return; }
        int dev = 0, cus = 0, per_cu = 0;
        if (hipGetDevice(&dev) != hipSuccess || hipDeviceGetAttribute(&cus, hipDeviceAttributeMultiprocessorCount, dev) != hipSuccess) { grid = -1; return; }
        if (hipFuncSetAttribute((const void*)mk_fwd, hipFuncAttributeMaxDynamicSharedMemorySize, LDS_BYTES) != hipSuccess) { fprintf(stderr, "kernel_launch: hipFuncSetAttribute failed\n"); grid = -1; return; }
        if (hipOccupancyMaxActiveBlocksPerMultiprocessor(&per_cu, (const void*)mk_fwd, NTHREADS, LDS_BYTES) != hipSuccess || per_cu < 1)
            fprintf(stderr, "kernel_launch: note: occupancy query reports %d workgroups per CU\n", per_cu);
        (void)hipGetLastError();
        grid = cus;
    }
    if (grid < 0) return;
    if (hipMemsetAsync((char*)d_ws + WS_CTL, 0, CTL_ZERO_BYTES, stream) != hipSuccess) { fprintf(stderr, "kernel_launch: memset failed\n"); return; }
    Args a{};
    for (int i = 0; i < N_IN; ++i) a.in[i] = (const float*)d_in[i];
    a.out = (float*)d_out; a.ws = (unsigned char*)d_ws;
#if MK_ONE_LAUNCH && MK_PROBE_PHASE >= 0
    a.ph_lo = 0; a.ph_hi = MK_PROBE_PHASE; a.li = 0; if (MK_PROBE_PHASE > 0) hipLaunchKernelGGL(mk_fwd, dim3(grid), dim3(NTHREADS), LDS_BYTES, stream, a);
    a.ph_lo = MK_PROBE_PHASE; a.ph_hi = MK_PROBE_PHASE + 1; a.li = 1; a.dummy = 1; hipLaunchKernelGGL(mk_fwd, dim3(grid), dim3(NTHREADS), LDS_BYTES, stream, a);
    a.ph_lo = MK_PROBE_PHASE; a.ph_hi = NPHASE; a.li = 2; a.dummy = 0; hipLaunchKernelGGL(mk_fwd, dim3(grid), dim3(NTHREADS), LDS_BYTES, stream, a);
#elif MK_ONE_LAUNCH
    a.ph_lo = 0; a.ph_hi = NPHASE;
    hipLaunchKernelGGL(mk_fwd, dim3(grid), dim3(NTHREADS), LDS_BYTES, stream, a);
#else
    for (int p = 0; p < NPHASE; ++p) { a.ph_lo = p; a.ph_hi = p + 1; hipLaunchKernelGGL(mk_fwd, dim3(grid), dim3(NTHREADS), LDS_BYTES, stream, a); }
#endif
    const hipError_t le = hipPeekAtLastError();
    if (le != hipSuccess) fprintf(stderr, "kernel_launch: launch failed: %s\n", hipGetErrorName(le));
}
```
